# Optimizing an MI355X kernel written in HIP

```python
import math
import jax, jax.numpy as jnp
from jax import lax
import numpy as np

D_MODEL = 1024
BATCH = 32
SEQ = 256
DEPTH = 2
DEC_BATCH = 8
DEC_SEQ = 2048
PAST_LEN = 512

GRID_W = 64
MOD_CHUNKS = 6
EPS = 1e-6
POOL_WIDTH = D_MODEL // 2
POOL_GROUPS = 4
POOL_GROUP_W = POOL_WIDTH // POOL_GROUPS
POOL_WINDOWS = (2, 4, 8, 16)
N_Q_HEADS = 8
N_KV_HEADS = 2
GQA_GROUP = N_Q_HEADS // N_KV_HEADS
HEAD_DIM = 64
ATTN_WIDTH = N_Q_HEADS * HEAD_DIM
KV_WIDTH = N_KV_HEADS * HEAD_DIM
WINDOW = 128
BLOCK = 128
ROPE_BASE = 10000.0
ATTN_SCALE = HEAD_DIM ** -0.5
SSD_HEADS = 16
SSD_HEADDIM = 64
SSD_INNER = SSD_HEADS * SSD_HEADDIM
SSD_GROUPS = 2
HEADS_PER_GROUP = SSD_HEADS // SSD_GROUPS
D_STATE = 128
CONV_W = 5
CHUNK = 128
CONV_CH = SSD_INNER + 2 * SSD_GROUPS * D_STATE
N_BRANCH = 3
D_FF = 4 * D_MODEL
IN_SIZES = (POOL_WIDTH, ATTN_WIDTH, KV_WIDTH, KV_WIDTH, SSD_INNER, CONV_CH, 2 * SSD_HEADS, N_BRANCH * D_MODEL)
IN_COLS = sum(IN_SIZES)

kernel_name = "hybrid_pool_swa_ssd_prefix_dit_step"


def rmsnorm(x, g):
    xf = x.astype(jnp.float32)
    y = xf * lax.rsqrt(jnp.mean(xf * xf, axis=-1, keepdims=True) + EPS)
    return (y * g.astype(jnp.float32)).astype(x.dtype)


def modulation(cvec, w_mod, b_mod):
    m = (jax.nn.silu(cvec) @ w_mod + b_mod)[..., None, :]
    return jnp.split(m, MOD_CHUNKS, axis=-1)


def in_projection(h, w_in):
    proj = h @ w_in
    offsets = []
    acc = 0
    for s in IN_SIZES[:-1]:
        acc += s
        offsets.append(acc)
    return jnp.split(proj, offsets, axis=-1)


def pool_mixer(u, pool_w, pool_scale):
    b, L, _ = u.shape
    cs = jnp.concatenate([jnp.zeros((b, 1, POOL_WIDTH), jnp.float32), jnp.cumsum(u.astype(jnp.float32), axis=1)], axis=1)
    t = jnp.arange(L)
    outs = []
    for gi, w in enumerate(POOL_WINDOWS):
        lo = jnp.clip(t - w // 2, 0, L)
        hi = jnp.clip(t + w // 2, 0, L)
        csg = cs[:, :, gi * POOL_GROUP_W:(gi + 1) * POOL_GROUP_W]
        cnt = (hi - lo).astype(jnp.float32)[None, :, None]
        outs.append((csg[:, hi] - csg[:, lo]) / cnt)
    pooled = jnp.concatenate(outs, axis=-1).astype(u.dtype) - u
    pooled = pooled.reshape(b, L, POOL_GROUPS, POOL_GROUP_W)
    mixed = jnp.einsum('blgc,gcd->blgd', pooled, pool_w).reshape(b, L, POOL_WIDTH)
    return mixed * pool_scale


def axial_rope(x):
    L = x.shape[1]
    rows = L // GRID_W
    row = jnp.repeat(jnp.arange(rows), GRID_W).astype(jnp.float32)
    col = jnp.tile(jnp.arange(GRID_W), rows).astype(jnp.float32)
    half = HEAD_DIM // 2
    nf = half // 2
    inv = ROPE_BASE ** (-jnp.arange(nf, dtype=jnp.float32) / nf)

    def rot(xa, pos):
        ang = pos[:, None] * inv[None, :]
        cos = jnp.cos(ang)[None, :, None, :]
        sin = jnp.sin(ang)[None, :, None, :]
        x1, x2 = xa[..., :nf], xa[..., nf:]
        return jnp.concatenate([x1 * cos - x2 * sin, x1 * sin + x2 * cos], axis=-1)

    xf = x.astype(jnp.float32)
    return jnp.concatenate([rot(xf[..., :half], row), rot(xf[..., half:], col)], axis=-1).astype(x.dtype)


def context_attention(q, k, v, sink):
    b, L = q.shape[:2]
    nb = L // BLOCK
    qb = q.reshape(b, nb, BLOCK, N_KV_HEADS, GQA_GROUP, HEAD_DIM).transpose(1, 0, 2, 3, 4, 5)
    sink_b = sink.astype(jnp.float32).reshape(1, N_KV_HEADS, GQA_GROUP, 1, 1)

    def one_block(qblk):
        s = jnp.einsum('bqkgd,bskd->bkgqs', qblk, k).astype(jnp.float32) * ATTN_SCALE
        m = jnp.maximum(jnp.max(s, axis=-1, keepdims=True), sink_b)
        p = jnp.exp(s - m)
        denom = jnp.sum(p, axis=-1, keepdims=True) + jnp.exp(sink_b - m)
        o = jnp.einsum('bkgqs,bskd->bqkgd', (p / denom).astype(v.dtype), v)
        return o.reshape(b, BLOCK, ATTN_WIDTH)

    out = lax.map(one_block, qb)
    return out.transpose(1, 0, 2, 3).reshape(b, L, ATTN_WIDTH)


def latent_attention(q, k, v, k_ctx, v_ctx, sink):
    b, L = q.shape[:2]
    nb = L // BLOCK
    qb = q.reshape(b, nb, BLOCK, N_KV_HEADS, GQA_GROUP, HEAD_DIM)
    pad = ((0, 0), (BLOCK, BLOCK), (0, 0), (0, 0))
    kp = jnp.pad(k, pad).reshape(b, nb + 2, BLOCK, N_KV_HEADS, HEAD_DIM)
    vp = jnp.pad(v, pad).reshape(b, nb + 2, BLOCK, N_KV_HEADS, HEAD_DIM)
    kw = jnp.concatenate([kp[:, :-2], kp[:, 1:-1], kp[:, 2:]], axis=2)
    vw = jnp.concatenate([vp[:, :-2], vp[:, 1:-1], vp[:, 2:]], axis=2)
    qpos = jnp.arange(nb)[:, None] * BLOCK + jnp.arange(BLOCK)[None, :]
    kpos = (jnp.arange(nb)[:, None] - 1) * BLOCK + jnp.arange(3 * BLOCK)[None, :]
    valid = (jnp.abs(qpos[:, :, None] - kpos[:, None, :]) <= WINDOW) & ((kpos >= 0) & (kpos < L))[:, None, :]
    s_loc = jnp.einsum('bnqkgd,bnskd->bnkgqs', qb, kw).astype(jnp.float32) * ATTN_SCALE
    s_loc = jnp.where(valid[None, :, None, None], s_loc, -jnp.inf)
    s_ctx = jnp.einsum('bnqkgd,bskd->bnkgqs', qb, k_ctx).astype(jnp.float32) * ATTN_SCALE
    sink_b = sink.astype(jnp.float32).reshape(1, 1, N_KV_HEADS, GQA_GROUP, 1, 1)
    m = jnp.maximum(jnp.maximum(jnp.max(s_loc, axis=-1, keepdims=True), jnp.max(s_ctx, axis=-1, keepdims=True)), sink_b)
    p_loc = jnp.exp(s_loc - m)
    p_ctx = jnp.exp(s_ctx - m)
    denom = jnp.sum(p_loc, axis=-1, keepdims=True) + jnp.sum(p_ctx, axis=-1, keepdims=True) + jnp.exp(sink_b - m)
    o = (jnp.einsum('bnkgqs,bnskd->bnqkgd', (p_loc / denom).astype(v.dtype), vw)
         + jnp.einsum('bnkgqs,bskd->bnqkgd', (p_ctx / denom).astype(v.dtype), v_ctx))
    return o.reshape(b, L, ATTN_WIDTH)


def depthwise_conv(u, w, bias):
    pad = CONV_W // 2
    out = lax.conv_general_dilated(u, w[:, None, :], window_strides=(1,), padding=((pad, pad),),
                                   dimension_numbers=('NWC', 'WIO', 'NWC'), feature_group_count=u.shape[-1])
    return out + bias


def ssd_chunked(x, dt, A, B, C, init_state):
    b, L = x.shape[:2]
    nc = L // CHUNK
    G, HG, P, N = SSD_GROUPS, HEADS_PER_GROUP, SSD_HEADDIM, D_STATE
    xc = x.astype(jnp.float32).reshape(b, nc, CHUNK, G, HG, P)
    dtc = dt.reshape(b, nc, CHUNK, G, HG)
    Bc = B.astype(jnp.float32).reshape(b, nc, CHUNK, G, N)
    Cc = C.astype(jnp.float32).reshape(b, nc, CHUNK, G, N)
    acum = jnp.moveaxis(jnp.cumsum(dtc * A.reshape(G, HG), axis=2), 2, -1)
    causal = jnp.tril(jnp.ones((CHUNK, CHUNK), dtype=bool))
    seg = jnp.where(causal, acum[..., :, None] - acum[..., None, :], -jnp.inf)
    cb = jnp.einsum('bcign,bcjgn->bcgij', Cc, Bc)
    w_intra = cb[:, :, :, None] * jnp.exp(seg)
    dtx = xc * dtc[..., None]
    y_diag = jnp.einsum('bcghij,bcjghp->bcighp', w_intra, dtx)
    decay_to_end = jnp.exp(acum[..., -1:] - acum)
    chunk_states = jnp.einsum('bcghj,bcjgn,bcjghp->bcghpn', decay_to_end, Bc, dtx)
    chunk_decay = jnp.exp(acum[..., -1])

    def step(S, inp):
        st, dec = inp
        return S * dec[..., None, None] + st, S

    S0 = init_state.astype(jnp.float32).reshape(b, G, HG, P, N)
    S_final, S_in = lax.scan(step, S0, (jnp.moveaxis(chunk_states, 1, 0), jnp.moveaxis(chunk_decay, 1, 0)))
    S_in = jnp.moveaxis(S_in, 0, 1)
    y_off = jnp.einsum('bcign,bcghpn,bcghi->bcighp', Cc, S_in, jnp.exp(acum))
    y = (y_diag + y_off).reshape(b, L, SSD_HEADS, P)
    return y, S_final.reshape(b, SSD_HEADS, P, N)


def ssd_mixer(z, xbc, dt_raw, init_f, init_b, p):
    b, L, _ = xbc.shape
    xbc = jax.nn.silu(depthwise_conv(xbc, p['conv_w'], p['conv_b']))
    xs, Bs, Cs = jnp.split(xbc, [SSD_INNER, SSD_INNER + SSD_GROUPS * D_STATE], axis=-1)
    x = xs.reshape(b, L, SSD_HEADS, SSD_HEADDIM)
    B = Bs.reshape(b, L, SSD_GROUPS, D_STATE)
    C = Cs.reshape(b, L, SSD_GROUPS, D_STATE)
    dtb = p['dt_bias'].astype(jnp.float32)
    A = -jnp.exp(p['a_log'].astype(jnp.float32))
    dt_f_raw, dt_b_raw = jnp.split(dt_raw.astype(jnp.float32), 2, axis=-1)
    dt_f = jax.nn.softplus(dt_f_raw + dtb[0])
    dt_b = jax.nn.softplus(dt_b_raw + dtb[1])
    y_f, s_f = ssd_chunked(x, dt_f, A[0], B, C, init_f)
    y_b, s_b = ssd_chunked(x[:, ::-1], dt_b[:, ::-1], A[1], B[:, ::-1], C[:, ::-1], init_b)
    y = y_f + y_b[:, ::-1] + p['d_skip'].astype(jnp.float32)[:, None] * x.astype(jnp.float32)
    y = y.reshape(b, L, SSD_INNER) * jax.nn.silu(z.astype(jnp.float32))
    return rmsnorm(y, p['ssd_norm_g']).astype(z.dtype), s_f, s_b


def token_mixers(h, p, ctx):
    b, L, _ = h.shape
    pool_u, q, k, v, z, xbc, dt_raw, gate_logits = in_projection(h, p['w_in'])
    pool_out = pool_mixer(pool_u, p['pool_w'], p['pool_scale'])
    q = rmsnorm(q.reshape(b, L, N_Q_HEADS, HEAD_DIM), p['q_norm_g'])
    k = rmsnorm(k.reshape(b, L, N_KV_HEADS, HEAD_DIM), p['k_norm_g'])
    v = v.reshape(b, L, N_KV_HEADS, HEAD_DIM)
    if ctx is None:
        attn_out = context_attention(q, k, v, p['attn_sink'])
        init_f = jnp.zeros((b, SSD_HEADS, SSD_HEADDIM, D_STATE), jnp.float32)
        init_b = init_f
    else:
        k_ctx, v_ctx, s_ctx = ctx
        attn_out = latent_attention(axial_rope(q), axial_rope(k), v, k_ctx, v_ctx, p['attn_sink'])
        init_f, init_b = s_ctx[:, 0], s_ctx[:, 1]
    ssd_out, s_f, s_b = ssd_mixer(z, xbc, dt_raw, init_f, init_b, p)
    g_pool, g_attn, g_ssd = jnp.split(jax.nn.sigmoid(gate_logits), N_BRANCH, axis=-1)
    merged = (g_pool * (pool_out @ p['w_pool_o']) + g_attn * (attn_out @ p['w_attn_o'])
              + g_ssd * (ssd_out @ p['w_ssd_o']))
    out = merged @ p['w_out']
    if ctx is None:
        return out, (k, v, jnp.stack([s_f, s_b], axis=1).astype(h.dtype))
    return out, None


def layer(x, cvec, p, ctx):
    sh1, sc1, g1, sh2, sc2, g2 = modulation(cvec, p['w_mod'], p['b_mod'])
    h = rmsnorm(x, p['norm1_g']) * (1.0 + sc1) + sh1
    mix, ctx_tensors = token_mixers(h, p, ctx)
    x = x + g1 * mix
    h = rmsnorm(x, p['norm2_g']) * (1.0 + sc2) + sh2
    x = x + g2 * (jnp.square(jax.nn.relu(h @ p['w_mlp1'])) @ p['w_mlp2'])
    return x, ctx_tensors


def setup_inputs(seed: int = 0) -> dict:
    key = jax.random.key(seed)
    ks = jax.random.split(key, 40)

    def nrm(k, shape, scale):
        return jax.random.normal(k, shape, jnp.float32) * scale

    dt_init = jnp.exp(jax.random.uniform(ks[30], (DEPTH, 2, SSD_HEADS), jnp.float32, math.log(1e-3), math.log(1e-1)))
    return {
        'x_prompt': nrm(ks[0], (BATCH, SEQ, D_MODEL), 1.0),
        'x_sample': nrm(ks[1], (DEC_BATCH, DEC_SEQ, D_MODEL), 1.0),
        'cache_k': nrm(ks[2], (DEC_BATCH, DEPTH, PAST_LEN, N_KV_HEADS, HEAD_DIM), 1.0),
        'cache_v': nrm(ks[3], (DEC_BATCH, DEPTH, PAST_LEN, N_KV_HEADS, HEAD_DIM), 1.0),
        'state_ssd': nrm(ks[4], (DEC_BATCH, DEPTH, 2, SSD_HEADS, SSD_HEADDIM, D_STATE), 0.1),
        'c': nrm(ks[5], (DEC_BATCH, D_MODEL), 1.0),
        'c_ctx': nrm(ks[6], (D_MODEL,), 1.0),
        'w_mod': nrm(ks[7], (DEPTH, D_MODEL, MOD_CHUNKS * D_MODEL), 0.5 * D_MODEL ** -0.5),
        'b_mod': nrm(ks[8], (DEPTH, MOD_CHUNKS * D_MODEL), 0.02),
        'norm1_g': 1.0 + nrm(ks[9], (DEPTH, D_MODEL), 0.02),
        'norm2_g': 1.0 + nrm(ks[10], (DEPTH, D_MODEL), 0.02),
        'w_in': nrm(ks[11], (DEPTH, D_MODEL, IN_COLS), D_MODEL ** -0.5),
        'pool_w': nrm(ks[12], (DEPTH, POOL_GROUPS, POOL_GROUP_W, POOL_GROUP_W), POOL_GROUP_W ** -0.5),
        'pool_scale': 1.0 + nrm(ks[13], (DEPTH, POOL_WIDTH), 0.02),
        'w_pool_o': nrm(ks[14], (DEPTH, POOL_WIDTH, D_MODEL), POOL_WIDTH ** -0.5),
        'q_norm_g': 1.0 + nrm(ks[15], (DEPTH, HEAD_DIM), 0.02),
        'k_norm_g': 1.0 + nrm(ks[16], (DEPTH, HEAD_DIM), 0.02),
        'attn_sink': nrm(ks[17], (DEPTH, N_Q_HEADS), 1.0),
        'w_attn_o': nrm(ks[18], (DEPTH, ATTN_WIDTH, D_MODEL), ATTN_WIDTH ** -0.5),
        'conv_w': nrm(ks[19], (DEPTH, CONV_W, CONV_CH), CONV_W ** -0.5),
        'conv_b': nrm(ks[20], (DEPTH, CONV_CH), 0.02),
        'dt_bias': dt_init + jnp.log(-jnp.expm1(-dt_init)),
        'a_log': jnp.log(jax.random.uniform(ks[21], (DEPTH, 2, SSD_HEADS), jnp.float32, 1.0, 16.0)),
        'd_skip': 1.0 + nrm(ks[22], (DEPTH, SSD_HEADS), 0.1),
        'ssd_norm_g': 1.0 + nrm(ks[23], (DEPTH, SSD_INNER), 0.02),
        'w_ssd_o': nrm(ks[24], (DEPTH, SSD_INNER, D_MODEL), SSD_INNER ** -0.5),
        'w_out': nrm(ks[25], (DEPTH, D_MODEL, D_MODEL), D_MODEL ** -0.5),
        'w_mlp1': nrm(ks[26], (DEPTH, D_MODEL, D_FF), D_MODEL ** -0.5),
        'w_mlp2': nrm(ks[27], (DEPTH, D_FF, D_MODEL), D_FF ** -0.5),
    }


def reference(x_prompt, x_sample, cache_k, cache_v, state_ssd, c, c_ctx, w_mod, b_mod, norm1_g, norm2_g,
              w_in, pool_w, pool_scale, w_pool_o, q_norm_g, k_norm_g, attn_sink, w_attn_o, conv_w, conv_b,
              dt_bias, a_log, d_skip, ssd_norm_g, w_ssd_o, w_out, w_mlp1, w_mlp2):
    y_prompt = x_prompt
    y_sample = x_sample
    ks_out, vs_out, ss_out = [], [], []
    for l in range(DEPTH):
        p = {
            'w_mod': w_mod[l], 'b_mod': b_mod[l], 'norm1_g': norm1_g[l], 'norm2_g': norm2_g[l],
            'w_in': w_in[l], 'pool_w': pool_w[l], 'pool_scale': pool_scale[l], 'w_pool_o': w_pool_o[l],
            'q_norm_g': q_norm_g[l], 'k_norm_g': k_norm_g[l], 'attn_sink': attn_sink[l], 'w_attn_o': w_attn_o[l],
            'conv_w': conv_w[l], 'conv_b': conv_b[l], 'dt_bias': dt_bias[l], 'a_log': a_log[l],
            'd_skip': d_skip[l], 'ssd_norm_g': ssd_norm_g[l], 'w_ssd_o': w_ssd_o[l], 'w_out': w_out[l],
            'w_mlp1': w_mlp1[l], 'w_mlp2': w_mlp2[l],
        }
        y_prompt, (k_l, v_l, s_l) = layer(y_prompt, c_ctx, p, None)
        ks_out.append(k_l)
        vs_out.append(v_l)
        ss_out.append(s_l)
        y_sample, _ = layer(y_sample, c, p, (cache_k[:, l], cache_v[:, l], state_ssd[:, l]))
    new_cache_k = jnp.stack(ks_out, axis=1)
    new_cache_v = jnp.stack(vs_out, axis=1)
    new_state_ssd = jnp.stack(ss_out, axis=1)
    return (y_prompt, y_sample, new_cache_k, new_cache_v, new_state_ssd)
```

```cpp
#include <hip/hip_runtime.h>
#include <hip/hip_cooperative_groups.h>
#include <cstdio>
#include <cstdint>
namespace cg = cooperative_groups;

#define LAS __attribute__((address_space(3)))
typedef unsigned short bf16_t;
typedef short bf16x8 __attribute__((ext_vector_type(8)));
typedef float f32x4 __attribute__((ext_vector_type(4)));
typedef float f32x2 __attribute__((ext_vector_type(2)));
typedef unsigned u32x4 __attribute__((ext_vector_type(4)));
typedef unsigned u32x2 __attribute__((ext_vector_type(2)));

constexpr int DM = 1024, MCTX = 8192, MLAT = 16384, MTOK = 24576, LCTX = 256, LLAT = 2048, PAST = 512;
constexpr int INC = 6944;
constexpr int NPH_LAYER = 11, NPHASES = 1 + 2 * NPH_LAYER;
constexpr size_t OUT_CK = 25165824, OUT_CV = 27262976, OUT_ST = 29360128, OUT_TOTAL = 46137344;
constexpr size_t MiB = 1u << 20;
constexpr size_t WS_MOD = 0;
constexpr size_t WS_CK = 1 * MiB, WS_CV = 2 * MiB;
constexpr size_t WS_WIN = 4 * MiB;
constexpr size_t WS_WG = 12 * MiB;
constexpr size_t WS_WPOOL = 18 * MiB;
constexpr size_t WS_WATT = 19 * MiB;
constexpr size_t WS_WSSD = 20 * MiB;
constexpr size_t WS_WOUT = 22 * MiB;
constexpr size_t WS_WM1 = 24 * MiB;
constexpr size_t WS_WM2 = 32 * MiB;
constexpr size_t WS_H = 40 * MiB;
constexpr size_t WS_Q = 88 * MiB;
constexpr size_t WS_Z = 112 * MiB;
constexpr size_t WS_XBC = 160 * MiB;
constexpr size_t WS_POOLED = WS_XBC, WS_G = 184 * MiB;
constexpr size_t WS_PU = 232 * MiB;
constexpr size_t WS_KV = 256 * MiB;
constexpr size_t WS_DT = 268 * MiB;
constexpr size_t WS_MERGED = WS_PU;
constexpr size_t WS_BC = 280 * MiB;
constexpr size_t WS_HID = WS_Q;
constexpr size_t WS_END = 304 * MiB;

constexpr int LDS_BYTES = 143360;

struct Params { const float* in[29]; float* out; unsigned char* ws; int ph_lo, ph_hi; };
enum { I_XP = 0, I_XS, I_CK, I_CV, I_ST, I_C, I_CCTX, I_WMOD, I_BMOD, I_N1G, I_N2G, I_WIN, I_POOLW, I_POOLS, I_WPO, I_QG, I_KG, I_SINK, I_WAO,
       I_CONVW, I_CONVB, I_DTB, I_ALOG, I_DSKIP, I_SSDG, I_WSO, I_WOUT, I_WM1, I_WM2 };

__device__ __forceinline__ unsigned cvt_pk_bf16(float lo, float hi) { unsigned r; asm volatile("v_cvt_pk_bf16_f32 %0, %1, %2" : "=v"(r) : "v"(lo), "v"(hi)); return r; }
__device__ __forceinline__ float bf_lo(unsigned u) { return __uint_as_float(u << 16); }
__device__ __forceinline__ float bf_hi(unsigned u) { return __uint_as_float(u & 0xffff0000u); }
__device__ __forceinline__ float silu_f(float x) { return x / (1.f + __expf(-x)); }
__device__ __forceinline__ float sigmoid_f(float x) { return 1.f / (1.f + __expf(-x)); }
__device__ __forceinline__ float wave_sum(float v) {
#pragma unroll
    for (int o = 1; o < 64; o <<= 1) v += __shfl_xor(v, o);
    return v;
}
__device__ __forceinline__ const float* xrow_ptr(const Params& P, int ZZ, int l, int row) {
    if (l == 0) return row < MCTX ? P.in[ZZ + I_XP] + (size_t)row * DM : P.in[ZZ + I_XS] + (size_t)(row - MCTX) * DM;
    return P.out + ZZ + (size_t)row * DM;
}
__device__ __forceinline__ int mod_index(int row) { return row < MCTX ? 0 : 1 + ((row - MCTX) >> 11); }
__device__ __forceinline__ int opq0() { int z = 0; asm volatile("" : "+s"(z)); return z; }
#define LDS_WAIT() asm volatile("s_waitcnt lgkmcnt(0)" ::: "memory")
namespace pg8 {
#define PG8_LAS __attribute__((address_space(3)))
typedef unsigned short bf16_t;
typedef short bf16x8 __attribute__((ext_vector_type(8)));
typedef float f32x4 __attribute__((ext_vector_type(4)));
typedef unsigned u32x4 __attribute__((ext_vector_type(4)));
constexpr int BM = 256, BK = 64, HALF = 128, HTB = HALF * BK * 2  , STAGE_BYTES = 8 * HTB, NXCD = 8, WGM = 8;

__host__ __device__ __forceinline__ int lds_byte(int r, int c) { const int st = (r >> 4) * 2 + (c >> 5), rr = r & 15, cc = c & 31, ob = rr * 64 + cc * 2; return st * 1024 + (ob ^ (((ob >> 9) & 1) << 5)); }
__host__ __device__ __forceinline__ void stage_rc(int b, int& R, int& C) { const int st = b / 1024, sb = b % 1024, swz = sb ^ (((sb >> 9) & 1) << 5); R = (st >> 1) * 16 + swz / 64; C = (st & 1) * 32 + (swz % 64) / 2; }
__host__ __device__ __forceinline__ int perm32(int rho) { const int n = rho >> 4, i = rho & 15; return 8 * (i >> 2) + 4 * n + (i & 3); }

struct Unit { int pm, pn; };
struct Gemm { const bf16_t* A; const bf16_t* Bt; int M, N, K; };

struct StaticOrder {
    int nM, nN, nwg, G, c;
    __host__ __device__ void init(int M, int N, int G_, int c_) { nM = M / BM; nN = N / BM; nwg = nM * nN; G = G_; c = c_; }
    __host__ __device__ bool next(int i, Unit& u) const {
        const long L = (long)i * G + c; if (L >= nwg) return false;
        int wgid = (int)L; { const int q = nwg / NXCD, r = nwg % NXCD, xcd = wgid % NXCD, off = wgid / NXCD; wgid = (xcd < r ? xcd * (q + 1) : r * (q + 1) + (xcd - r) * q) + off; }
        const int nig = WGM * nN, gid = wgid / nig, fm = gid * WGM, gsz = (nM - fm) < WGM ? (nM - fm) : WGM;
        u.pm = fm + ((wgid % nig) % gsz); u.pn = (wgid % nig) / gsz; return true;
    }
    __device__ __forceinline__ void a_ready(const Unit&) const {}
    __device__ __forceinline__ void done(const Unit&) const {}
};


struct EpiInProj {
    static constexpr bool PERM = true, AFTER_DRAIN = false;
    unsigned char* ws; float* out_cv; int layer;
    __device__ __forceinline__ void operator()(const f32x4 (&acc)[2][2][4][2], const Unit& u, int wr, int wc, int fr, int fq) const {
        const int pn = u.pn;
        const int row0 = u.pm * BM + wr * 64 + fr, cw = wc * 32 + 8 * fq;
        if (pn == 15) {
            if (wc == 0) { float* D = (float*)(ws + WS_DT);
#pragma unroll
                for (int ai = 0; ai < 2; ++ai)
#pragma unroll
                    for (int m = 0; m < 4; ++m) { float* rp = D + (size_t)(row0 + ai * HALF + m * 16) * 32 + cw; *(f32x4*)rp = acc[ai][0][m][0]; *(f32x4*)(rp + 4) = acc[ai][0][m][1]; } }
            return;
        }
        size_t boff; int ld, colt;
        if (pn < 2) { boff = WS_PU; ld = 512; colt = pn * 256; } else if (pn < 4) { boff = WS_Q; ld = 512; colt = (pn - 2) * 256; } else if (pn == 4) { boff = WS_KV; ld = 256; colt = 0; }
        else if (pn < 9) { boff = WS_Z; ld = 1024; colt = (pn - 5) * 256; } else { boff = WS_XBC; ld = 1536; colt = (pn - 9) * 256; }
        bf16_t* base = (bf16_t*)(ws + boff) + colt + cw;
#pragma unroll
        for (int ai = 0; ai < 2; ++ai)
#pragma unroll
            for (int m = 0; m < 4; ++m) { bf16_t* rowp = base + (size_t)(row0 + ai * HALF + m * 16) * ld;
#pragma unroll
                for (int bj = 0; bj < 2; ++bj) { const f32x4 v0 = acc[ai][bj][m][0], v1 = acc[ai][bj][m][1];
                    u32x4 w; w.x = cvt_pk_bf16(v0[0], v0[1]); w.y = cvt_pk_bf16(v0[2], v0[3]); w.z = cvt_pk_bf16(v1[0], v1[1]); w.w = cvt_pk_bf16(v1[2], v1[3]);
                    *(u32x4*)(rowp + bj * HALF) = w; } }
        if (pn == 4 && u.pm < 32) {
#pragma unroll
            for (int ai = 0; ai < 2; ++ai)
#pragma unroll
                for (int m = 0; m < 4; ++m) { const int row = row0 + ai * HALF + m * 16; float* o = out_cv + ((size_t)((row >> 8) * 2 + layer) * 256 + (row & 255)) * 128 + cw;
                    *(f32x4*)o = acc[ai][1][m][0]; *(f32x4*)(o + 4) = acc[ai][1][m][1]; }
        }
    }
};

template <int ACT> struct EpiAct {
    static constexpr bool PERM = true, AFTER_DRAIN = false;
    bf16_t* O; int ldc;
    __device__ __forceinline__ void operator()(const f32x4 (&acc)[2][2][4][2], const Unit& u, int wr, int wc, int fr, int fq) const {
        const int row0 = u.pm * BM + wr * 64 + fr, col0 = u.pn * BM + wc * 32 + 8 * fq;
#pragma unroll
        for (int ai = 0; ai < 2; ++ai)
#pragma unroll
            for (int m = 0; m < 4; ++m) { bf16_t* rowp = O + (size_t)(row0 + ai * HALF + m * 16) * ldc + col0;
#pragma unroll
                for (int bj = 0; bj < 2; ++bj) { f32x4 v0 = acc[ai][bj][m][0], v1 = acc[ai][bj][m][1];
#pragma unroll
                    for (int e = 0; e < 4; ++e) {
                        if (ACT == 1) { v0[e] = 1.f / (1.f + __expf(-v0[e])); v1[e] = 1.f / (1.f + __expf(-v1[e])); }
                        if (ACT == 2) { const float a = fmaxf(v0[e], 0.f), b = fmaxf(v1[e], 0.f); v0[e] = a * a; v1[e] = b * b; } }
                    u32x4 w; w.x = cvt_pk_bf16(v0[0], v0[1]); w.y = cvt_pk_bf16(v0[2], v0[3]); w.z = cvt_pk_bf16(v1[0], v1[1]); w.w = cvt_pk_bf16(v1[2], v1[3]);
                    *(u32x4*)(rowp + bj * HALF) = w; } }
    }
};

struct EpiMerge {
    static constexpr bool PERM = true, AFTER_DRAIN = false;
    const bf16_t* G; bf16_t* MG; int first;
    __device__ __forceinline__ void operator()(const f32x4 (&acc)[2][2][4][2], const Unit& u, int wr, int wc, int fr, int fq) const {
        const int row0 = u.pm * BM + wr * 64 + fr, col0 = u.pn * BM + wc * 32 + 8 * fq;
#pragma unroll
        for (int ai = 0; ai < 2; ++ai)
#pragma unroll
            for (int m = 0; m < 4; ++m) { const size_t off = (size_t)(row0 + ai * HALF + m * 16) * 1024 + col0;
#pragma unroll
                for (int bj = 0; bj < 2; ++bj) { const f32x4 v0 = acc[ai][bj][m][0], v1 = acc[ai][bj][m][1];
                    const u32x4 gq = *(const u32x4*)(G + off + bj * HALF);
                    float r[8];
                    r[0] = bf_lo(gq.x) * v0[0]; r[1] = bf_hi(gq.x) * v0[1]; r[2] = bf_lo(gq.y) * v0[2]; r[3] = bf_hi(gq.y) * v0[3];
                    r[4] = bf_lo(gq.z) * v1[0]; r[5] = bf_hi(gq.z) * v1[1]; r[6] = bf_lo(gq.w) * v1[2]; r[7] = bf_hi(gq.w) * v1[3];
                    if (!first) { const u32x4 mq = *(const u32x4*)(MG + off + bj * HALF);
                        r[0] += bf_lo(mq.x); r[1] += bf_hi(mq.x); r[2] += bf_lo(mq.y); r[3] += bf_hi(mq.y); r[4] += bf_lo(mq.z); r[5] += bf_hi(mq.z); r[6] += bf_lo(mq.w); r[7] += bf_hi(mq.w); }
                    u32x4 w; w.x = cvt_pk_bf16(r[0], r[1]); w.y = cvt_pk_bf16(r[2], r[3]); w.z = cvt_pk_bf16(r[4], r[5]); w.w = cvt_pk_bf16(r[6], r[7]);
                    *(u32x4*)(MG + off + bj * HALF) = w; } }
    }
};

struct EpiResid {
    static constexpr bool PERM = false, AFTER_DRAIN = false;
    const float *xa, *xb; float* xout; const float* gate;
    __device__ __forceinline__ void operator()(const f32x4 (&acc)[2][2][4][2], const Unit& u, int wr, int wc, int fr, int fq) const {
        const int row0 = u.pm * BM + wr * 64 + fr, col0 = u.pn * BM + wc * 32 + 4 * fq;
        const int mi = u.pm < 32 ? 0 : 1 + ((u.pm - 32) >> 3);
        const float* xin = (xb != nullptr && u.pm >= 32) ? xb - (size_t)MCTX * 1024 : xa;
        f32x4 gv[2][2];
#pragma unroll
        for (int bj = 0; bj < 2; ++bj)
#pragma unroll
            for (int n = 0; n < 2; ++n) gv[bj][n] = *(const f32x4*)(gate + (size_t)mi * 6144 + col0 + bj * HALF + n * 16);
#pragma unroll
        for (int ai = 0; ai < 2; ++ai)
#pragma unroll
            for (int m = 0; m < 4; ++m) { const size_t off = (size_t)(row0 + ai * HALF + m * 16) * 1024 + col0;
#pragma unroll
                for (int bj = 0; bj < 2; ++bj)
#pragma unroll
                    for (int n = 0; n < 2; ++n) { const f32x4 xi = *(const f32x4*)(xin + off + bj * HALF + n * 16);
                        *(f32x4*)(xout + off + bj * HALF + n * 16) = xi + gv[bj][n] * acc[ai][bj][m][n]; } }
    }
};

template <class Epi, class Sched, bool ALIGN_EPI = false, bool SP2 = false>
__device__ __forceinline__ void gemm_phase(PG8_LAS unsigned char* lds, const Gemm g, const Sched& S, const Epi& E) {
    int tid_ = threadIdx.x; asm volatile("" : "+v"(tid_));
    const int tid = tid_, wid = __builtin_amdgcn_readfirstlane(tid >> 6), lane = tid & 63, wr = wid >> 2, wc = wid & 3, fr = lane & 15, fq = lane >> 4;
    const int K = g.K, nt = K / BK;
    unsigned voffA[2], voffB[2];
#pragma unroll
    for (int i = 0; i < 2; ++i) { int R, C; stage_rc(tid * 16 + i * 8192, R, C); const int Rb = Epi::PERM ? ((R & ~31) + perm32(R & 31)) : R;
        voffA[i] = (unsigned)(R * K + C) * 2u; voffB[i] = (unsigned)(Rb * K + C) * 2u; }
    const size_t kstep = (size_t)(BK * 2);
    const size_t hstep = (size_t)HALF * K * 2;
    const size_t tstep = 2 * hstep;
    const unsigned ldsw = (unsigned)wid * 1024u;
    const int aoff = lds_byte(wr * 64 + fr, fq * 8), boff = lds_byte(wc * 32 + fr, fq * 8);
#define PG8_SA(b, h) (((b) * 2 + (h)) * HTB)
#define PG8_SB(b, h) ((4 + (b) * 2 + (h)) * HTB)
#define PG8_STAGE(bufoff, gbase, voff) do { _Pragma("unroll") for (int _i = 0; _i < 2; ++_i) \
        __builtin_amdgcn_global_load_lds((const unsigned*)((const char*)(gbase) + (voff)[_i]), (PG8_LAS unsigned*)(lds + (bufoff) + ldsw + _i * 8192), 16, 0, 0); } while (0)
#define PG8_LDA(dst, b, h) do { _Pragma("unroll") for (int m = 0; m < 4; ++m) _Pragma("unroll") for (int k = 0; k < 2; ++k) dst[m][k] = *(const PG8_LAS bf16x8*)(lds + PG8_SA(b, h) + aoff + m * 2048 + k * 1024); } while (0)
#define PG8_LDB(dst, b, h) do { _Pragma("unroll") for (int n = 0; n < 2; ++n) _Pragma("unroll") for (int k = 0; k < 2; ++k) dst[n][k] = *(const PG8_LAS bf16x8*)(lds + PG8_SB(b, h) + boff + n * 2048 + k * 1024); } while (0)
#define PG8_MMA(ai, bj, At, Bt) do { __builtin_amdgcn_s_setprio(1); _Pragma("unroll") for (int m = 0; m < 4; ++m) _Pragma("unroll") for (int n = 0; n < 2; ++n) _Pragma("unroll") for (int k = 0; k < 2; ++k) \
        acc[ai][bj][m][n] = __builtin_amdgcn_mfma_f32_16x16x32_bf16(Bt[n][k], At[m][k], acc[ai][bj][m][n], 0, 0, 0); __builtin_amdgcn_s_setprio(0); } while (0)
#define PG8_WAIT_V(n) asm volatile("s_waitcnt vmcnt(" #n ")" ::: "memory")
#define PG8_WAIT_L(n) asm volatile("s_waitcnt lgkmcnt(" #n ")" ::: "memory")
#define PG8_BAR __builtin_amdgcn_s_barrier()
#define PG8_SCHED __builtin_amdgcn_sched_barrier(0)
    Unit cur, nxt; int ui = 0;
    if (!S.next(0, cur)) return;
    f32x4 acc[2][2][4][2];
#pragma unroll
    for (int a = 0; a < 2; ++a)
#pragma unroll
        for (int b = 0; b < 2; ++b)
#pragma unroll
            for (int m = 0; m < 4; ++m)
#pragma unroll
                for (int n = 0; n < 2; ++n) acc[a][b][m][n] = (f32x4){0.f, 0.f, 0.f, 0.f};
    bf16x8 At[4][2], B0[2][2], B1[2][2];
    const char* cA = (const char*)g.A + (size_t)cur.pm * tstep; const char* cB = (const char*)g.Bt + (size_t)cur.pn * tstep;
    S.a_ready(cur);
    if constexpr (SP2) {
        PG8_STAGE(PG8_SB(0, 0), cB, voffB); PG8_STAGE(PG8_SB(0, 1), cB + hstep, voffB); PG8_STAGE(PG8_SA(0, 0), cA, voffA); PG8_STAGE(PG8_SA(0, 1), cA + hstep, voffA);
        if (wr == 1) PG8_BAR;
        PG8_WAIT_V(2); PG8_BAR;
        PG8_STAGE(PG8_SB(1, 0), cB + kstep, voffB); PG8_STAGE(PG8_SA(1, 0), cA + kstep, voffA); PG8_STAGE(PG8_SB(1, 1), cB + hstep + kstep, voffB);
        PG8_WAIT_V(6); PG8_BAR;
    } else {
        PG8_STAGE(PG8_SB(0, 0), cB, voffB); PG8_STAGE(PG8_SA(0, 0), cA, voffA); PG8_STAGE(PG8_SB(0, 1), cB + hstep, voffB); PG8_STAGE(PG8_SA(0, 1), cA + hstep, voffA);
        if (wr == 1) PG8_BAR;
        PG8_WAIT_V(4); PG8_BAR;
        PG8_STAGE(PG8_SB(1, 0), cB + kstep, voffB); PG8_STAGE(PG8_SA(1, 0), cA + kstep, voffA); PG8_STAGE(PG8_SB(1, 1), cB + hstep + kstep, voffB);
        PG8_WAIT_V(6); PG8_BAR;
    }
    for (;;) {
        const bool has_next = S.next(ui + 1, nxt);
        const char* nA = has_next ? (const char*)g.A + (size_t)nxt.pm * tstep : cA; const char* nB = has_next ? (const char*)g.Bt + (size_t)nxt.pn * tstep : cB;
        for (int t = 0; t < nt; t += 2) {
            const bool last = (t == nt - 2);
            const char* a1 = cA + (size_t)(t + 1) * kstep;
            const char* a2 = last ? nA : cA + (size_t)(t + 2) * kstep; const char* b2 = last ? nB : cB + (size_t)(t + 2) * kstep;
            const char* a3 = a2 + kstep; const char* b3 = b2 + kstep;
            if (last && has_next) S.a_ready(nxt);
            if constexpr (SP2) {
            PG8_LDB(B0, 0, 0); PG8_LDB(B1, 0, 1); PG8_SCHED; PG8_LDA(At, 0, 0); PG8_STAGE(PG8_SA(1, 1), a1 + hstep, voffA);
            PG8_WAIT_V(8); PG8_WAIT_L(0); PG8_BAR; PG8_MMA(0, 0, At, B0); PG8_MMA(0, 1, At, B1); PG8_BAR; PG8_SCHED;
            PG8_LDA(At, 0, 1); PG8_STAGE(PG8_SB(0, 0), b2, voffB); PG8_STAGE(PG8_SB(0, 1), b2 + hstep, voffB); PG8_STAGE(PG8_SA(0, 0), a2, voffA);
            PG8_WAIT_V(8); PG8_WAIT_L(0); PG8_BAR; PG8_MMA(1, 0, At, B0); PG8_MMA(1, 1, At, B1); PG8_BAR; PG8_SCHED;
            PG8_LDB(B0, 1, 0); PG8_LDB(B1, 1, 1); PG8_SCHED; PG8_LDA(At, 1, 0); PG8_STAGE(PG8_SA(0, 1), a2 + hstep, voffA);
            PG8_WAIT_V(8); PG8_WAIT_L(0); PG8_BAR; PG8_MMA(0, 0, At, B0); PG8_MMA(0, 1, At, B1); PG8_BAR; PG8_SCHED;
            PG8_LDA(At, 1, 1); PG8_STAGE(PG8_SB(1, 0), b3, voffB); PG8_STAGE(PG8_SB(1, 1), b3 + hstep, voffB); PG8_STAGE(PG8_SA(1, 0), a3, voffA);
            PG8_WAIT_V(8); PG8_WAIT_L(0); PG8_BAR; PG8_MMA(1, 0, At, B0); PG8_MMA(1, 1, At, B1); PG8_BAR; PG8_SCHED;
            } else {
            PG8_LDB(B0, 0, 0); PG8_SCHED; PG8_LDA(At, 0, 0); PG8_STAGE(PG8_SA(1, 1), a1 + hstep, voffA);
            PG8_WAIT_L(8); PG8_BAR; PG8_WAIT_L(0); PG8_MMA(0, 0, At, B0); PG8_BAR; PG8_SCHED;
            PG8_LDB(B1, 0, 1); PG8_STAGE(PG8_SB(0, 0), b2, voffB);
            PG8_BAR; PG8_WAIT_L(0); PG8_MMA(0, 1, At, B1); PG8_BAR;
            PG8_LDA(At, 0, 1); PG8_STAGE(PG8_SA(0, 0), a2, voffA);
            PG8_BAR; PG8_WAIT_L(0); PG8_MMA(1, 0, At, B0); PG8_BAR; PG8_SCHED;
            PG8_STAGE(PG8_SB(0, 1), b2 + hstep, voffB);
            PG8_WAIT_V(6); PG8_BAR; PG8_MMA(1, 1, At, B1); PG8_BAR;
            PG8_LDB(B0, 1, 0); PG8_SCHED; PG8_LDA(At, 1, 0); PG8_STAGE(PG8_SA(0, 1), a2 + hstep, voffA);
            PG8_WAIT_L(8); PG8_BAR; PG8_WAIT_L(0); PG8_MMA(0, 0, At, B0); PG8_BAR; PG8_SCHED;
            PG8_LDB(B1, 1, 1); PG8_STAGE(PG8_SB(1, 0), b3, voffB);
            PG8_BAR; PG8_WAIT_L(0); PG8_MMA(0, 1, At, B1); PG8_BAR;
            PG8_LDA(At, 1, 1); PG8_STAGE(PG8_SA(1, 0), a3, voffA);
            PG8_BAR; PG8_WAIT_L(0); PG8_MMA(1, 0, At, B0); PG8_BAR; PG8_SCHED;
            PG8_STAGE(PG8_SB(1, 1), b3 + hstep, voffB);
            PG8_WAIT_V(6); PG8_BAR; PG8_MMA(1, 1, At, B1); PG8_BAR;
            }
        }
        if constexpr (ALIGN_EPI) { if (wr == 0) PG8_BAR; }
        if constexpr (!Epi::AFTER_DRAIN) { E(acc, cur, wr, wc, fr, fq); S.done(cur); }
        if (!has_next) break;
#pragma unroll
        for (int a = 0; a < 2; ++a)
#pragma unroll
            for (int b = 0; b < 2; ++b)
#pragma unroll
                for (int m = 0; m < 4; ++m)
#pragma unroll
                    for (int n = 0; n < 2; ++n) acc[a][b][m][n] = (f32x4){0.f, 0.f, 0.f, 0.f};
        cur = nxt; cA = nA; cB = nB; ++ui;
        if constexpr (ALIGN_EPI) { if (wr == 1) PG8_BAR; }
    }
    PG8_WAIT_V(0);
    if constexpr (!ALIGN_EPI) { if (wr == 0) PG8_BAR; }
    PG8_BAR;
    if constexpr (Epi::AFTER_DRAIN) { E.fused(acc, cur, wr, wc, fr, fq, lds, wid, lane); S.done(cur); }
#undef PG8_SA
#undef PG8_SB
#undef PG8_STAGE
#undef PG8_LDA
#undef PG8_LDB
#undef PG8_MMA
#undef PG8_WAIT_V
#undef PG8_WAIT_L
#undef PG8_BAR
#undef PG8_SCHED
}
}
using pg8::bf16_t;
__device__ __forceinline__ void phase_mod(const Params& P, LAS unsigned char* lds) {
    const int ZZ = opq0();
    const int tid = threadIdx.x, lane = tid & 63, w = tid >> 6;
    LAS float* sv = (LAS float*)lds;
    LAS float* red = (LAS float*)(lds + 9 * 1024 * 4);
    for (int i = tid; i < 9 * 1024; i += 512) { const int v = i >> 10, k = i & 1023; const float c = v == 0 ? P.in[ZZ + I_CCTX][k] : P.in[ZZ + I_C][(v - 1) * 1024 + k]; sv[i] = silu_f(c); }
    __syncthreads();
    float* MOD = (float*)(P.ws + ZZ + WS_MOD);
    for (int cgp = blockIdx.x; cgp < 256; cgp += gridDim.x) {
        const int col = cgp * 48 + (lane < 48 ? lane : 0), l = col / 6144, j = col % 6144;
        const float* wp = P.in[ZZ + I_WMOD] + (size_t)l * 1024 * 6144 + j;
        float a[9];
#pragma unroll
        for (int v = 0; v < 9; ++v) a[v] = 0.f;
        const int k0 = w * 128;
#pragma unroll 4
        for (int k = k0; k < k0 + 128; ++k) { const float wv = wp[(size_t)k * 6144];
#pragma unroll
            for (int v = 0; v < 9; ++v) a[v] += sv[v * 1024 + k] * wv; }
        if (lane < 48) {
#pragma unroll
            for (int v = 0; v < 9; ++v) red[(w * 9 + v) * 48 + lane] = a[v]; }
        __syncthreads();
        if (tid < 432) { const int v = tid / 48, ln = tid % 48; float s = 0.f;
#pragma unroll
            for (int ww = 0; ww < 8; ++ww) s += red[(ww * 9 + v) * 48 + ln];
            const int c2 = cgp * 48 + ln, l2 = c2 / 6144, j2 = c2 % 6144;
            MOD[(size_t)(l2 * 9 + v) * 6144 + j2] = s + P.in[ZZ + I_BMOD][l2 * 6144 + j2]; }
        __syncthreads();
    }
}

__device__ __forceinline__ void transpose_item(const float* W, int ldw, int srccol0, bf16_t* WT, int K, int n0, int k0, LAS float* scr, int lane) {
    if (srccol0 >= 0) {
#pragma unroll 8
        for (int i = 0; i < 32; ++i) { const int kk = 2 * i + (lane >> 5); scr[kk * 33 + (lane & 31)] = W[(size_t)(k0 + kk) * ldw + srccol0 + (lane & 31)]; }
    } else {
#pragma unroll 8
        for (int i = 0; i < 32; ++i) { const int kk = 2 * i + (lane >> 5); scr[kk * 33 + (lane & 31)] = 0.f; }
    }
    LDS_WAIT(); asm volatile("" ::: "memory");
    const int c = lane & 7;
#pragma unroll
    for (int j = 0; j < 4; ++j) { const int n = (lane >> 3) + 8 * j; const LAS float* s = scr + (8 * c) * 33 + n;
        u32x4 o; o.x = cvt_pk_bf16(s[0 * 33], s[1 * 33]); o.y = cvt_pk_bf16(s[2 * 33], s[3 * 33]); o.z = cvt_pk_bf16(s[4 * 33], s[5 * 33]); o.w = cvt_pk_bf16(s[6 * 33], s[7 * 33]);
        *(u32x4*)(WT + (size_t)(n0 + n) * K + k0 + 8 * c) = o; }
    LDS_WAIT(); asm volatile("" ::: "memory");
}
__device__ __forceinline__ int win_srccol(int n0) { return n0 < 3872 ? n0 : -1; }
__device__ __forceinline__ void norm_mod_row(const float* xrow, const float* g, const float* sh, const float* sc, bf16_t* orow, int lane) {
    const f32x4* xr = (const f32x4*)xrow + lane;
    f32x4 v[4]; float s = 0.f;
#pragma unroll
    for (int j = 0; j < 4; ++j) { v[j] = xr[64 * j]; s += (v[j][0] * v[j][0] + v[j][1] * v[j][1]) + (v[j][2] * v[j][2] + v[j][3] * v[j][3]); }
    const float rstd = 1.0f / sqrtf(wave_sum(s) * (1.0f / 1024.0f) + 1e-6f);
    unsigned long long* o8 = (unsigned long long*)orow + lane;
#pragma unroll
    for (int j = 0; j < 4; ++j) { const f32x4 gg = ((const f32x4*)g)[lane + 64 * j], s1 = ((const f32x4*)sc)[lane + 64 * j], s0 = ((const f32x4*)sh)[lane + 64 * j];
        f32x4 y = (v[j] * rstd * gg) * (s1 + 1.0f) + s0;
        o8[64 * j] = (unsigned long long)cvt_pk_bf16(y[0], y[1]) | ((unsigned long long)cvt_pk_bf16(y[2], y[3]) << 32); }
}
__device__ __forceinline__ void h1_rows(const Params& P, int l, int gw, int NGW, int lane) {
    const int ZZ = opq0();
    const float* MOD = (const float*)(P.ws + ZZ + WS_MOD) + (size_t)l * 9 * 6144;
    bf16_t* H = (bf16_t*)(P.ws + ZZ + WS_H);
    for (int m = gw; m < MTOK; m += NGW) { const float* md = MOD + (size_t)mod_index(m) * 6144;
        norm_mod_row(xrow_ptr(P, ZZ, l, m), P.in[ZZ + I_N1G] + l * 1024, md, md + 1024, H + (size_t)m * 1024, lane); }
}
__device__ __forceinline__ void phase_p0(const Params& P, int l, LAS unsigned char* lds) {
    const int ZZ = opq0();
    const int tid = threadIdx.x, lane = tid & 63, w = tid >> 6;
    LAS float* scr = (LAS float*)(lds + w * 8704);
    const int gw = blockIdx.x * 8 + w, NGW = gridDim.x * 8;
    constexpr int I0 = 2048, I1 = I0 + 1536, I2 = I1 + 256, I3 = I2 + 512, I4 = I3 + 512, I5 = I4 + 2048, I6 = I5 + 2048;
    unsigned char* ws = P.ws + ZZ;
    for (int it = gw; it < I6; it += NGW) {
        if (it < I0) { const int kb = it / 128, nb = it % 128; transpose_item(P.in[ZZ + I_WIN] + (size_t)l * 1024 * INC, INC, win_srccol(nb * 32), (bf16_t*)(ws + WS_WIN), 1024, nb * 32, kb * 64, scr, lane); }
        else if (it < I1) { const int r = it - I0, kb = r / 96, nb = r % 96; transpose_item(P.in[ZZ + I_WIN] + (size_t)l * 1024 * INC, INC, 3872 + nb * 32, (bf16_t*)(ws + WS_WG), 1024, nb * 32, kb * 64, scr, lane); }
        else if (it < I2) { const int r = it - I1, kb = r / 32, nb = r % 32; transpose_item(P.in[ZZ + I_WAO] + (size_t)l * 512 * 1024, 1024, nb * 32, (bf16_t*)(ws + WS_WATT), 512, nb * 32, kb * 64, scr, lane); }
        else if (it < I3) { const int r = it - I2, kb = r / 32, nb = r % 32; transpose_item(P.in[ZZ + I_WSO] + (size_t)l * 1024 * 1024, 1024, nb * 32, (bf16_t*)(ws + WS_WSSD), 1024, nb * 32, kb * 64, scr, lane); }
        else if (it < I4) { const int r = it - I3, kb = r / 32, nb = r % 32; transpose_item(P.in[ZZ + I_WOUT] + (size_t)l * 1024 * 1024, 1024, nb * 32, (bf16_t*)(ws + WS_WOUT), 1024, nb * 32, kb * 64, scr, lane); }
        else if (it < I5) { const int r = it - I4, kb = r / 128, nb = r % 128; transpose_item(P.in[ZZ + I_WM1] + (size_t)l * 1024 * 4096, 4096, nb * 32, (bf16_t*)(ws + WS_WM1), 1024, nb * 32, kb * 64, scr, lane); }
        else { const int r = it - I5, kb = r / 32, nb = r % 32; transpose_item(P.in[ZZ + I_WM2] + (size_t)l * 4096 * 1024, 1024, nb * 32, (bf16_t*)(ws + WS_WM2), 4096, nb * 32, kb * 64, scr, lane); }
    }
    for (int tk = gw; tk < 1024; tk += NGW) {
        const int c0 = (tk >> 4) * 8, n = (tk & 15) * 64 + lane, g = c0 >> 7, cc0 = c0 & 127;
        const float* wo = P.in[ZZ + I_WPO] + (size_t)l * 512 * 1024 + (size_t)(g * 128) * 1024 + n;
        const float* sc = P.in[ZZ + I_POOLS] + l * 512 + g * 128;
        const float* pw = P.in[ZZ + I_POOLW] + ((size_t)(l * 4 + g) * 128 + cc0) * 128;
        float a[8];
#pragma unroll
        for (int j = 0; j < 8; ++j) a[j] = 0.f;
#pragma unroll 4
        for (int d = 0; d < 128; ++d) { const float wv = wo[(size_t)d * 1024] * sc[d];
#pragma unroll
            for (int j = 0; j < 8; ++j) a[j] += pw[j * 128 + d] * wv; }
        u32x4 o; o.x = cvt_pk_bf16(a[0], a[1]); o.y = cvt_pk_bf16(a[2], a[3]); o.z = cvt_pk_bf16(a[4], a[5]); o.w = cvt_pk_bf16(a[6], a[7]);
        *(u32x4*)((bf16_t*)(ws + WS_WPOOL) + (size_t)n * 512 + c0) = o;
    }
    for (int tk = gw; tk < 2048; tk += NGW) {
        const int which = tk >> 10, idx = (tk & 1023) * 512 + lane * 8, b = idx >> 16, rem = idx & 65535;
        const float* src = P.in[ZZ + which ? I_CV : I_CK] + (size_t)(b * 2 + l) * 65536 + rem;
        const f32x4 a = *(const f32x4*)src, c = *(const f32x4*)(src + 4);
        u32x4 o; o.x = cvt_pk_bf16(a[0], a[1]); o.y = cvt_pk_bf16(a[2], a[3]); o.z = cvt_pk_bf16(c[0], c[1]); o.w = cvt_pk_bf16(c[2], c[3]);
        *(u32x4*)((bf16_t*)(ws + (which ? WS_CV : WS_CK)) + idx) = o;
    }
    h1_rows(P, l, gw, NGW, lane);
}

__device__ __forceinline__ float rope_inv(int i) { return exp2f(-(float)i * 0.83048202372184058696f); }
__device__ __forceinline__ void attn_unit(const Params& P, int l, LAS unsigned char* lds, int unit) {
    const int ZZ = opq0();
    const int tid = threadIdx.x, lane = tid & 63, w = tid >> 6, g = lane >> 4, li = lane & 15;
    bf16_t* Qb = (bf16_t*)(P.ws + ZZ + WS_Q);
    const bf16_t* KVb = (const bf16_t*)(P.ws + ZZ + WS_KV);
    const bf16_t* CKb = (const bf16_t*)(P.ws + ZZ + WS_CK);
    const bf16_t* CVb = (const bf16_t*)(P.ws + ZZ + WS_CV);
    int lat, b, h, qb;
    if (unit < 1024) { lat = 1; b = unit >> 7; h = (unit >> 4) & 7; qb = unit & 15; }
    else { const int u2 = unit - 1024; lat = 0; b = u2 >> 4; h = (u2 >> 1) & 7; qb = u2 & 1; }
    const int kvh = h >> 2;
    const int row0 = lat ? MCTX + b * LLAT + qb * 128 : b * LCTX + qb * 128;
    const int qrow = row0 + 16 * w + li;
    const int qpos = qb * 128 + 16 * w + li;
    bf16x8 bq[2];
    {
        float qv[2][8]; float ss = 0.f;
#pragma unroll
        for (int ks = 0; ks < 2; ++ks) { const u32x4 raw = *(const u32x4*)(Qb + (size_t)qrow * 512 + h * 64 + 32 * ks + 8 * g);
            qv[ks][0] = bf_lo(raw.x); qv[ks][1] = bf_hi(raw.x); qv[ks][2] = bf_lo(raw.y); qv[ks][3] = bf_hi(raw.y); qv[ks][4] = bf_lo(raw.z); qv[ks][5] = bf_hi(raw.z); qv[ks][6] = bf_lo(raw.w); qv[ks][7] = bf_hi(raw.w);
#pragma unroll
            for (int e = 0; e < 8; ++e) ss += qv[ks][e] * qv[ks][e]; }
        ss += __shfl_xor(ss, 16); ss += __shfl_xor(ss, 32);
        const float rstd = 1.0f / sqrtf(ss * (1.0f / 64.0f) + 1e-6f);
        const float* qg = P.in[ZZ + I_QG] + l * 64;
#pragma unroll
        for (int ks = 0; ks < 2; ++ks)
#pragma unroll
            for (int e = 0; e < 8; ++e) qv[ks][e] = qv[ks][e] * rstd * qg[32 * ks + 8 * g + e];
        if (lat) {
#pragma unroll
            for (int ks = 0; ks < 2; ++ks) { const float pos = (float)(ks == 0 ? (qpos >> 6) : (qpos & 63));
#pragma unroll
                for (int e = 0; e < 8; ++e) { const float ang = pos * rope_inv(8 * (g & 1) + e); const float cs = __cosf(ang), sn = __sinf(ang);
                    const float own = qv[ks][e], oth = __shfl_xor(own, 32);
                    qv[ks][e] = g < 2 ? own * cs - oth * sn : oth * sn + own * cs; } }
        }
#pragma unroll
        for (int ks = 0; ks < 2; ++ks) { u32x4 pk; pk.x = cvt_pk_bf16(qv[ks][0] * 0.125f, qv[ks][1] * 0.125f); pk.y = cvt_pk_bf16(qv[ks][2] * 0.125f, qv[ks][3] * 0.125f);
            pk.z = cvt_pk_bf16(qv[ks][4] * 0.125f, qv[ks][5] * 0.125f); pk.w = cvt_pk_bf16(qv[ks][6] * 0.125f, qv[ks][7] * 0.125f); bq[ks] = __builtin_bit_cast(bf16x8, pk); }
    }
    const float sink = P.in[ZZ + I_SINK][l * 8 + h];
    float m_run = sink, l_run = (g == 0) ? 1.f : 0.f;
    f32x4 o[4];
#pragma unroll
    for (int i = 0; i < 4; ++i) o[i] = (f32x4){0.f, 0.f, 0.f, 0.f};
    const int ntiles = lat ? 14 : 4;
    const bool wr_k = (!lat) && qb == 0 && (h & 3) == 0;
    for (int t = 0; t < ntiles; ++t) {
        const bf16_t *kp, *vp; int stride; int kpos0 = 0; bool masked = false, rawk = true;
        if (!lat) { kp = KVb + (size_t)(b * LCTX + 64 * t) * 256 + kvh * 64; vp = kp + 128; stride = 256; }
        else if (t < 8) { kp = CKb + (size_t)(b * PAST + 64 * t) * 128 + kvh * 64; vp = CVb + (size_t)(b * PAST + 64 * t) * 128 + kvh * 64; stride = 128; rawk = false; }
        else { const int blk = qb - 1 + ((t - 8) >> 1); if (blk < 0 || blk > 15) continue; kpos0 = blk * 128 + ((t - 8) & 1) * 64;
            kp = KVb + (size_t)(MCTX + b * LLAT + kpos0) * 256 + kvh * 64; vp = kp + 128; stride = 256; masked = true; }
        __syncthreads();
        if (tid >= 256) {
            const int t2 = tid - 256;
#pragma unroll
            for (int i = 0; i < 2; ++i) { const int idx = t2 + 256 * i, key = idx >> 3, ch = idx & 7;
                u32x4 v = *(const u32x4*)(kp + (size_t)key * stride + ch * 8);
                if (rawk) {
                    float kv[8] = {bf_lo(v.x), bf_hi(v.x), bf_lo(v.y), bf_hi(v.y), bf_lo(v.z), bf_hi(v.z), bf_lo(v.w), bf_hi(v.w)};
                    float ss = 0.f;
#pragma unroll
                    for (int e = 0; e < 8; ++e) ss += kv[e] * kv[e];
                    ss += __shfl_xor(ss, 1); ss += __shfl_xor(ss, 2); ss += __shfl_xor(ss, 4);
                    const float rstd = 1.0f / sqrtf(ss * (1.0f / 64.0f) + 1e-6f);
                    const float* kg = P.in[ZZ + I_KG] + l * 64 + 8 * ch;
#pragma unroll
                    for (int e = 0; e < 8; ++e) kv[e] = kv[e] * rstd * kg[e];
                    if (wr_k) { float* ok = P.out + ZZ + OUT_CK + ((size_t)((b * 2 + l) * 256 + 64 * t + key)) * 128 + kvh * 64 + 8 * ch;
                        *(f32x4*)ok = (f32x4){kv[0], kv[1], kv[2], kv[3]}; *(f32x4*)(ok + 4) = (f32x4){kv[4], kv[5], kv[6], kv[7]}; }
                    if (lat) {
                        const int kpos = kpos0 + key; const float pos = (float)((ch >> 2) == 0 ? (kpos >> 6) : (kpos & 63));
#pragma unroll
                        for (int e = 0; e < 8; ++e) { const float ang = pos * rope_inv(8 * (ch & 1) + e); const float cs = __cosf(ang), sn = __sinf(ang);
                            const float own = kv[e], oth = __shfl_xor(own, 2);
                            kv[e] = (ch & 2) == 0 ? own * cs - oth * sn : oth * sn + own * cs; }
                    }
                    v.x = cvt_pk_bf16(kv[0], kv[1]); v.y = cvt_pk_bf16(kv[2], kv[3]); v.z = cvt_pk_bf16(kv[4], kv[5]); v.w = cvt_pk_bf16(kv[6], kv[7]);
                }
                *(LAS u32x4*)(lds + key * 128 + ((ch ^ (key & 7)) << 4)) = v; }
        } else {
            const int dp = tid & 31, kb = tid >> 5; unsigned vv[8];
#pragma unroll
            for (int j = 0; j < 8; ++j) vv[j] = *(const unsigned*)(vp + (size_t)(8 * kb + j) * stride + 2 * dp);
            u32x4 lo, hi;
            lo.x = (vv[0] & 0xffffu) | (vv[1] << 16); lo.y = (vv[2] & 0xffffu) | (vv[3] << 16); lo.z = (vv[4] & 0xffffu) | (vv[5] << 16); lo.w = (vv[6] & 0xffffu) | (vv[7] << 16);
            hi.x = (vv[0] >> 16) | (vv[1] & 0xffff0000u); hi.y = (vv[2] >> 16) | (vv[3] & 0xffff0000u); hi.z = (vv[4] >> 16) | (vv[5] & 0xffff0000u); hi.w = (vv[6] >> 16) | (vv[7] & 0xffff0000u);
            const int d0 = 2 * dp, d1 = d0 + 1;
            *(LAS u32x4*)(lds + 8192 + d0 * 128 + ((kb ^ (d0 & 7)) << 4)) = lo;
            *(LAS u32x4*)(lds + 8192 + d1 * 128 + ((kb ^ (d1 & 7)) << 4)) = hi;
        }
        __syncthreads();
        f32x4 s[4];
#pragma unroll
        for (int mt = 0; mt < 4; ++mt) { s[mt] = (f32x4){0.f, 0.f, 0.f, 0.f}; const int key = 16 * mt + li;
#pragma unroll
            for (int ks = 0; ks < 2; ++ks) { const int ch = 4 * ks + g;
                const bf16x8 a = *(const LAS bf16x8*)(lds + key * 128 + ((ch ^ (key & 7)) << 4));
                s[mt] = __builtin_amdgcn_mfma_f32_16x16x32_bf16(a, bq[ks], s[mt], 0, 0, 0); } }
        if (masked) {
#pragma unroll
            for (int mt = 0; mt < 4; ++mt)
#pragma unroll
                for (int r = 0; r < 4; ++r) { const int kpos = kpos0 + 16 * mt + 4 * g + r; const int df = qpos - kpos; if (df > 128 || df < -128) s[mt][r] = -INFINITY; }
        }
        float mx = -INFINITY;
#pragma unroll
        for (int mt = 0; mt < 4; ++mt) mx = fmaxf(mx, fmaxf(fmaxf(s[mt][0], s[mt][1]), fmaxf(s[mt][2], s[mt][3])));
        mx = fmaxf(mx, __shfl_xor(mx, 16)); mx = fmaxf(mx, __shfl_xor(mx, 32));
        const float m_new = fmaxf(m_run, mx), alpha = __expf(m_run - m_new);
        m_run = m_new; l_run *= alpha;
#pragma unroll
        for (int i = 0; i < 4; ++i) o[i] = o[i] * alpha;
        float ps = 0.f;
#pragma unroll
        for (int mt = 0; mt < 4; ++mt)
#pragma unroll
            for (int r = 0; r < 4; ++r) { s[mt][r] = __expf(s[mt][r] - m_new); ps += s[mt][r]; }
        l_run += ps;
        bf16x8 bp[2];
#pragma unroll
        for (int s2 = 0; s2 < 2; ++s2) { u32x4 pk; pk.x = cvt_pk_bf16(s[2 * s2][0], s[2 * s2][1]); pk.y = cvt_pk_bf16(s[2 * s2][2], s[2 * s2][3]);
            pk.z = cvt_pk_bf16(s[2 * s2 + 1][0], s[2 * s2 + 1][1]); pk.w = cvt_pk_bf16(s[2 * s2 + 1][2], s[2 * s2 + 1][3]); bp[s2] = __builtin_bit_cast(bf16x8, pk); }
#pragma unroll
        for (int dt = 0; dt < 4; ++dt) { const int d = 16 * dt + li;
#pragma unroll
            for (int s2 = 0; s2 < 2; ++s2) {
                const u32x2 lo8 = *(const LAS u32x2*)(lds + 8192 + d * 128 + (((4 * s2 + (g >> 1)) ^ (d & 7)) << 4) + 8 * (g & 1));
                const u32x2 hi8 = *(const LAS u32x2*)(lds + 8192 + d * 128 + (((4 * s2 + 2 + (g >> 1)) ^ (d & 7)) << 4) + 8 * (g & 1));
                u32x4 av; av.x = lo8.x; av.y = lo8.y; av.z = hi8.x; av.w = hi8.y;
                o[dt] = __builtin_amdgcn_mfma_f32_16x16x32_bf16(__builtin_bit_cast(bf16x8, av), bp[s2], o[dt], 0, 0, 0); } }
    }
    l_run += __shfl_xor(l_run, 16); l_run += __shfl_xor(l_run, 32);
    const float inv = 1.0f / l_run;
#pragma unroll
    for (int dt = 0; dt < 4; ++dt) { const f32x4 x = o[dt] * inv; u32x2 wv; wv.x = cvt_pk_bf16(x[0], x[1]); wv.y = cvt_pk_bf16(x[2], x[3]);
        *(u32x2*)(Qb + (size_t)qrow * 512 + h * 64 + 16 * dt + 4 * g) = wv; }
}
__device__ __forceinline__ void bc_conv(const Params& P, int l) {
    const int ZZ = opq0();
    const bf16_t* X = (const bf16_t*)(P.ws + ZZ + WS_XBC);
    bf16_t* BC = (bf16_t*)(P.ws + ZZ + WS_BC);
    const float* cw = P.in[ZZ + I_CONVW] + (size_t)l * 5 * 1536 + 1024;
    const float* cb = P.in[ZZ + I_CONVB] + (size_t)l * 1536 + 1024;
    const int nthr = gridDim.x * 512;
    for (int task = blockIdx.x * 512 + threadIdx.x; task < (MTOK / 4) * 256; task += nthr) {
        const int cp = task & 255, r4 = task >> 8, row = r4 * 4, c = 2 * cp;
        int t, L; if (row < MCTX) { t = row & 255; L = LCTX; } else { t = (row - MCTX) & 2047; L = LLAT; }
        float raw0[8], raw1[8];
#pragma unroll
        for (int i = 0; i < 8; ++i) { const int tt = t - 2 + i; unsigned u = 0u; if (tt >= 0 && tt < L) u = *(const unsigned*)(X + (size_t)(row - 2 + i) * 1536 + 1024 + c); raw0[i] = bf_lo(u); raw1[i] = bf_hi(u); }
        float w0[5], w1[5];
#pragma unroll
        for (int j = 0; j < 5; ++j) { w0[j] = cw[j * 1536 + c]; w1[j] = cw[j * 1536 + c + 1]; }
        const float b0 = cb[c], b1 = cb[c + 1];
#pragma unroll
        for (int i = 0; i < 4; ++i) { float a0 = b0, a1 = b1;
#pragma unroll
            for (int j = 0; j < 5; ++j) { a0 += w0[j] * raw0[i + j]; a1 += w1[j] * raw1[i + j]; }
            *(unsigned*)(BC + (size_t)(row + i) * 512 + c) = cvt_pk_bf16(silu_f(a0), silu_f(a1)); }
    }
}
__device__ __forceinline__ void phase_attn(const Params& P, int l, LAS unsigned char* lds) {
    for (int u = blockIdx.x; u < 1536; u += gridDim.x) attn_unit(P, l, lds, u);
    bc_conv(P, l);
}

__device__ __forceinline__ void ssd_unit(const Params& P, int l, LAS unsigned char* lds, int lat, int b, int h, int dir) {
    const int ZZ = opq0();
    const int tid = threadIdx.x, p = tid >> 3, ns = tid & 7;
    const int L = lat ? LLAT : LCTX, row0 = lat ? MCTX + b * LLAT : b * LCTX, grp = h >> 3;
    const float A = -__expf(P.in[ZZ + I_ALOG][l * 32 + dir * 16 + h]);
    const float Dsk = P.in[ZZ + I_DSKIP][l * 16 + h];
    const float dtbias = P.in[ZZ + I_DTB][l * 32 + dir * 16 + h];
    const bf16_t* X = (const bf16_t*)(P.ws + ZZ + WS_XBC);
    const bf16_t* BC = (const bf16_t*)(P.ws + ZZ + WS_BC);
    const float* DT = (const float*)(P.ws + ZZ + WS_DT);
    bf16_t* Y = (bf16_t*)(P.ws + ZZ + WS_H);
    bf16_t* Z = (bf16_t*)(P.ws + ZZ + WS_Z);
    LAS float* xs = (LAS float*)lds;
    LAS float* Bs = (LAS float*)(lds + 16384);
    LAS float* Cs = (LAS float*)(lds + 49152);
    LAS float* yb = (LAS float*)(lds + 81920);
    LAS float* dts = (LAS float*)(lds + 98304);
    LAS float* das = (LAS float*)(lds + 98304 + 256);
    float S[16];
    if (lat) { const float* sp = P.in[ZZ + I_ST] + ((size_t)((((b * 2 + l) * 2 + dir) * 16 + h) * 64 + p)) * 128 + ns * 16;
#pragma unroll
        for (int i = 0; i < 4; ++i) { const f32x4 v = *(const f32x4*)(sp + 4 * i); S[4 * i] = v[0]; S[4 * i + 1] = v[1]; S[4 * i + 2] = v[2]; S[4 * i + 3] = v[3]; } }
    else {
#pragma unroll
        for (int i = 0; i < 16; ++i) S[i] = 0.f; }
    const float* cw = P.in[ZZ + I_CONVW] + (size_t)l * 5 * 1536 + h * 64;
    const float* cb = P.in[ZZ + I_CONVB] + (size_t)l * 1536 + h * 64;
    const int nck = L / 64;
    for (int ck = 0; ck < nck; ++ck) {
        const int t0 = dir == 0 ? ck * 64 : L - 64 - ck * 64;
        __syncthreads();
        {
            const int tt = tid >> 3, c0 = (tid & 7) * 16; const bf16_t* src = BC + (size_t)(row0 + t0 + tt) * 512 + grp * 128 + c0;
#pragma unroll
            for (int hf = 0; hf < 2; ++hf) { const u32x4 bq = *(const u32x4*)(src + hf * 8), cq = *(const u32x4*)(src + 256 + hf * 8);
                *(LAS f32x4*)(Bs + tt * 128 + c0 + hf * 8) = (f32x4){bf_lo(bq.x), bf_hi(bq.x), bf_lo(bq.y), bf_hi(bq.y)};
                *(LAS f32x4*)(Bs + tt * 128 + c0 + hf * 8 + 4) = (f32x4){bf_lo(bq.z), bf_hi(bq.z), bf_lo(bq.w), bf_hi(bq.w)};
                *(LAS f32x4*)(Cs + tt * 128 + c0 + hf * 8) = (f32x4){bf_lo(cq.x), bf_hi(cq.x), bf_lo(cq.y), bf_hi(cq.y)};
                *(LAS f32x4*)(Cs + tt * 128 + c0 + hf * 8 + 4) = (f32x4){bf_lo(cq.z), bf_hi(cq.z), bf_lo(cq.w), bf_hi(cq.w)}; }
        }
        if (tid < 64) { const float xr = DT[(size_t)(row0 + t0 + tid) * 32 + dir * 16 + h] + dtbias; const float dtv = fmaxf(xr, 0.f) + log1pf(__expf(-fabsf(xr))); dts[tid] = dtv; das[tid] = __expf(dtv * A); }
        {
            const int p2 = tid & 31, tr = tid >> 5, c = 2 * p2, tl = 4 * tr;
            float raw0[8], raw1[8];
#pragma unroll
            for (int i = 0; i < 8; ++i) { const int tt = t0 + tl - 2 + i; unsigned u = 0u; if (tt >= 0 && tt < L) u = *(const unsigned*)(X + (size_t)(row0 + tt) * 1536 + h * 64 + c); raw0[i] = bf_lo(u); raw1[i] = bf_hi(u); }
            float w0[5], w1[5];
#pragma unroll
            for (int j = 0; j < 5; ++j) { w0[j] = cw[j * 1536 + c]; w1[j] = cw[j * 1536 + c + 1]; }
            const float b0 = cb[c], b1 = cb[c + 1];
#pragma unroll
            for (int i = 0; i < 4; ++i) { float a0 = b0, a1 = b1;
#pragma unroll
                for (int j = 0; j < 5; ++j) { a0 += w0[j] * raw0[i + j]; a1 += w1[j] * raw1[i + j]; }
                *(LAS f32x2*)(xs + (tl + i) * 64 + c) = (f32x2){silu_f(a0), silu_f(a1)}; }
        }
        __syncthreads();
        for (int st = 0; st < 64; ++st) {
            const int tt = dir == 0 ? st : 63 - st;
            const float da = das[tt], dx = dts[tt] * xs[tt * 64 + p];
            float yp = 0.f;
#pragma unroll
            for (int i = 0; i < 4; ++i) { const f32x4 bv = *(const LAS f32x4*)(Bs + tt * 128 + ns * 16 + 4 * i), cv = *(const LAS f32x4*)(Cs + tt * 128 + ns * 16 + 4 * i);
#pragma unroll
                for (int e = 0; e < 4; ++e) { S[4 * i + e] = S[4 * i + e] * da + dx * bv[e]; yp += cv[e] * S[4 * i + e]; } }
            yp += __shfl_xor(yp, 1); yp += __shfl_xor(yp, 2); yp += __shfl_xor(yp, 4);
            if (ns == 0) yb[tt * 64 + p] = yp;
        }
        __syncthreads();
        {
            const int tt = tid >> 3, p0 = (tid & 7) * 8; const size_t off = (size_t)(row0 + t0 + tt) * 1024 + h * 64 + p0;
            const f32x4 ya = *(const LAS f32x4*)(yb + tt * 64 + p0), yc = *(const LAS f32x4*)(yb + tt * 64 + p0 + 4);
            float yv[8] = {ya[0], ya[1], ya[2], ya[3], yc[0], yc[1], yc[2], yc[3]};
            if (dir == 0) {
                u32x4 o; o.x = cvt_pk_bf16(yv[0], yv[1]); o.y = cvt_pk_bf16(yv[2], yv[3]); o.z = cvt_pk_bf16(yv[4], yv[5]); o.w = cvt_pk_bf16(yv[6], yv[7]);
                *(u32x4*)(Y + off) = o;
            } else {
                const u32x4 yq = *(const u32x4*)(Y + off), zq = *(const u32x4*)(Z + off);
                const f32x4 xa = *(const LAS f32x4*)(xs + tt * 64 + p0), xc = *(const LAS f32x4*)(xs + tt * 64 + p0 + 4);
                const float yf[8] = {bf_lo(yq.x), bf_hi(yq.x), bf_lo(yq.y), bf_hi(yq.y), bf_lo(yq.z), bf_hi(yq.z), bf_lo(yq.w), bf_hi(yq.w)};
                const float zf[8] = {bf_lo(zq.x), bf_hi(zq.x), bf_lo(zq.y), bf_hi(zq.y), bf_lo(zq.z), bf_hi(zq.z), bf_lo(zq.w), bf_hi(zq.w)};
                const float xf[8] = {xa[0], xa[1], xa[2], xa[3], xc[0], xc[1], xc[2], xc[3]};
                float r[8];
#pragma unroll
                for (int e = 0; e < 8; ++e) r[e] = (yf[e] + yv[e] + Dsk * xf[e]) * silu_f(zf[e]);
                u32x4 o; o.x = cvt_pk_bf16(r[0], r[1]); o.y = cvt_pk_bf16(r[2], r[3]); o.z = cvt_pk_bf16(r[4], r[5]); o.w = cvt_pk_bf16(r[6], r[7]);
                *(u32x4*)(Z + off) = o;
            }
        }
    }
    if (!lat) { float* sp = P.out + ZZ + OUT_ST + ((size_t)((((b * 2 + l) * 2 + dir) * 16 + h) * 64 + p)) * 128 + ns * 16;
#pragma unroll
        for (int i = 0; i < 4; ++i) *(f32x4*)(sp + 4 * i) = (f32x4){S[4 * i], S[4 * i + 1], S[4 * i + 2], S[4 * i + 3]}; }
}
__device__ __forceinline__ void phase_ssd(const Params& P, int l, LAS unsigned char* lds, int dir) {
    for (int u = blockIdx.x; u < 640; u += gridDim.x) {
        if (u < 128) ssd_unit(P, l, lds, 1, u >> 4, u & 15, dir);
        else { const int u2 = u - 128; ssd_unit(P, l, lds, 0, u2 >> 4, u2 & 15, dir); }
    }
}

__device__ __forceinline__ void phase_fin(const Params& P, int l) {
    const int ZZ = opq0();
    const int tid = threadIdx.x, lane = tid & 63, w = tid >> 6;
    const int gw = blockIdx.x * 8 + w, NGW = gridDim.x * 8;
    bf16_t* Z = (bf16_t*)(P.ws + ZZ + WS_Z);
    const bf16_t* PU = (const bf16_t*)(P.ws + ZZ + WS_PU);
    bf16_t* PO = (bf16_t*)(P.ws + ZZ + WS_POOLED);
    const float* sg = P.in[ZZ + I_SSDG] + l * 1024;
    for (int m = gw; m < MTOK; m += NGW) {
        {
            u32x4* zr = (u32x4*)(Z + (size_t)m * 1024);
            const u32x4 q0 = zr[lane], q1 = zr[lane + 64];
            float v[16] = {bf_lo(q0.x), bf_hi(q0.x), bf_lo(q0.y), bf_hi(q0.y), bf_lo(q0.z), bf_hi(q0.z), bf_lo(q0.w), bf_hi(q0.w),
                           bf_lo(q1.x), bf_hi(q1.x), bf_lo(q1.y), bf_hi(q1.y), bf_lo(q1.z), bf_hi(q1.z), bf_lo(q1.w), bf_hi(q1.w)};
            float s = 0.f;
#pragma unroll
            for (int e = 0; e < 16; ++e) s += v[e] * v[e];
            const float rstd = 1.0f / sqrtf(wave_sum(s) * (1.0f / 1024.0f) + 1e-6f);
            const f32x4 g0 = *(const f32x4*)(sg + lane * 8), g1 = *(const f32x4*)(sg + lane * 8 + 4), g2 = *(const f32x4*)(sg + 512 + lane * 8), g3 = *(const f32x4*)(sg + 512 + lane * 8 + 4);
            const float gg[16] = {g0[0], g0[1], g0[2], g0[3], g1[0], g1[1], g1[2], g1[3], g2[0], g2[1], g2[2], g2[3], g3[0], g3[1], g3[2], g3[3]};
#pragma unroll
            for (int e = 0; e < 16; ++e) v[e] = v[e] * rstd * gg[e];
            u32x4 o0, o1;
            o0.x = cvt_pk_bf16(v[0], v[1]); o0.y = cvt_pk_bf16(v[2], v[3]); o0.z = cvt_pk_bf16(v[4], v[5]); o0.w = cvt_pk_bf16(v[6], v[7]);
            o1.x = cvt_pk_bf16(v[8], v[9]); o1.y = cvt_pk_bf16(v[10], v[11]); o1.z = cvt_pk_bf16(v[12], v[13]); o1.w = cvt_pk_bf16(v[14], v[15]);
            zr[lane] = o0; zr[lane + 64] = o1;
        }
        {
            int t, L; if (m < MCTX) { t = m & 255; L = LCTX; } else { t = (m - MCTX) & 2047; L = LLAT; }
            const int hw = 1 << (lane >> 4);
            const int lo = t - hw < 0 ? 0 : t - hw, hi = t + hw > L ? L : t + hw;
            float a[8];
#pragma unroll
            for (int e = 0; e < 8; ++e) a[e] = 0.f;
            for (int s = lo; s < hi; ++s) { const u32x4 q = *(const u32x4*)(PU + (size_t)(m - t + s) * 512 + lane * 8);
                a[0] += bf_lo(q.x); a[1] += bf_hi(q.x); a[2] += bf_lo(q.y); a[3] += bf_hi(q.y); a[4] += bf_lo(q.z); a[5] += bf_hi(q.z); a[6] += bf_lo(q.w); a[7] += bf_hi(q.w); }
            const float ic = 1.0f / (float)(hi - lo);
            const u32x4 q = *(const u32x4*)(PU + (size_t)m * 512 + lane * 8);
            const float uu[8] = {bf_lo(q.x), bf_hi(q.x), bf_lo(q.y), bf_hi(q.y), bf_lo(q.z), bf_hi(q.z), bf_lo(q.w), bf_hi(q.w)};
#pragma unroll
            for (int e = 0; e < 8; ++e) a[e] = a[e] * ic - uu[e];
            u32x4 o; o.x = cvt_pk_bf16(a[0], a[1]); o.y = cvt_pk_bf16(a[2], a[3]); o.z = cvt_pk_bf16(a[4], a[5]); o.w = cvt_pk_bf16(a[6], a[7]);
            *(u32x4*)(PO + (size_t)m * 512 + lane * 8) = o;
        }
    }
    h1_rows(P, l, gw, NGW, lane);
}
__device__ __forceinline__ void phase_h2(const Params& P, int l) {
    const int ZZ = opq0();
    const int tid = threadIdx.x, lane = tid & 63, w = tid >> 6;
    const int gw = blockIdx.x * 8 + w, NGW = gridDim.x * 8;
    const float* MOD = (const float*)(P.ws + ZZ + WS_MOD) + (size_t)l * 9 * 6144;
    bf16_t* H = (bf16_t*)(P.ws + ZZ + WS_H);
    for (int m = gw; m < MTOK; m += NGW) { const float* md = MOD + (size_t)mod_index(m) * 6144;
        norm_mod_row(P.out + ZZ + (size_t)m * 1024, P.in[ZZ + I_N2G] + l * 1024, md + 3072, md + 4096, H + (size_t)m * 1024, lane); }
}
#ifndef N_LAUNCHES
#define N_LAUNCHES 1
#endif
#ifndef DEBUG_STAGE
#define DEBUG_STAGE 0
#endif
#define PH_IN(p) (lo <= (p) && (p) < hi)
#ifdef ONLY_CASE
#define PH_ON(k) (((ONLY_CASE) >> (k)) & 1)
#else
#define PH_ON(k) 1
#endif
#define SEAM(p) do { if (PH_IN(p) && PH_IN((p) + 1)) grid.sync(); } while (0)
template <int L>
__device__ __forceinline__ void layer_program(const Params& P, LAS unsigned char* lds, cg::grid_group& grid, const int lo, const int hi) {
    constexpr int B = 1 + NPH_LAYER * L;
    if (PH_ON(0) && PH_IN(B + 0)) phase_p0(P, L, lds);
    SEAM(B + 0);
    if (PH_ON(1) && PH_IN(B + 1)) {
        const int ZZ = opq0(); unsigned char* ws = P.ws + ZZ; float* outp = P.out + ZZ;
        pg8::Gemm g{(const bf16_t*)(ws + WS_H), (const bf16_t*)(ws + WS_WIN), MTOK, 4096, 1024};
        pg8::StaticOrder S; S.init(MTOK, 4096, gridDim.x, blockIdx.x);
        pg8::EpiInProj E{ws, outp + OUT_CV, L};
        pg8::gemm_phase<pg8::EpiInProj, pg8::StaticOrder, true, true>(lds, g, S, E);
    }
    SEAM(B + 1);
    if (PH_ON(2) && PH_IN(B + 2)) phase_attn(P, L, lds);
    SEAM(B + 2);
    if (PH_ON(3) && PH_IN(B + 3)) phase_ssd(P, L, lds, 0);
    SEAM(B + 3);
    if (PH_ON(4) && PH_IN(B + 4)) phase_ssd(P, L, lds, 1);
    SEAM(B + 4);
    if (PH_ON(5) && PH_IN(B + 5)) phase_fin(P, L);
    SEAM(B + 5);
    if (PH_ON(6) && PH_IN(B + 6)) {
#define MERGE_STEP(J, AOFF, BOFF, KK) { \
        { const int ZZ = opq0(); unsigned char* ws = P.ws + ZZ; \
          pg8::Gemm gg{(const bf16_t*)(ws + WS_H), (const bf16_t*)(ws + WS_WG) + (size_t)(J) * 1024 * 1024, MTOK, 1024, 1024}; \
          pg8::StaticOrder S; S.init(MTOK, 1024, gridDim.x, blockIdx.x); \
          pg8::EpiAct<1> Eg{(bf16_t*)(ws + WS_G), 1024}; \
          pg8::gemm_phase<pg8::EpiAct<1>, pg8::StaticOrder, true, true>(lds, gg, S, Eg); } \
        { const int ZZ = opq0(); unsigned char* ws = P.ws + ZZ; \
          pg8::Gemm gv{(const bf16_t*)(ws + (AOFF)), (const bf16_t*)(ws + (BOFF)), MTOK, 1024, (KK)}; \
          pg8::StaticOrder S; S.init(MTOK, 1024, gridDim.x, blockIdx.x); \
          pg8::EpiMerge Em{(const bf16_t*)(ws + WS_G), (bf16_t*)(ws + WS_MERGED), (J) == 0 ? 1 : 0}; \
          pg8::gemm_phase<pg8::EpiMerge, pg8::StaticOrder, true, true>(lds, gv, S, Em); } }
        MERGE_STEP(0, WS_POOLED, WS_WPOOL, 512)
        MERGE_STEP(1, WS_Q, WS_WATT, 512)
        MERGE_STEP(2, WS_Z, WS_WSSD, 1024)
#undef MERGE_STEP
    }
    SEAM(B + 6);
    if (PH_ON(7) && PH_IN(B + 7)) {
        const int ZZ = opq0(); unsigned char* ws = P.ws + ZZ; float* outp = P.out + ZZ;
        const float* MOD = (const float*)(ws + WS_MOD) + (size_t)L * 9 * 6144;
        pg8::Gemm g{(const bf16_t*)(ws + WS_MERGED), (const bf16_t*)(ws + WS_WOUT), MTOK, 1024, 1024};
        pg8::StaticOrder S; S.init(MTOK, 1024, gridDim.x, blockIdx.x);
        pg8::EpiResid E{L == 0 ? P.in[ZZ + I_XP] : outp, L == 0 ? P.in[ZZ + I_XS] : nullptr, outp, MOD + 2048};
        pg8::gemm_phase<pg8::EpiResid, pg8::StaticOrder, true, true>(lds, g, S, E);
    }
    SEAM(B + 7);
    if (PH_ON(8) && PH_IN(B + 8)) phase_h2(P, L);
    SEAM(B + 8);
    if (PH_ON(9) && PH_IN(B + 9)) {
        const int ZZ = opq0(); unsigned char* ws = P.ws + ZZ;
        pg8::Gemm g{(const bf16_t*)(ws + WS_H), (const bf16_t*)(ws + WS_WM1), MTOK, 4096, 1024};
        pg8::StaticOrder S; S.init(MTOK, 4096, gridDim.x, blockIdx.x);
        pg8::EpiAct<2> E{(bf16_t*)(ws + WS_HID), 4096};
        pg8::gemm_phase<pg8::EpiAct<2>, pg8::StaticOrder, true, true>(lds, g, S, E);
    }
    SEAM(B + 9);
    if (PH_ON(10) && PH_IN(B + 10)) {
        const int ZZ = opq0(); unsigned char* ws = P.ws + ZZ; float* outp = P.out + ZZ;
        const float* MOD = (const float*)(ws + WS_MOD) + (size_t)L * 9 * 6144;
        pg8::Gemm g{(const bf16_t*)(ws + WS_HID), (const bf16_t*)(ws + WS_WM2), MTOK, 1024, 4096};
        pg8::StaticOrder S; S.init(MTOK, 1024, gridDim.x, blockIdx.x);
        pg8::EpiResid E{outp, nullptr, outp, MOD + 5120};
        pg8::gemm_phase<pg8::EpiResid, pg8::StaticOrder, true, true>(lds, g, S, E);
    }
    SEAM(B + 10);
}
__global__ void __launch_bounds__(512, 2) fwd_megakernel(Params P) {
    extern __shared__ __attribute__((aligned(16))) unsigned char lds_raw[];
    LAS unsigned char* lds = (LAS unsigned char*)lds_raw;
    cg::grid_group grid = cg::this_grid();
    const int lo = P.ph_lo, hi = P.ph_hi;
    if (PH_ON(20) && PH_IN(0)) phase_mod(P, lds);
    SEAM(0);
    layer_program<0>(P, lds, grid, lo, hi);
    layer_program<1>(P, lds, grid, lo, hi);
}

#if DEBUG_STAGE
__global__ void debug_mask(float* out, int mode, float scale) {
    size_t i = (size_t)blockIdx.x * blockDim.x + threadIdx.x; const size_t stride = (size_t)gridDim.x * blockDim.x;
    for (; i < OUT_TOTAL; i += stride) {
        bool keep = false;
        if (mode == 1) keep = i >= OUT_CV && i < OUT_ST && (((i - OUT_CV) >> 15) & 1) == 0;
        if (mode == 2) keep = i >= OUT_CK && i < OUT_CV && (((i - OUT_CK) >> 15) & 1) == 0;
        if (mode == 3) keep = i >= OUT_ST && (((i - OUT_ST) >> 18) & 1) == 0;
        if (mode == 4) keep = i >= OUT_CK && i < OUT_CV;
        if (mode == 5) keep = i >= OUT_CV && i < OUT_ST;
        if (mode == 6) keep = i >= OUT_ST;
        if (mode == 7) keep = i < (size_t)MCTX * 1024;
        if (mode == 8) keep = i >= (size_t)MCTX * 1024 && i < OUT_CK;
        out[i] = keep ? out[i] * scale : 0.f;
    }
}
#endif

extern "C" void kernel_launch(void* const* d_in, const int* in_sizes, int n_in, void* d_out, int out_size, void* d_ws, size_t ws_size, hipStream_t stream) {
    static int grid = 0;
    if (grid == 0) {
        if (n_in != 29 || out_size != (int)OUT_TOTAL || ws_size < WS_END) { fprintf(stderr, "kernel_launch: unexpected shapes (n_in %d, out %d, ws %zu < %zu); nothing launched\n", n_in, out_size, ws_size, (size_t)WS_END); grid = -1; return; }
        int dev = 0, cus = 0, per_cu = 0;
        hipGetDevice(&dev);
        hipDeviceGetAttribute(&cus, hipDeviceAttributeMultiprocessorCount, dev);
        if (hipFuncSetAttribute((const void*)fwd_megakernel, hipFuncAttributeMaxDynamicSharedMemorySize, LDS_BYTES) != hipSuccess) { fprintf(stderr, "kernel_launch: hipFuncSetAttribute failed\n"); grid = -1; return; }
        if (hipOccupancyMaxActiveBlocksPerMultiprocessor(&per_cu, (const void*)fwd_megakernel, 512, LDS_BYTES) != hipSuccess || per_cu < 1) { fprintf(stderr, "kernel_launch: occupancy query says %d blocks per CU\n", per_cu); grid = -1; return; }
        grid = cus;
    }
    if (grid < 0) return;
    Params p{};
    for (int i = 0; i < 29; ++i) p.in[i] = (const float*)d_in[i];
    p.out = (float*)d_out; p.ws = (unsigned char*)d_ws;
#if DEBUG_STAGE
    const int last_phase = DEBUG_LAST_PHASE;
#else
    const int last_phase = NPHASES;
#endif
#if N_LAUNCHES == 1
    p.ph_lo = 0; p.ph_hi = last_phase;
    { void* args[] = {&p}; hipError_t e = hipLaunchCooperativeKernel((const void*)fwd_megakernel, dim3(grid), dim3(512), args, LDS_BYTES, stream);
      if (e != hipSuccess) fprintf(stderr, "cooperative launch failed: %s (grid %d)\n", hipGetErrorString(e), grid); }
#else
    for (int ph = 0; ph < last_phase; ++ph) {
        p.ph_lo = ph; p.ph_hi = ph + 1;
        void* args[] = {&p}; hipError_t e = hipLaunchCooperativeKernel((const void*)fwd_megakernel, dim3(grid), dim3(512), args, LDS_BYTES, stream);
        if (e != hipSuccess) { fprintf(stderr, "cooperative launch failed: %s (grid %d)\n", hipGetErrorString(e), grid); break; }
    }
#endif
#if DEBUG_STAGE
    debug_mask<<<1024, 256, 0, stream>>>((float*)d_out, DEBUG_STAGE, 4.0f);
#endif
}
```

```cpp
#include <hip/hip_runtime.h>
#include <hip/hip_cooperative_groups.h>
#include <cstdio>
#include <cstdint>
namespace cg = cooperative_groups;

#define LAS __attribute__((address_space(3)))
typedef unsigned short bf16_t;
typedef short bf16x8 __attribute__((ext_vector_type(8)));
typedef float f32x4 __attribute__((ext_vector_type(4)));
typedef float f32x2 __attribute__((ext_vector_type(2)));
typedef unsigned u32x4 __attribute__((ext_vector_type(4)));
typedef unsigned u32x2 __attribute__((ext_vector_type(2)));

constexpr int DM = 1024, MCTX = 8192, MLAT = 16384, MTOK = 24576, LCTX = 256, LLAT = 2048, PAST = 512;
constexpr int INC = 6944;
constexpr int NPH_LAYER = 11, NPHASES = 1 + 2 * NPH_LAYER;
constexpr size_t OUT_CK = 25165824, OUT_CV = 27262976, OUT_ST = 29360128, OUT_TOTAL = 46137344;
constexpr size_t MiB = 1u << 20;
constexpr size_t WS_MOD = 0;
constexpr size_t WS_BAR = 3 * MiB;
constexpr size_t WS_SSQ = 3 * MiB + 256 * 1024;
constexpr size_t OUTB_Y = 48 * MiB;
constexpr size_t WS_CK = 1 * MiB, WS_CV = 2 * MiB;
constexpr size_t WS_WIN = 4 * MiB;
constexpr size_t WS_WG = 12 * MiB;
constexpr size_t WS_WPOOL = 18 * MiB;
constexpr size_t WS_WATT = 19 * MiB;
constexpr size_t WS_WSSD = 20 * MiB;
constexpr size_t WS_WOUT = 22 * MiB;
constexpr size_t WS_WM1 = 24 * MiB;
constexpr size_t WS_WM2 = 32 * MiB;
constexpr size_t WS_X = 40 * MiB;
constexpr size_t WS_Q = 88 * MiB;
constexpr size_t WS_Z = 112 * MiB;
constexpr size_t WS_XBC = 160 * MiB;
constexpr size_t WS_X2 = WS_XBC, WS_BCR = 208 * MiB;
constexpr size_t WS_G8 = WS_XBC;
constexpr size_t WS_PU = 232 * MiB;
constexpr size_t WS_KV = 256 * MiB;
constexpr size_t WS_DT = 268 * MiB;
constexpr size_t WS_DTS = 272 * MiB, WS_CUM2 = 275 * MiB;
constexpr size_t WS_MERGED = WS_PU;
constexpr size_t WS_BC = 280 * MiB;
constexpr size_t WS_POOLED = WS_BCR;
constexpr size_t WS_HID = WS_Q;
constexpr size_t WS_SSQH = 304 * MiB;
constexpr size_t WS_END = 306 * MiB;

constexpr int LDS_GT = 133120;
constexpr int LDS_MISC = 162816;
constexpr int LDS_BYTES = 163840;

struct Params { const float* in[29]; float* out; unsigned char* ws; int ph_lo, ph_hi; };
enum { I_XP = 0, I_XS, I_CK, I_CV, I_ST, I_C, I_CCTX, I_WMOD, I_BMOD, I_N1G, I_N2G, I_WIN, I_POOLW, I_POOLS, I_WPO, I_QG, I_KG, I_SINK, I_WAO,
       I_CONVW, I_CONVB, I_DTB, I_ALOG, I_DSKIP, I_SSDG, I_WSO, I_WOUT, I_WM1, I_WM2 };

__device__ __forceinline__ unsigned cvt_pk_bf16(float lo, float hi) { unsigned r; asm volatile("s_nop 0\n\tv_cvt_pk_bf16_f32 %0, %1, %2" : "=v"(r) : "v"(lo), "v"(hi)); return r; }
typedef __bf16 bf16v2_t __attribute__((ext_vector_type(2)));
__device__ __forceinline__ unsigned cvt_pk_bf16_c(float lo, float hi) { const f32x2 v = {lo, hi}; return __builtin_bit_cast(unsigned, __builtin_convertvector(v, bf16v2_t)); }
__device__ __forceinline__ float bf_lo(unsigned u) { return __uint_as_float(u << 16); }
__device__ __forceinline__ float bf_hi(unsigned u) { return __uint_as_float(u & 0xffff0000u); }
__device__ __forceinline__ float silu_f(float x) { return x * __builtin_amdgcn_rcpf(1.f + __expf(-x)); }
__device__ __forceinline__ float sigmoid_f(float x) { return 1.f / (1.f + __expf(-x)); }
__device__ __forceinline__ float wave_sum(float v) {
#pragma unroll
    for (int o = 1; o < 64; o <<= 1) v += __shfl_xor(v, o);
    return v;
}
__device__ __forceinline__ const float* xrow_ptr0(const Params& P, int ZZ, int row) {
    return row < MCTX ? P.in[ZZ + I_XP] + (size_t)row * DM : P.in[ZZ + I_XS] + (size_t)(row - MCTX) * DM;
}
__device__ __forceinline__ int mod_index(int row) { return row < MCTX ? 0 : 1 + ((row - MCTX) >> 11); }
__device__ __forceinline__ int opq0() { int z = 0; asm volatile("" : "+s"(z)); return z; }
#define LDS_BARRIER() do { asm volatile("s_waitcnt lgkmcnt(0)" ::: "memory"); __builtin_amdgcn_s_barrier(); asm volatile("" ::: "memory"); } while (0)
#define LDS_WAIT() asm volatile("s_waitcnt lgkmcnt(0)" ::: "memory")
namespace pg8 {
#define PG8_LAS __attribute__((address_space(3)))
typedef unsigned short bf16_t;
typedef short bf16x8 __attribute__((ext_vector_type(8)));
typedef float f32x4 __attribute__((ext_vector_type(4)));
typedef unsigned u32x4 __attribute__((ext_vector_type(4)));
constexpr int BM = 256, BK = 64, HALF = 128, HTB = HALF * BK * 2  , STAGE_BYTES = 8 * HTB, NXCD = 8, WGM = 8;

__host__ __device__ __forceinline__ int lds_byte(int r, int c) { const int st = (r >> 4) * 2 + (c >> 5), rr = r & 15, cc = c & 31, ob = rr * 64 + cc * 2; return st * 1024 + (ob ^ (((ob >> 9) & 1) << 5)); }
__host__ __device__ __forceinline__ void stage_rc(int b, int& R, int& C) { const int st = b / 1024, sb = b % 1024, swz = sb ^ (((sb >> 9) & 1) << 5); R = (st >> 1) * 16 + swz / 64; C = (st & 1) * 32 + (swz % 64) / 2; }
__host__ __device__ __forceinline__ int perm32(int rho) { const int n = rho >> 4, i = rho & 15; return 8 * (i >> 2) + 4 * n + (i & 3); }

struct Unit { int pm, pn; };
struct Gemm { const bf16_t* A; const bf16_t* Bt; int M, N, K; };

struct StaticOrder {
    int nM, nN, nwg, G, c;
    __host__ __device__ void init(int M, int N, int G_, int c_, int RT = BM) { nM = M / RT; nN = N / BM; nwg = nM * nN; G = G_; c = c_; }
    __host__ __device__ bool next(int i, Unit& u) const {
        const long L = (long)i * G + c; if (L >= nwg) return false;
        int wgid = (int)L; { const int q = nwg / NXCD, r = nwg % NXCD, xcd = wgid % NXCD, off = wgid / NXCD; wgid = (xcd < r ? xcd * (q + 1) : r * (q + 1) + (xcd - r) * q) + off; }
        const int nig = WGM * nN, gid = wgid / nig, fm = gid * WGM, gsz = (nM - fm) < WGM ? (nM - fm) : WGM;
        u.pm = fm + ((wgid % nig) % gsz); u.pn = (wgid % nig) / gsz; return true;
    }
    __device__ __forceinline__ void a_ready(const Unit&) const {}
    __device__ __forceinline__ void done(const Unit&) const {}
};


struct EpiInProj {
    static constexpr bool PERM = true, AFTER_DRAIN = false; static constexpr int MT = 4;
    unsigned char* ws; float* out_cv; int layer;
    __device__ __forceinline__ void operator()(const f32x4 (&acc)[2][2][4][2], const Unit& u, int wr, int wc, int fr, int fq) const {
        const int pn = u.pn;
        const int row0 = u.pm * BM + wr * 64 + fr, cw = wc * 32 + 8 * fq;
        if (pn == 15) {
            if (wc == 0) { float* D = (float*)(ws + WS_DT);
#pragma unroll
                for (int ai = 0; ai < 2; ++ai)
#pragma unroll
                    for (int m = 0; m < 4; ++m) { float* rp = D + (size_t)(row0 + ai * HALF + m * 16) * 32 + cw; *(f32x4*)rp = acc[ai][0][m][0]; *(f32x4*)(rp + 4) = acc[ai][0][m][1]; } }
            return;
        }
        size_t boff; int ld, colt;
        if (pn < 2) { boff = WS_PU; ld = 512; colt = pn * 256; } else if (pn < 4) { boff = WS_Q; ld = 512; colt = (pn - 2) * 256; } else if (pn == 4) { boff = WS_KV; ld = 256; colt = 0; }
        else if (pn < 9) { boff = WS_Z; ld = 1024; colt = (pn - 5) * 256; } else { boff = WS_BCR; ld = 512; colt = (pn - 13) * 256; }
        if (pn >= 9 && pn < 13) {
#pragma unroll
            for (int ai = 0; ai < 2; ++ai)
#pragma unroll
                for (int m = 0; m < 4; ++m) { const int row = row0 + ai * HALF + m * 16;
#pragma unroll
                    for (int bj = 0; bj < 2; ++bj) { const int head = (pn - 9) * 4 + bj * 2 + (wc >> 1); const f32x4 v0 = acc[ai][bj][m][0], v1 = acc[ai][bj][m][1];
                        u32x4 w; w.x = cvt_pk_bf16_c(v0[0], v0[1]); w.y = cvt_pk_bf16_c(v0[2], v0[3]); w.z = cvt_pk_bf16_c(v1[0], v1[1]); w.w = cvt_pk_bf16_c(v1[2], v1[3]);
                        *(u32x4*)((bf16_t*)(ws + WS_X2) + ((size_t)head * MTOK + row) * 64 + (wc & 1) * 32 + 8 * fq) = w; } }
            return;
        }
        bf16_t* base = (bf16_t*)(ws + boff) + colt + cw;
#pragma unroll
        for (int ai = 0; ai < 2; ++ai)
#pragma unroll
            for (int m = 0; m < 4; ++m) { bf16_t* rowp = base + (size_t)(row0 + ai * HALF + m * 16) * ld;
#pragma unroll
                for (int bj = 0; bj < 2; ++bj) { const f32x4 v0 = acc[ai][bj][m][0], v1 = acc[ai][bj][m][1];
                    u32x4 w; w.x = cvt_pk_bf16_c(v0[0], v0[1]); w.y = cvt_pk_bf16_c(v0[2], v0[3]); w.z = cvt_pk_bf16_c(v1[0], v1[1]); w.w = cvt_pk_bf16_c(v1[2], v1[3]);
                    *(u32x4*)(rowp + bj * HALF) = w; } }
        if (pn == 4 && u.pm < 32) {
#pragma unroll
            for (int ai = 0; ai < 2; ++ai)
#pragma unroll
                for (int m = 0; m < 4; ++m) { const int row = row0 + ai * HALF + m * 16; float* o = out_cv + ((size_t)((row >> 8) * 2 + layer) * 256 + (row & 255)) * 128 + cw;
                    *(f32x4*)o = acc[ai][1][m][0]; *(f32x4*)(o + 4) = acc[ai][1][m][1]; }
        }
    }
};

template <int ACT, int MT_> struct EpiAct {
    static constexpr bool PERM = true, AFTER_DRAIN = false; static constexpr int MT = MT_;
    bf16_t* O; int ldc;
    __device__ __forceinline__ void operator()(const f32x4 (&acc)[2][2][MT_][2], const Unit& u, int wr, int wc, int fr, int fq) const {
        const int row0 = u.pm * (64 * MT_) + wr * (16 * MT_) + fr, col0 = u.pn * BM + wc * 32 + 8 * fq;
#pragma unroll
        for (int ai = 0; ai < 2; ++ai)
#pragma unroll
            for (int m = 0; m < MT_; ++m) { bf16_t* rowp = O + (size_t)(row0 + ai * (32 * MT_) + m * 16) * ldc + col0;
#pragma unroll
                for (int bj = 0; bj < 2; ++bj) { f32x4 v0 = acc[ai][bj][m][0], v1 = acc[ai][bj][m][1];
#pragma unroll
                    for (int e = 0; e < 4; ++e) {
                        if (ACT == 1) { v0[e] = __builtin_amdgcn_rcpf(1.f + __expf(-v0[e])); v1[e] = __builtin_amdgcn_rcpf(1.f + __expf(-v1[e])); }
                        if (ACT == 2) { const float a = fmaxf(v0[e], 0.f), b = fmaxf(v1[e], 0.f); v0[e] = a * a; v1[e] = b * b; } }
                    u32x4 w; w.x = cvt_pk_bf16_c(v0[0], v0[1]); w.y = cvt_pk_bf16_c(v0[2], v0[3]); w.z = cvt_pk_bf16_c(v1[0], v1[1]); w.w = cvt_pk_bf16_c(v1[2], v1[3]);
                    *(u32x4*)(rowp + bj * HALF) = w; } }
    }
};

struct EpiGate8 {
    static constexpr bool PERM = true, AFTER_DRAIN = false; static constexpr int MT = 4;
    unsigned char* G8;
    __device__ __forceinline__ void operator()(const f32x4 (&acc)[2][2][4][2], const Unit& u, int wr, int wc, int fr, int fq) const {
        const int row0 = u.pm * BM + wr * 64 + fr, col0 = u.pn * BM + wc * 32 + 8 * fq;
#pragma unroll
        for (int ai = 0; ai < 2; ++ai)
#pragma unroll
            for (int m = 0; m < 4; ++m) { unsigned char* rowp = G8 + (size_t)(row0 + ai * HALF + m * 16) * 3072 + col0;
#pragma unroll
                for (int bj = 0; bj < 2; ++bj) { const f32x4 v0 = acc[ai][bj][m][0], v1 = acc[ai][bj][m][1];
                    unsigned q[8];
#pragma unroll
                    for (int e = 0; e < 4; ++e) { q[e] = (unsigned)(255.f * __builtin_amdgcn_rcpf(1.f + __expf(-v0[e])) + 0.5f); q[4 + e] = (unsigned)(255.f * __builtin_amdgcn_rcpf(1.f + __expf(-v1[e])) + 0.5f); }
                    u32x2 w; w.x = q[0] | (q[1] << 8) | (q[2] << 16) | (q[3] << 24); w.y = q[4] | (q[5] << 8) | (q[6] << 16) | (q[7] << 24);
                    *(u32x2*)(rowp + bj * HALF) = w; } }
    }
};
template <int MT_> struct EpiMerge {
    static constexpr bool PERM = true, AFTER_DRAIN = false; static constexpr int MT = MT_;
    const unsigned char* G8; bf16_t* MG; int first; const float* ssq;
    __device__ __forceinline__ void operator()(const f32x4 (&acc)[2][2][MT_][2], const Unit& u, int wr, int wc, int fr, int fq) const {
        const int row0 = u.pm * (64 * MT_) + wr * (16 * MT_) + fr, col0 = u.pn * BM + wc * 32 + 8 * fq;
        constexpr float S = 1.0f / 255.0f;
#pragma unroll
        for (int ai = 0; ai < 2; ++ai)
#pragma unroll
            for (int m = 0; m < MT_; ++m) { const int row = row0 + ai * (32 * MT_) + m * 16; const size_t off = (size_t)row * 1024 + col0;
                const float rs = ssq ? S * (1.0f / sqrtf(ssq[row] * (1.0f / 1024.0f) + 1e-6f)) : S;
#pragma unroll
                for (int bj = 0; bj < 2; ++bj) { const f32x4 v0 = acc[ai][bj][m][0], v1 = acc[ai][bj][m][1];
                    const u32x2 gq = *(const u32x2*)(G8 + (size_t)row * 3072 + col0 + bj * HALF);
                    float r[8];
                    r[0] = (float)(gq.x & 255u) * rs * v0[0]; r[1] = (float)((gq.x >> 8) & 255u) * rs * v0[1]; r[2] = (float)((gq.x >> 16) & 255u) * rs * v0[2]; r[3] = (float)(gq.x >> 24) * rs * v0[3];
                    r[4] = (float)(gq.y & 255u) * rs * v1[0]; r[5] = (float)((gq.y >> 8) & 255u) * rs * v1[1]; r[6] = (float)((gq.y >> 16) & 255u) * rs * v1[2]; r[7] = (float)(gq.y >> 24) * rs * v1[3];
                    if (!first) { const u32x4 mq = *(const u32x4*)(MG + off + bj * HALF);
                        r[0] += bf_lo(mq.x); r[1] += bf_hi(mq.x); r[2] += bf_lo(mq.y); r[3] += bf_hi(mq.y); r[4] += bf_lo(mq.z); r[5] += bf_hi(mq.z); r[6] += bf_lo(mq.w); r[7] += bf_hi(mq.w); }
                    u32x4 w; w.x = cvt_pk_bf16_c(r[0], r[1]); w.y = cvt_pk_bf16_c(r[2], r[3]); w.z = cvt_pk_bf16_c(r[4], r[5]); w.w = cvt_pk_bf16_c(r[6], r[7]);
                    *(u32x4*)(MG + off + bj * HALF) = w; } }
    }
};

template <int MT_, bool XIN_BF, bool XOUT_BF> struct EpiResid {
    static constexpr bool PERM = true, AFTER_DRAIN = false; static constexpr int MT = MT_;
    const void *xa, *xb; void* xout; const float* gate; float gscale;
    __device__ __forceinline__ void operator()(const f32x4 (&acc)[2][2][MT_][2], const Unit& u, int wr, int wc, int fr, int fq) const {
        const int row0 = u.pm * (64 * MT_) + wr * (16 * MT_) + fr, col0 = u.pn * BM + wc * 32 + 8 * fq;
#pragma unroll
        for (int ai = 0; ai < 2; ++ai)
#pragma unroll
            for (int m = 0; m < MT_; ++m) { const int row = row0 + ai * (32 * MT_) + m * 16; const size_t off = (size_t)row * 1024 + col0;
                const int mi = row < MCTX ? 0 : 1 + ((row - MCTX) >> 11);
                const float* xin = (xb != nullptr && row >= MCTX) ? (const float*)xb - (size_t)MCTX * 1024 : (const float*)xa;
                const float* gp = gate + (size_t)mi * 6144 + col0;
#pragma unroll
                for (int bj = 0; bj < 2; ++bj) { f32x4 x0, x1;
                    if (XIN_BF) { const u32x4 q = *(const u32x4*)((const bf16_t*)xa + off + bj * HALF);
                        x0 = (f32x4){bf_lo(q.x), bf_hi(q.x), bf_lo(q.y), bf_hi(q.y)}; x1 = (f32x4){bf_lo(q.z), bf_hi(q.z), bf_lo(q.w), bf_hi(q.w)}; }
                    else { x0 = *(const f32x4*)(xin + off + bj * HALF); x1 = *(const f32x4*)(xin + off + bj * HALF + 4); }
                    const f32x4 g0 = *(const f32x4*)(gp + bj * HALF), g1 = *(const f32x4*)(gp + bj * HALF + 4);
                    const f32x4 r0 = x0 + g0 * acc[ai][bj][m][0] * gscale, r1 = x1 + g1 * acc[ai][bj][m][1] * gscale;
                    if (XOUT_BF) { u32x4 w; w.x = cvt_pk_bf16_c(r0[0], r0[1]); w.y = cvt_pk_bf16_c(r0[2], r0[3]); w.z = cvt_pk_bf16_c(r1[0], r1[1]); w.w = cvt_pk_bf16_c(r1[2], r1[3]);
                        *(u32x4*)((bf16_t*)xout + off + bj * HALF) = w; }
                    else { *(f32x4*)((float*)xout + off + bj * HALF) = r0; *(f32x4*)((float*)xout + off + bj * HALF + 4) = r1; } } }
    }
};

template <class Epi, class Sched, bool ALIGN_EPI = false, bool SP2 = false>
__device__ __forceinline__ void gemm_phase(PG8_LAS unsigned char* lds, const Gemm g, const Sched& S, const Epi& E) {
    int tid_ = threadIdx.x; asm volatile("" : "+v"(tid_));
    const int tid = tid_, wid = __builtin_amdgcn_readfirstlane(tid >> 6), lane = tid & 63, wr = wid >> 2, wc = wid & 3, fr = lane & 15, fq = lane >> 4;
    const int K = g.K, nt = K / BK;
    unsigned voffA[2], voffB[2];
#pragma unroll
    for (int i = 0; i < 2; ++i) { int R, C; stage_rc(tid * 16 + i * 8192, R, C); const int Rb = Epi::PERM ? ((R & ~31) + perm32(R & 31)) : R;
        voffA[i] = (unsigned)(R * K + C) * 2u; voffB[i] = (unsigned)(Rb * K + C) * 2u; }
    if (Epi::MT == 3 && wid >= 4) voffA[1] = voffA[0];
    const size_t kstep = (size_t)(BK * 2);
    constexpr int MT = Epi::MT;
    static_assert(MT == 4 || (MT == 3 && SP2), "192-row tiles: SP2 loop only");
    const size_t hstepB = (size_t)HALF * K * 2, hstepA = (size_t)(32 * MT) * K * 2;
    const size_t tstepB = 2 * hstepB, tstepA = 2 * hstepA;
    const unsigned ldsw = (unsigned)wid * 1024u;
    const int aoff = lds_byte(wr * (16 * MT) + fr, fq * 8), boff = lds_byte(wc * 32 + fr, fq * 8);
#define PG8_SA(b, h) (((b) * 2 + (h)) * HTB)
#define PG8_SB(b, h) ((4 + (b) * 2 + (h)) * HTB)
#define PG8_STAGE(bufoff, gbase, voff) do { _Pragma("unroll") for (int _i = 0; _i < 2; ++_i) \
        __builtin_amdgcn_global_load_lds((const unsigned*)((const char*)(gbase) + (voff)[_i]), (PG8_LAS unsigned*)(lds + (bufoff) + ldsw + _i * 8192), 16, 0, 0); } while (0)
#define PG8_LDA(dst, b, h) do { _Pragma("unroll") for (int m = 0; m < MT; ++m) _Pragma("unroll") for (int k = 0; k < 2; ++k) dst[m][k] = *(const PG8_LAS bf16x8*)(lds + PG8_SA(b, h) + aoff + m * 2048 + k * 1024); } while (0)
#define PG8_LDB(dst, b, h) do { _Pragma("unroll") for (int n = 0; n < 2; ++n) _Pragma("unroll") for (int k = 0; k < 2; ++k) dst[n][k] = *(const PG8_LAS bf16x8*)(lds + PG8_SB(b, h) + boff + n * 2048 + k * 1024); } while (0)
#define PG8_MMA(ai, bj, At, Bt) do { __builtin_amdgcn_s_setprio(1); _Pragma("unroll") for (int m = 0; m < MT; ++m) _Pragma("unroll") for (int n = 0; n < 2; ++n) _Pragma("unroll") for (int k = 0; k < 2; ++k) \
        acc[ai][bj][m][n] = __builtin_amdgcn_mfma_f32_16x16x32_bf16(Bt[n][k], At[m][k], acc[ai][bj][m][n], 0, 0, 0); __builtin_amdgcn_s_setprio(0); } while (0)
#define PG8_WAIT_V(n) asm volatile("s_waitcnt vmcnt(" #n ")" ::: "memory")
#define PG8_WAIT_L(n) asm volatile("s_waitcnt lgkmcnt(" #n ")" ::: "memory")
#define PG8_BAR __builtin_amdgcn_s_barrier()
#define PG8_SCHED __builtin_amdgcn_sched_barrier(0)
    Unit cur, nxt; int ui = 0;
    if (!S.next(0, cur)) return;
    f32x4 acc[2][2][MT][2];
#pragma unroll
    for (int a = 0; a < 2; ++a)
#pragma unroll
        for (int b = 0; b < 2; ++b)
#pragma unroll
            for (int m = 0; m < MT; ++m)
#pragma unroll
                for (int n = 0; n < 2; ++n) acc[a][b][m][n] = (f32x4){0.f, 0.f, 0.f, 0.f};
    bf16x8 At[MT][2], B0[2][2], B1[2][2];
    const char* cA = (const char*)g.A + (size_t)cur.pm * tstepA; const char* cB = (const char*)g.Bt + (size_t)cur.pn * tstepB;
    S.a_ready(cur);
    if constexpr (SP2) {
        PG8_STAGE(PG8_SB(0, 0), cB, voffB); PG8_STAGE(PG8_SB(0, 1), cB + hstepB, voffB); PG8_STAGE(PG8_SA(0, 0), cA, voffA); PG8_STAGE(PG8_SA(0, 1), cA + hstepA, voffA);
        if (wr == 1) PG8_BAR;
        PG8_WAIT_V(2); PG8_BAR;
        PG8_STAGE(PG8_SB(1, 0), cB + kstep, voffB); PG8_STAGE(PG8_SA(1, 0), cA + kstep, voffA); PG8_STAGE(PG8_SB(1, 1), cB + hstepB + kstep, voffB);
        PG8_WAIT_V(6); PG8_BAR;
    } else {
        PG8_STAGE(PG8_SB(0, 0), cB, voffB); PG8_STAGE(PG8_SA(0, 0), cA, voffA); PG8_STAGE(PG8_SB(0, 1), cB + hstepB, voffB); PG8_STAGE(PG8_SA(0, 1), cA + hstepA, voffA);
        if (wr == 1) PG8_BAR;
        PG8_WAIT_V(4); PG8_BAR;
        PG8_STAGE(PG8_SB(1, 0), cB + kstep, voffB); PG8_STAGE(PG8_SA(1, 0), cA + kstep, voffA); PG8_STAGE(PG8_SB(1, 1), cB + hstepB + kstep, voffB);
        PG8_WAIT_V(6); PG8_BAR;
    }
    for (;;) {
        const bool has_next = S.next(ui + 1, nxt);
        const char* nA = has_next ? (const char*)g.A + (size_t)nxt.pm * tstepA : cA; const char* nB = has_next ? (const char*)g.Bt + (size_t)nxt.pn * tstepB : cB;
        for (int t = 0; t < nt; t += 2) {
            const bool last = (t == nt - 2);
            const char* a1 = cA + (size_t)(t + 1) * kstep;
            const char* a2 = last ? nA : cA + (size_t)(t + 2) * kstep; const char* b2 = last ? nB : cB + (size_t)(t + 2) * kstep;
            const char* a3 = a2 + kstep; const char* b3 = b2 + kstep;
            if (last && has_next) S.a_ready(nxt);
            if constexpr (SP2) {
            PG8_LDB(B0, 0, 0); PG8_LDB(B1, 0, 1); PG8_SCHED; PG8_LDA(At, 0, 0); PG8_STAGE(PG8_SA(1, 1), a1 + hstepA, voffA);
            PG8_WAIT_V(8); PG8_WAIT_L(0); PG8_BAR; PG8_MMA(0, 0, At, B0); PG8_MMA(0, 1, At, B1); PG8_BAR; PG8_SCHED;
            PG8_LDA(At, 0, 1); PG8_STAGE(PG8_SB(0, 0), b2, voffB); PG8_STAGE(PG8_SB(0, 1), b2 + hstepB, voffB); PG8_STAGE(PG8_SA(0, 0), a2, voffA);
            PG8_WAIT_V(8); PG8_WAIT_L(0); PG8_BAR; PG8_MMA(1, 0, At, B0); PG8_MMA(1, 1, At, B1); PG8_BAR; PG8_SCHED;
            PG8_LDB(B0, 1, 0); PG8_LDB(B1, 1, 1); PG8_SCHED; PG8_LDA(At, 1, 0); PG8_STAGE(PG8_SA(0, 1), a2 + hstepA, voffA);
            PG8_WAIT_V(8); PG8_WAIT_L(0); PG8_BAR; PG8_MMA(0, 0, At, B0); PG8_MMA(0, 1, At, B1); PG8_BAR; PG8_SCHED;
            PG8_LDA(At, 1, 1); PG8_STAGE(PG8_SB(1, 0), b3, voffB); PG8_STAGE(PG8_SB(1, 1), b3 + hstepB, voffB); PG8_STAGE(PG8_SA(1, 0), a3, voffA);
            PG8_WAIT_V(8); PG8_WAIT_L(0); PG8_BAR; PG8_MMA(1, 0, At, B0); PG8_MMA(1, 1, At, B1); PG8_BAR; PG8_SCHED;
            } else {
            PG8_LDB(B0, 0, 0); PG8_SCHED; PG8_LDA(At, 0, 0); PG8_STAGE(PG8_SA(1, 1), a1 + hstepA, voffA);
            PG8_WAIT_L(8); PG8_BAR; PG8_WAIT_L(0); PG8_MMA(0, 0, At, B0); PG8_BAR; PG8_SCHED;
            PG8_LDB(B1, 0, 1); PG8_STAGE(PG8_SB(0, 0), b2, voffB);
            PG8_BAR; PG8_WAIT_L(0); PG8_MMA(0, 1, At, B1); PG8_BAR;
            PG8_LDA(At, 0, 1); PG8_STAGE(PG8_SA(0, 0), a2, voffA);
            PG8_BAR; PG8_WAIT_L(0); PG8_MMA(1, 0, At, B0); PG8_BAR; PG8_SCHED;
            PG8_STAGE(PG8_SB(0, 1), b2 + hstepB, voffB);
            PG8_WAIT_V(6); PG8_BAR; PG8_MMA(1, 1, At, B1); PG8_BAR;
            PG8_LDB(B0, 1, 0); PG8_SCHED; PG8_LDA(At, 1, 0); PG8_STAGE(PG8_SA(0, 1), a2 + hstepA, voffA);
            PG8_WAIT_L(8); PG8_BAR; PG8_WAIT_L(0); PG8_MMA(0, 0, At, B0); PG8_BAR; PG8_SCHED;
            PG8_LDB(B1, 1, 1); PG8_STAGE(PG8_SB(1, 0), b3, voffB);
            PG8_BAR; PG8_WAIT_L(0); PG8_MMA(0, 1, At, B1); PG8_BAR;
            PG8_LDA(At, 1, 1); PG8_STAGE(PG8_SA(1, 0), a3, voffA);
            PG8_BAR; PG8_WAIT_L(0); PG8_MMA(1, 0, At, B0); PG8_BAR; PG8_SCHED;
            PG8_STAGE(PG8_SB(1, 1), b3 + hstepB, voffB);
            PG8_WAIT_V(6); PG8_BAR; PG8_MMA(1, 1, At, B1); PG8_BAR;
            }
        }
        if constexpr (ALIGN_EPI) { if (wr == 0) PG8_BAR; }
        if constexpr (!Epi::AFTER_DRAIN) { E(acc, cur, wr, wc, fr, fq); S.done(cur); }
        if (!has_next) break;
#pragma unroll
        for (int a = 0; a < 2; ++a)
#pragma unroll
            for (int b = 0; b < 2; ++b)
#pragma unroll
                for (int m = 0; m < MT; ++m)
#pragma unroll
                    for (int n = 0; n < 2; ++n) acc[a][b][m][n] = (f32x4){0.f, 0.f, 0.f, 0.f};
        cur = nxt; cA = nA; cB = nB; ++ui;
        if constexpr (ALIGN_EPI) { if (wr == 1) PG8_BAR; }
    }
    PG8_WAIT_V(0);
    if constexpr (!ALIGN_EPI) { if (wr == 0) PG8_BAR; }
    PG8_BAR;
    if constexpr (Epi::AFTER_DRAIN) { E.fused(acc, cur, wr, wc, fr, fq, lds, wid, lane); S.done(cur); }
#undef PG8_SA
#undef PG8_SB
#undef PG8_STAGE
#undef PG8_LDA
#undef PG8_LDB
#undef PG8_MMA
#undef PG8_WAIT_V
#undef PG8_WAIT_L
#undef PG8_BAR
#undef PG8_SCHED
}

template <class Sched>
__device__ __forceinline__ void gemm_merge3(PG8_LAS unsigned char* lds, const bf16_t* A0, const bf16_t* A1, const bf16_t* A2, const bf16_t* W0, const bf16_t* W1, const bf16_t* W2,
                                            const Sched& S, const unsigned char* G8, bf16_t* MG, const float* ssq) {
    int tid_ = threadIdx.x; asm volatile("" : "+v"(tid_));
    const int tid = tid_, wid = __builtin_amdgcn_readfirstlane(tid >> 6), lane = tid & 63, wr = wid >> 2, wc = wid & 3, fr = lane & 15, fq = lane >> 4;
    constexpr int MT = 3;
    unsigned rA[2], rB[2], c2[2];
#pragma unroll
    for (int i = 0; i < 2; ++i) { int R, C; stage_rc(tid * 16 + i * 8192, R, C); rA[i] = (unsigned)R; rB[i] = (unsigned)((R & ~31) + perm32(R & 31)); c2[i] = (unsigned)C * 2u; }
    const size_t kstep = (size_t)(BK * 2);
    const unsigned ldsw = (unsigned)wid * 1024u;
    const int aoff = lds_byte(wr * (16 * MT) + fr, fq * 8), boff = lds_byte(wc * 32 + fr, fq * 8);
#define PG8_SA(b, h) (((b) * 2 + (h)) * HTB)
#define PG8_SB(b, h) ((4 + (b) * 2 + (h)) * HTB)
#define PG8_STAGE(bufoff, gbase, rr, kb) do { _Pragma("unroll") for (int _i = 0; _i < 2; ++_i) \
        __builtin_amdgcn_global_load_lds((const unsigned*)((const char*)(gbase) + ((rr)[_i] * (unsigned)(kb) + c2[_i])), (PG8_LAS unsigned*)(lds + (bufoff) + ldsw + _i * 8192), 16, 0, 0); } while (0)
#define PG8_LDA(dst, b, h) do { _Pragma("unroll") for (int m = 0; m < MT; ++m) _Pragma("unroll") for (int k = 0; k < 2; ++k) dst[m][k] = *(const PG8_LAS bf16x8*)(lds + PG8_SA(b, h) + aoff + m * 2048 + k * 1024); } while (0)
#define PG8_LDB(dst, b, h) do { _Pragma("unroll") for (int n = 0; n < 2; ++n) _Pragma("unroll") for (int k = 0; k < 2; ++k) dst[n][k] = *(const PG8_LAS bf16x8*)(lds + PG8_SB(b, h) + boff + n * 2048 + k * 1024); } while (0)
#define PG8_MMA(ai, bj, At, Bt) do { __builtin_amdgcn_s_setprio(1); _Pragma("unroll") for (int m = 0; m < MT; ++m) _Pragma("unroll") for (int n = 0; n < 2; ++n) _Pragma("unroll") for (int k = 0; k < 2; ++k) \
        acc[ai][bj][m][n] = __builtin_amdgcn_mfma_f32_16x16x32_bf16(Bt[n][k], At[m][k], acc[ai][bj][m][n], 0, 0, 0); __builtin_amdgcn_s_setprio(0); } while (0)
#define PG8_WAIT_V(n) asm volatile("s_waitcnt vmcnt(" #n ")" ::: "memory")
#define PG8_WAIT_L(n) asm volatile("s_waitcnt lgkmcnt(" #n ")" ::: "memory")
#define PG8_BAR __builtin_amdgcn_s_barrier()
#define PG8_SCHED __builtin_amdgcn_sched_barrier(0)
#define PG8_SEGA(s) ((const char*)((s) == 0 ? A0 : (s) == 1 ? A1 : A2))
#define PG8_SEGW(s) ((const char*)((s) == 0 ? W0 : (s) == 1 ? W1 : W2))
    Unit cur, nxt; int ti = 0, seg = 0;
    if (!S.next(0, cur)) return;
    f32x4 acc[2][2][MT][2];
#pragma unroll
    for (int a = 0; a < 2; ++a)
#pragma unroll
        for (int b = 0; b < 2; ++b)
#pragma unroll
            for (int m = 0; m < MT; ++m)
#pragma unroll
                for (int n = 0; n < 2; ++n) acc[a][b][m][n] = (f32x4){0.f, 0.f, 0.f, 0.f};
    u32x4 mrg[2][MT][2];
    bf16x8 At[MT][2], B0[2][2], B1[2][2];
    int kb = 512 * 2;
    const char* cA = PG8_SEGA(0) + (size_t)cur.pm * (size_t)(64 * MT) * kb; const char* cB = PG8_SEGW(0) + (size_t)cur.pn * (size_t)BM * kb;
    {   const size_t hA = (size_t)(32 * MT) * kb, hB = (size_t)HALF * kb;
        PG8_STAGE(PG8_SB(0, 0), cB, rB, kb); PG8_STAGE(PG8_SB(0, 1), cB + hB, rB, kb); PG8_STAGE(PG8_SA(0, 0), cA, rA, kb); PG8_STAGE(PG8_SA(0, 1), cA + hA, rA, kb);
        if (wr == 1) PG8_BAR;
        PG8_WAIT_V(2); PG8_BAR;
        PG8_STAGE(PG8_SB(1, 0), cB + kstep, rB, kb); PG8_STAGE(PG8_SA(1, 0), cA + kstep, rA, kb); PG8_STAGE(PG8_SB(1, 1), cB + hB + kstep, rB, kb);
        PG8_WAIT_V(6); PG8_BAR; }
    for (;;) {
        int nseg = seg + 1; bool has_next = true; Unit nu = cur;
        if (nseg == 3) { nseg = 0; has_next = S.next(ti + 1, nxt); nu = nxt; }
        const int nkb = has_next ? (nseg == 2 ? 2048 : 1024) : kb;
        const char* nA = has_next ? PG8_SEGA(nseg) + (size_t)nu.pm * (size_t)(64 * MT) * nkb : cA; const char* nB = has_next ? PG8_SEGW(nseg) + (size_t)nu.pn * (size_t)BM * nkb : cB;
        const int nt = kb >> 7;
        const size_t hA = (size_t)(32 * MT) * kb, hB = (size_t)HALF * kb;
        for (int t = 0; t < nt; t += 2) {
            const bool last = (t == nt - 2);
            const char* a1 = cA + (size_t)(t + 1) * kstep;
            const char* a2 = last ? nA : cA + (size_t)(t + 2) * kstep; const char* b2 = last ? nB : cB + (size_t)(t + 2) * kstep;
            const char* a3 = a2 + kstep; const char* b3 = b2 + kstep;
            const int kb2 = last ? nkb : kb; const size_t hA2 = (size_t)(32 * MT) * kb2, hB2 = (size_t)HALF * kb2;
            PG8_LDB(B0, 0, 0); PG8_LDB(B1, 0, 1); PG8_SCHED; PG8_LDA(At, 0, 0); PG8_STAGE(PG8_SA(1, 1), a1 + hA, rA, kb);
            PG8_WAIT_V(8); PG8_WAIT_L(0); PG8_BAR; PG8_MMA(0, 0, At, B0); PG8_MMA(0, 1, At, B1); PG8_BAR; PG8_SCHED;
            PG8_LDA(At, 0, 1); PG8_STAGE(PG8_SB(0, 0), b2, rB, kb2); PG8_STAGE(PG8_SB(0, 1), b2 + hB2, rB, kb2); PG8_STAGE(PG8_SA(0, 0), a2, rA, kb2);
            PG8_WAIT_V(8); PG8_WAIT_L(0); PG8_BAR; PG8_MMA(1, 0, At, B0); PG8_MMA(1, 1, At, B1); PG8_BAR; PG8_SCHED;
            PG8_LDB(B0, 1, 0); PG8_LDB(B1, 1, 1); PG8_SCHED; PG8_LDA(At, 1, 0); PG8_STAGE(PG8_SA(0, 1), a2 + hA2, rA, kb2);
            PG8_WAIT_V(8); PG8_WAIT_L(0); PG8_BAR; PG8_MMA(0, 0, At, B0); PG8_MMA(0, 1, At, B1); PG8_BAR; PG8_SCHED;
            PG8_LDA(At, 1, 1); PG8_STAGE(PG8_SB(1, 0), b3, rB, kb2); PG8_STAGE(PG8_SB(1, 1), b3 + hB2, rB, kb2); PG8_STAGE(PG8_SA(1, 0), a3, rA, kb2);
            PG8_WAIT_V(8); PG8_WAIT_L(0); PG8_BAR; PG8_MMA(1, 0, At, B0); PG8_MMA(1, 1, At, B1); PG8_BAR; PG8_SCHED;
        }
        if (wr == 0) PG8_BAR;
        {
            const int row0 = cur.pm * (64 * MT) + wr * (16 * MT) + fr, col0 = cur.pn * BM + wc * 32 + 8 * fq;
            constexpr float SC = 1.0f / 255.0f;
#pragma unroll
            for (int ai = 0; ai < 2; ++ai)
#pragma unroll
                for (int m = 0; m < MT; ++m) { const int row = row0 + ai * (32 * MT) + m * 16;
                    const float rs = seg == 2 ? SC * (1.0f / sqrtf(ssq[row] * (1.0f / 1024.0f) + 1e-6f)) : SC;
#pragma unroll
                    for (int bj = 0; bj < 2; ++bj) { const f32x4 v0 = acc[ai][bj][m][0], v1 = acc[ai][bj][m][1];
                        const u32x2 gq = *(const u32x2*)(G8 + (size_t)row * 3072 + seg * 1024 + col0 + bj * HALF);
                        float r[8];
                        r[0] = (float)(gq.x & 255u) * rs * v0[0]; r[1] = (float)((gq.x >> 8) & 255u) * rs * v0[1]; r[2] = (float)((gq.x >> 16) & 255u) * rs * v0[2]; r[3] = (float)(gq.x >> 24) * rs * v0[3];
                        r[4] = (float)(gq.y & 255u) * rs * v1[0]; r[5] = (float)((gq.y >> 8) & 255u) * rs * v1[1]; r[6] = (float)((gq.y >> 16) & 255u) * rs * v1[2]; r[7] = (float)(gq.y >> 24) * rs * v1[3];
                        if (seg != 0) { const u32x4 mq = mrg[ai][m][bj];
                            r[0] += __uint_as_float(mq.x << 16); r[1] += __uint_as_float(mq.x & 0xffff0000u); r[2] += __uint_as_float(mq.y << 16); r[3] += __uint_as_float(mq.y & 0xffff0000u);
                            r[4] += __uint_as_float(mq.z << 16); r[5] += __uint_as_float(mq.z & 0xffff0000u); r[6] += __uint_as_float(mq.w << 16); r[7] += __uint_as_float(mq.w & 0xffff0000u); }
                        u32x4 w; w.x = cvt_pk_bf16_c(r[0], r[1]); w.y = cvt_pk_bf16_c(r[2], r[3]); w.z = cvt_pk_bf16_c(r[4], r[5]); w.w = cvt_pk_bf16_c(r[6], r[7]);
                        mrg[ai][m][bj] = w;
                        if (seg == 2) *(u32x4*)(MG + (size_t)row * 1024 + col0 + bj * HALF) = w; } }
        }
        if (!has_next) break;
#pragma unroll
        for (int a = 0; a < 2; ++a)
#pragma unroll
            for (int b = 0; b < 2; ++b)
#pragma unroll
                for (int m = 0; m < MT; ++m)
#pragma unroll
                    for (int n = 0; n < 2; ++n) acc[a][b][m][n] = (f32x4){0.f, 0.f, 0.f, 0.f};
        if (nseg == 0) { cur = nxt; ++ti; }
        seg = nseg; kb = nkb; cA = nA; cB = nB;
        if (wr == 1) PG8_BAR;
    }
    PG8_WAIT_V(0);
    PG8_BAR;
#undef PG8_SEGA
#undef PG8_SEGW
#undef PG8_SA
#undef PG8_SB
#undef PG8_STAGE
#undef PG8_LDA
#undef PG8_LDB
#undef PG8_MMA
#undef PG8_WAIT_V
#undef PG8_WAIT_L
#undef PG8_BAR
#undef PG8_SCHED
}
template <class Sched>
__device__ __forceinline__ void gemm_merge6(PG8_LAS unsigned char* lds, const bf16_t* H, const bf16_t* WG, const bf16_t* A0, const bf16_t* A1, const bf16_t* A2, const bf16_t* W0, const bf16_t* W1, const bf16_t* W2,
                                            const Sched& S, bf16_t* MG, const float* ssqh) {
    constexpr int GT_OFF = 133120;
    int tid_ = threadIdx.x; asm volatile("" : "+v"(tid_));
    const int tid = tid_, wid = __builtin_amdgcn_readfirstlane(tid >> 6), lane = tid & 63, wr = wid >> 2, wc = wid & 3, fr = lane & 15, fq = lane >> 4;
    constexpr int MT = 3;
    unsigned rA, rB, c2;
    { int R, C; stage_rc(tid * 16, R, C); rA = (unsigned)R; rB = (unsigned)((R & ~31) + perm32(R & 31)); c2 = (unsigned)C * 2u; }
    const size_t kstep = (size_t)(BK * 2);
    const unsigned ldsw = (unsigned)wid * 1024u;
    const int aoff = lds_byte(wr * (16 * MT) + fr, fq * 8), boff = lds_byte(wc * 32 + fr, fq * 8);
#define PG8_SA(b, h) (((b) * 2 + (h)) * HTB)
#define PG8_SB(b, h) ((4 + (b) * 2 + (h)) * HTB)
#define PG8_STAGE(bufoff, gbase, rr, kb) do { const unsigned vo_ = (rr) * (unsigned)(kb) + c2; _Pragma("unroll") for (int _i = 0; _i < 2; ++_i) \
        __builtin_amdgcn_global_load_lds((const unsigned*)((const char*)(gbase) + (size_t)(_i * 64) * (size_t)(kb) + vo_), (PG8_LAS unsigned*)(lds + (bufoff) + ldsw + _i * 8192), 16, 0, 0); } while (0)
    const int a2nd = wid < 4 ? 64 : 0;
#define PG8_STAGEA(bufoff, gbase, kb) do { const unsigned vo_ = rA * (unsigned)(kb) + c2; _Pragma("unroll") for (int _i = 0; _i < 2; ++_i) \
        __builtin_amdgcn_global_load_lds((const unsigned*)((const char*)(gbase) + (size_t)(_i * a2nd) * (size_t)(kb) + vo_), (PG8_LAS unsigned*)(lds + (bufoff) + ldsw + _i * 8192), 16, 0, 0); } while (0)
#define PG8_LDA(dst, b, h) do { _Pragma("unroll") for (int m = 0; m < MT; ++m) _Pragma("unroll") for (int k = 0; k < 2; ++k) dst[m][k] = *(const PG8_LAS bf16x8*)(lds + PG8_SA(b, h) + aoff + m * 2048 + k * 1024); } while (0)
#define PG8_LDB(dst, b, h) do { _Pragma("unroll") for (int n = 0; n < 2; ++n) _Pragma("unroll") for (int k = 0; k < 2; ++k) dst[n][k] = *(const PG8_LAS bf16x8*)(lds + PG8_SB(b, h) + boff + n * 2048 + k * 1024); } while (0)
#define PG8_MMA(ai, bj, At, Bt) do { __builtin_amdgcn_s_setprio(1); _Pragma("unroll") for (int m = 0; m < MT; ++m) _Pragma("unroll") for (int n = 0; n < 2; ++n) _Pragma("unroll") for (int k = 0; k < 2; ++k) \
        acc[ai][bj][m][n] = __builtin_amdgcn_mfma_f32_16x16x32_bf16(Bt[n][k], At[m][k], acc[ai][bj][m][n], 0, 0, 0); __builtin_amdgcn_s_setprio(0); } while (0)
#define PG8_WAIT_V(n) asm volatile("s_waitcnt vmcnt(" #n ")" ::: "memory")
#define PG8_WAIT_L(n) asm volatile("s_waitcnt lgkmcnt(" #n ")" ::: "memory")
#define PG8_BAR __builtin_amdgcn_s_barrier()
#define PG8_SCHED __builtin_amdgcn_sched_barrier(0)
#define PG8_SEGA(s) ((const char*)(((s) & 1) == 0 ? H : (s) == 1 ? A0 : (s) == 3 ? A1 : A2))
#define PG8_SEGW(s) ((const char*)(((s) & 1) == 0 ? WG + (size_t)((s) >> 1) * 1024 * 1024 : (s) == 1 ? W0 : (s) == 3 ? W1 : W2))
#define PG8_SEGKB(s) (((s) == 1 || (s) == 3) ? 1024 : 2048)
    Unit cur, nxt; int ti = 0, seg = 0;
    if (!S.next(0, cur)) return;
    f32x4 acc[2][2][MT][2];
#pragma unroll
    for (int a = 0; a < 2; ++a)
#pragma unroll
        for (int b = 0; b < 2; ++b)
#pragma unroll
            for (int m = 0; m < MT; ++m)
#pragma unroll
                for (int n = 0; n < 2; ++n) acc[a][b][m][n] = (f32x4){0.f, 0.f, 0.f, 0.f};
    u32x4 mrg[2][MT][2];
    u32x2 gt[MT][2];
    PG8_LAS u32x4* gtl = (PG8_LAS u32x4*)(lds + GT_OFF) + tid;
    bf16x8 At[MT][2], B0[2][2], B1[2][2];
    int kb = 1024 * 2;
    const char* cA = PG8_SEGA(0) + (size_t)cur.pm * (size_t)(64 * MT) * kb; const char* cB = PG8_SEGW(0) + (size_t)cur.pn * (size_t)BM * kb;
    {   const size_t hA = (size_t)(32 * MT) * kb, hB = (size_t)HALF * kb;
        PG8_STAGE(PG8_SB(0, 0), cB, rB, kb); PG8_STAGE(PG8_SB(0, 1), cB + hB, rB, kb); PG8_STAGEA(PG8_SA(0, 0), cA, kb); PG8_STAGEA(PG8_SA(0, 1), cA + hA, kb);
        if (wr == 1) PG8_BAR;
        PG8_WAIT_V(2); PG8_BAR;
        PG8_STAGE(PG8_SB(1, 0), cB + kstep, rB, kb); PG8_STAGEA(PG8_SA(1, 0), cA + kstep, kb); PG8_STAGE(PG8_SB(1, 1), cB + hB + kstep, rB, kb);
        PG8_WAIT_V(6); PG8_BAR; }
    for (;;) {
        int nseg = seg + 1; bool has_next = true; Unit nu = cur;
        if (nseg == 6) { nseg = 0; has_next = S.next(ti + 1, nxt); nu = nxt; }
        const int nkb = has_next ? PG8_SEGKB(nseg) : kb;
        const char* nA = has_next ? PG8_SEGA(nseg) + (size_t)nu.pm * (size_t)(64 * MT) * nkb : cA; const char* nB = has_next ? PG8_SEGW(nseg) + (size_t)nu.pn * (size_t)BM * nkb : cB;
        const int nt = kb >> 7;
        const size_t hA = (size_t)(32 * MT) * kb, hB = (size_t)HALF * kb;
        for (int t = 0; t < nt; t += 2) {
            const bool last = (t == nt - 2);
            const char* a1 = cA + (size_t)(t + 1) * kstep;
            const char* a2 = last ? nA : cA + (size_t)(t + 2) * kstep; const char* b2 = last ? nB : cB + (size_t)(t + 2) * kstep;
            const char* a3 = a2 + kstep; const char* b3 = b2 + kstep;
            const int kb2 = last ? nkb : kb; const size_t hA2 = (size_t)(32 * MT) * kb2, hB2 = (size_t)HALF * kb2;
            PG8_LDB(B0, 0, 0); PG8_LDB(B1, 0, 1); PG8_SCHED; PG8_LDA(At, 0, 0); PG8_STAGEA(PG8_SA(1, 1), a1 + hA, kb);
            PG8_WAIT_V(8); PG8_WAIT_L(0); PG8_BAR; PG8_MMA(0, 0, At, B0); PG8_MMA(0, 1, At, B1); PG8_BAR; PG8_SCHED;
            PG8_LDA(At, 0, 1); PG8_STAGE(PG8_SB(0, 0), b2, rB, kb2); PG8_STAGE(PG8_SB(0, 1), b2 + hB2, rB, kb2); PG8_STAGEA(PG8_SA(0, 0), a2, kb2);
            PG8_WAIT_V(8); PG8_WAIT_L(0); PG8_BAR; PG8_MMA(1, 0, At, B0); PG8_MMA(1, 1, At, B1); PG8_BAR; PG8_SCHED;
            PG8_LDB(B0, 1, 0); PG8_LDB(B1, 1, 1); PG8_SCHED; PG8_LDA(At, 1, 0); PG8_STAGEA(PG8_SA(0, 1), a2 + hA2, kb2);
            PG8_WAIT_V(8); PG8_WAIT_L(0); PG8_BAR; PG8_MMA(0, 0, At, B0); PG8_MMA(0, 1, At, B1); PG8_BAR; PG8_SCHED;
            PG8_LDA(At, 1, 1); PG8_STAGE(PG8_SB(1, 0), b3, rB, kb2); PG8_STAGE(PG8_SB(1, 1), b3 + hB2, rB, kb2); PG8_STAGEA(PG8_SA(1, 0), a3, kb2);
            PG8_WAIT_V(8); PG8_WAIT_L(0); PG8_BAR; PG8_MMA(1, 0, At, B0); PG8_MMA(1, 1, At, B1); PG8_BAR; PG8_SCHED;
        }
        if (wr == 0) PG8_BAR;
        if ((seg & 1) == 0) {
            u32x2 gl[MT][2];
#pragma unroll
            for (int ai = 0; ai < 2; ++ai)
#pragma unroll
                for (int m = 0; m < MT; ++m)
#pragma unroll
                    for (int bj = 0; bj < 2; ++bj) { const f32x4 v0 = acc[ai][bj][m][0], v1 = acc[ai][bj][m][1];
                        unsigned q[8];
#pragma unroll
                        for (int e = 0; e < 4; ++e) { q[e] = (unsigned)(255.f * __builtin_amdgcn_rcpf(1.f + __expf(-v0[e])) + 0.5f); q[4 + e] = (unsigned)(255.f * __builtin_amdgcn_rcpf(1.f + __expf(-v1[e])) + 0.5f); }
                        u32x2 w; w.x = q[0] | (q[1] << 8) | (q[2] << 16) | (q[3] << 24); w.y = q[4] | (q[5] << 8) | (q[6] << 16) | (q[7] << 24);
                        if (ai == 0) gt[m][bj] = w; else gl[m][bj] = w; }
            { u32x4 t; t.x = gl[0][0].x; t.y = gl[0][0].y; t.z = gl[0][1].x; t.w = gl[0][1].y; gtl[0] = t; t.x = gl[1][0].x; t.y = gl[1][0].y; t.z = gl[1][1].x; t.w = gl[1][1].y; gtl[512] = t;
              t.x = gl[2][0].x; t.y = gl[2][0].y; t.z = gl[2][1].x; t.w = gl[2][1].y; gtl[1024] = t; }
        } else {
            int fr_ = fr, fq_ = fq; asm volatile("" : "+v"(fr_), "+v"(fq_));
            const int row0 = cur.pm * (64 * MT) + wr * (16 * MT) + fr_, col0 = cur.pn * BM + wc * 32 + 8 * fq_;
            constexpr float SC = 1.0f / 255.0f;
#pragma unroll
            for (int ai = 0; ai < 2; ++ai)
#pragma unroll
                for (int m = 0; m < MT; ++m) { const int row = row0 + ai * (32 * MT) + m * 16;
                    float rs = SC;
                    if (seg == 5) {
                        const float* sp = ssqh + (size_t)(4 * fq_) * MTOK + row;
                        float s4 = (sp[0] + sp[MTOK]) + (sp[2 * (size_t)MTOK] + sp[3 * (size_t)MTOK]);
                        s4 += __shfl_xor(s4, 16); s4 += __shfl_xor(s4, 32);
                        rs = SC * (1.0f / sqrtf(s4 * (1.0f / 1024.0f) + 1e-6f)); }
#pragma unroll
                    for (int bj = 0; bj < 2; ++bj) { const f32x4 v0 = acc[ai][bj][m][0], v1 = acc[ai][bj][m][1];
                        u32x2 gq; if (ai == 0) gq = gt[m][bj]; else { const u32x4 t = gtl[512 * m]; gq.x = bj ? t.z : t.x; gq.y = bj ? t.w : t.y; }
                        float r[8];
                        r[0] = (float)(gq.x & 255u) * rs * v0[0]; r[1] = (float)((gq.x >> 8) & 255u) * rs * v0[1]; r[2] = (float)((gq.x >> 16) & 255u) * rs * v0[2]; r[3] = (float)(gq.x >> 24) * rs * v0[3];
                        r[4] = (float)(gq.y & 255u) * rs * v1[0]; r[5] = (float)((gq.y >> 8) & 255u) * rs * v1[1]; r[6] = (float)((gq.y >> 16) & 255u) * rs * v1[2]; r[7] = (float)(gq.y >> 24) * rs * v1[3];
                        if (seg != 1) { const u32x4 mq = mrg[ai][m][bj];
                            r[0] += __uint_as_float(mq.x << 16); r[1] += __uint_as_float(mq.x & 0xffff0000u); r[2] += __uint_as_float(mq.y << 16); r[3] += __uint_as_float(mq.y & 0xffff0000u);
                            r[4] += __uint_as_float(mq.z << 16); r[5] += __uint_as_float(mq.z & 0xffff0000u); r[6] += __uint_as_float(mq.w << 16); r[7] += __uint_as_float(mq.w & 0xffff0000u); }
                        u32x4 w; w.x = cvt_pk_bf16_c(r[0], r[1]); w.y = cvt_pk_bf16_c(r[2], r[3]); w.z = cvt_pk_bf16_c(r[4], r[5]); w.w = cvt_pk_bf16_c(r[6], r[7]);
                        mrg[ai][m][bj] = w;
                        if (seg == 5) *(u32x4*)(MG + (size_t)row * 1024 + col0 + bj * HALF) = w; } }
        }
        if (!has_next) break;
#pragma unroll
        for (int a = 0; a < 2; ++a)
#pragma unroll
            for (int b = 0; b < 2; ++b)
#pragma unroll
                for (int m = 0; m < MT; ++m)
#pragma unroll
                    for (int n = 0; n < 2; ++n) acc[a][b][m][n] = (f32x4){0.f, 0.f, 0.f, 0.f};
        if (nseg == 0) { cur = nxt; ++ti; }
        seg = nseg; kb = nkb; cA = nA; cB = nB;
        if (wr == 1) PG8_BAR;
    }
    PG8_WAIT_V(0);
    PG8_BAR;
#undef PG8_SEGA
#undef PG8_SEGW
#undef PG8_SEGKB
#undef PG8_SA
#undef PG8_SB
#undef PG8_STAGE
#undef PG8_STAGEA
#undef PG8_LDA
#undef PG8_LDB
#undef PG8_MMA
#undef PG8_WAIT_V
#undef PG8_WAIT_L
#undef PG8_BAR
#undef PG8_SCHED
}
}
using pg8::bf16_t;
__device__ __forceinline__ void phase_mod(const Params& P, LAS unsigned char* lds) {
    const int ZZ = opq0();
    const int tid = threadIdx.x, lane = tid & 63, w = tid >> 6;
    LAS float* sv = (LAS float*)lds;
    LAS float* red = (LAS float*)(lds + 9 * 1024 * 4);
    for (int i = tid; i < 9 * 1024; i += 512) { const int v = i >> 10, k = i & 1023; const float c = v == 0 ? P.in[ZZ + I_CCTX][k] : P.in[ZZ + I_C][(v - 1) * 1024 + k]; sv[i] = silu_f(c); }
    __syncthreads();
    float* MOD = (float*)(P.ws + ZZ + WS_MOD);
    for (int cgp = blockIdx.x; cgp < 192; cgp += gridDim.x) {
        const int col = cgp * 64 + lane, l = col / 6144, j = col % 6144;
        const float* wp = P.in[ZZ + I_WMOD] + (size_t)l * 1024 * 6144 + j;
        float a[9];
#pragma unroll
        for (int v = 0; v < 9; ++v) a[v] = 0.f;
        const int k0 = w * 128;
        for (int kb = k0; kb < k0 + 128; kb += 16) {
            float wv[16];
#pragma unroll
            for (int kk = 0; kk < 16; ++kk) wv[kk] = wp[(size_t)(kb + kk) * 6144];
#pragma unroll
            for (int kk = 0; kk < 16; ++kk)
#pragma unroll
                for (int v = 0; v < 9; ++v) a[v] += sv[v * 1024 + kb + kk] * wv[kk];
        }
#pragma unroll
        for (int v = 0; v < 9; ++v) red[(w * 9 + v) * 64 + lane] = a[v];
        __syncthreads();
        for (int o = tid; o < 9 * 64; o += 512) { const int v = o >> 6, ln = o & 63; float s = 0.f;
#pragma unroll
            for (int ww = 0; ww < 8; ++ww) s += red[(ww * 9 + v) * 64 + ln];
            const int c2 = cgp * 64 + ln, l2 = c2 / 6144, j2 = c2 % 6144;
            MOD[(size_t)(l2 * 9 + v) * 6144 + j2] = s + P.in[ZZ + I_BMOD][l2 * 6144 + j2]; }
        __syncthreads();
    }
}

__device__ __forceinline__ void transpose_item(const float* W, int ldw, int srccol0, bf16_t* WT, int K, int n0, int k0, LAS float* scr, int lane, const float* kscale = nullptr) {
    const int ks = lane >> 3, c4 = lane & 7;
    f32x4 v[8];
    if (srccol0 >= 0) {
#pragma unroll
        for (int i = 0; i < 8; ++i) { v[i] = *(const f32x4*)(W + (size_t)(k0 + 8 * i + ks) * ldw + srccol0 + 4 * c4); if (kscale) v[i] = v[i] * kscale[k0 + 8 * i + ks]; }
    } else {
#pragma unroll
        for (int i = 0; i < 8; ++i) v[i] = (f32x4){0.f, 0.f, 0.f, 0.f};
    }
#pragma unroll
    for (int i = 0; i < 8; ++i) { LAS float* d = scr + (8 * i + ks) * 33 + 4 * c4; d[0] = v[i][0]; d[1] = v[i][1]; d[2] = v[i][2]; d[3] = v[i][3]; }
    LDS_WAIT(); asm volatile("" ::: "memory");
    const int c = lane & 7;
#pragma unroll
    for (int j = 0; j < 4; ++j) { const int n = (lane >> 3) + 8 * j; const LAS float* s = scr + (8 * c) * 33 + n;
        u32x4 o; o.x = cvt_pk_bf16(s[0 * 33], s[1 * 33]); o.y = cvt_pk_bf16(s[2 * 33], s[3 * 33]); o.z = cvt_pk_bf16(s[4 * 33], s[5 * 33]); o.w = cvt_pk_bf16(s[6 * 33], s[7 * 33]);
        *(u32x4*)(WT + (size_t)(n0 + n) * K + k0 + 8 * c) = o; }
    LDS_WAIT(); asm volatile("" ::: "memory");
}
__device__ __forceinline__ void titem_load(const float* W, int ldw, int srccol0, int k0, const float* kscale, f32x4 (&v)[8], float (&sc)[8], int lane) {
    const int ks = lane >> 3, c4 = lane & 7;
#pragma unroll
    for (int i = 0; i < 8; ++i) { v[i] = (f32x4){0.f, 0.f, 0.f, 0.f}; sc[i] = 1.0f;
        if (srccol0 >= 0) { v[i] = *(const f32x4*)(W + (size_t)(k0 + 8 * i + ks) * ldw + srccol0 + 4 * c4); if (kscale) sc[i] = kscale[k0 + 8 * i + ks]; } }
}
__device__ __forceinline__ void titem_store(bf16_t* WT, int K, int n0, int k0, const f32x4 (&v)[8], const float (&sc)[8], LAS float* scr, int lane) {
    const int ks = lane >> 3, c4 = lane & 7;
#pragma unroll
    for (int i = 0; i < 8; ++i) { LAS float* d = scr + (8 * i + ks) * 33 + 4 * c4; d[0] = v[i][0] * sc[i]; d[1] = v[i][1] * sc[i]; d[2] = v[i][2] * sc[i]; d[3] = v[i][3] * sc[i]; }
    LDS_WAIT(); asm volatile("" ::: "memory");
    const int c = lane & 7;
#pragma unroll
    for (int j = 0; j < 4; ++j) { const int n = (lane >> 3) + 8 * j; const LAS float* s = scr + (8 * c) * 33 + n;
        u32x4 o; o.x = cvt_pk_bf16(s[0 * 33], s[1 * 33]); o.y = cvt_pk_bf16(s[2 * 33], s[3 * 33]); o.z = cvt_pk_bf16(s[4 * 33], s[5 * 33]); o.w = cvt_pk_bf16(s[6 * 33], s[7 * 33]);
        *(u32x4*)(WT + (size_t)(n0 + n) * K + k0 + 8 * c) = o; }
    LDS_WAIT(); asm volatile("" ::: "memory");
}
__device__ __forceinline__ int win_srccol(int n0) { return n0 < 3872 ? n0 : -1; }
template <int NR, bool XBF>
__device__ __forceinline__ void norm_mod_rows(const void* const (&xr)[NR], const float* g, const float* const (&md)[NR], int sh_off, int sc_off, bf16_t* const (&orow)[NR], int lane) {
    f32x4 v[XBF ? 1 : NR][4]; u32x2 q[XBF ? NR : 1][4]; float s[NR];
#define NM_X(r, j) (XBF ? (f32x4){bf_lo(q[XBF ? (r) : 0][j].x), bf_hi(q[XBF ? (r) : 0][j].x), bf_lo(q[XBF ? (r) : 0][j].y), bf_hi(q[XBF ? (r) : 0][j].y)} : v[XBF ? 0 : (r)][j])
#pragma unroll
    for (int r = 0; r < NR; ++r)
#pragma unroll
        for (int j = 0; j < 4; ++j) { if (XBF) q[XBF ? r : 0][j] = ((const u32x2*)xr[r])[lane + 64 * j]; else v[XBF ? 0 : r][j] = ((const f32x4*)xr[r])[lane + 64 * j]; }
#pragma unroll
    for (int r = 0; r < NR; ++r) { s[r] = 0.f;
#pragma unroll
        for (int j = 0; j < 4; ++j) { const f32x4 x = NM_X(r, j); s[r] += (x[0] * x[0] + x[1] * x[1]) + (x[2] * x[2] + x[3] * x[3]); } }
#pragma unroll
    for (int o = 1; o < 64; o <<= 1)
#pragma unroll
        for (int r = 0; r < NR; ++r) s[r] += __shfl_xor(s[r], o);
#pragma unroll
    for (int j = 0; j < 4; ++j) { const f32x4 gg = ((const f32x4*)g)[lane + 64 * j];
#pragma unroll
        for (int r = 0; r < NR; ++r) { const float rs = 1.0f / sqrtf(s[r] * (1.0f / 1024.0f) + 1e-6f);
            const f32x4 a1 = ((const f32x4*)(md[r] + sc_off))[lane + 64 * j], a0 = ((const f32x4*)(md[r] + sh_off))[lane + 64 * j];
            const f32x4 x = NM_X(r, j);
            const f32x4 y = (x * rs * gg) * (a1 + 1.0f) + a0;
            ((unsigned long long*)orow[r])[lane + 64 * j] = (unsigned long long)cvt_pk_bf16(y[0], y[1]) | ((unsigned long long)cvt_pk_bf16(y[2], y[3]) << 32); } }
#undef NM_X
}
__device__ __forceinline__ void norm_rows_x(const Params& P, int ZZ, const float* g, const float* MOD, int sh_off, int sc_off, int gw, int NGW, int lane) {
    const bf16_t* X = (const bf16_t*)(P.ws + ZZ + WS_X); bf16_t* H = (bf16_t*)(P.out + ZZ);
    gw = __builtin_amdgcn_readfirstlane(gw);
    for (int m = 6 * gw; m < MTOK; m += 6 * NGW) {
        const void* xr[6]; const float* md[6]; bf16_t* orow[6];
#pragma unroll
        for (int r = 0; r < 6; ++r) { xr[r] = X + (size_t)(m + r) * 1024; md[r] = MOD + (size_t)mod_index(m + r) * 6144; orow[r] = H + (size_t)(m + r) * 1024; }
        norm_mod_rows<6, true>(xr, g, md, sh_off, sc_off, orow, lane);
    }
}
__device__ __forceinline__ void h1_rows2(const Params& P, int l, int gw, int NGW, int lane) {
    const int ZZ = opq0();
    const float* MOD = (const float*)(P.ws + ZZ + WS_MOD) + (size_t)l * 9 * 6144;
    if (l != 0) { norm_rows_x(P, ZZ, P.in[ZZ + I_N1G] + l * 1024, MOD, 0, 1024, gw, NGW, lane); return; }
    bf16_t* H = (bf16_t*)(P.out + ZZ);
    for (int m = 4 * gw; m < MTOK; m += 4 * NGW) {
        const void* xr[4]; const float* md[4]; bf16_t* orow[4];
#pragma unroll
        for (int r = 0; r < 4; ++r) { xr[r] = xrow_ptr0(P, ZZ, m + r); md[r] = MOD + (size_t)mod_index(m + r) * 6144; orow[r] = H + (size_t)(m + r) * 1024; }
        norm_mod_rows<4, false>(xr, P.in[ZZ + I_N1G] + l * 1024, md, 0, 1024, orow, lane);
    }
}
__device__ __forceinline__ void phase_p0(const Params& P, int l, LAS unsigned char* lds) {
    const int ZZ = opq0();
    const int tid = threadIdx.x, lane = tid & 63, w = tid >> 6;
    LAS float* scr = (LAS float*)(lds + w * 8704);
    const int gw = blockIdx.x * 8 + w, NGW = gridDim.x * 8;
    constexpr int I0 = 2048, I1 = I0 + 1536, I2 = I1 + 256, I3 = I2 + 512, I4 = I3 + 512, I5 = I4 + 2048, I6 = I5 + 2048;
    unsigned char* ws = P.ws + ZZ;
    const float* const pWIN = P.in[ZZ + I_WIN] + (size_t)l * 1024 * INC; const float* const pWAO = P.in[ZZ + I_WAO] + (size_t)l * 512 * 1024; const float* const pWSO = P.in[ZZ + I_WSO] + (size_t)l * 1024 * 1024;
    const float* const pWOUT = P.in[ZZ + I_WOUT] + (size_t)l * 1024 * 1024; const float* const pWM1 = P.in[ZZ + I_WM1] + (size_t)l * 1024 * 4096; const float* const pWM2 = P.in[ZZ + I_WM2] + (size_t)l * 4096 * 1024;
    const float* const pSSDG = P.in[ZZ + I_SSDG] + l * 1024;
#define P0_ITEM(IT, W_, LD_, SC_, K0_, KS_, WT_, KK_, N0_) do { const int it_ = (IT); KS_ = nullptr; \
        if (it_ < I0) { const int kb = it_ / 128, nb = it_ % 128; W_ = pWIN; LD_ = INC; SC_ = win_srccol(nb * 32); WT_ = (bf16_t*)(ws + WS_WIN); KK_ = 1024; N0_ = nb * 32; K0_ = kb * 64; } \
        else if (it_ < I1) { const int r = it_ - I0, kb = r / 96, nb = r % 96; W_ = pWIN; LD_ = INC; SC_ = 3872 + nb * 32; WT_ = (bf16_t*)(ws + WS_WG); KK_ = 1024; N0_ = nb * 32; K0_ = kb * 64; } \
        else if (it_ < I2) { const int r = it_ - I1, kb = r / 32, nb = r % 32; W_ = pWAO; LD_ = 1024; SC_ = nb * 32; WT_ = (bf16_t*)(ws + WS_WATT); KK_ = 512; N0_ = nb * 32; K0_ = kb * 64; } \
        else if (it_ < I3) { const int r = it_ - I2, kb = r / 32, nb = r % 32; W_ = pWSO; LD_ = 1024; SC_ = nb * 32; WT_ = (bf16_t*)(ws + WS_WSSD); KK_ = 1024; N0_ = nb * 32; K0_ = kb * 64; \
            KS_ = pSSDG; }     \
        else if (it_ < I4) { const int r = it_ - I3, kb = r / 32, nb = r % 32; W_ = pWOUT; LD_ = 1024; SC_ = nb * 32; WT_ = (bf16_t*)(ws + WS_WOUT); KK_ = 1024; N0_ = nb * 32; K0_ = kb * 64; } \
        else if (it_ < I5) { const int r = it_ - I4, kb = r / 128, nb = r % 128; W_ = pWM1; LD_ = 4096; SC_ = nb * 32; WT_ = (bf16_t*)(ws + WS_WM1); KK_ = 1024; N0_ = nb * 32; K0_ = kb * 64; } \
        else { const int r = it_ - I5, kb = r / 32, nb = r % 32; W_ = pWM2; LD_ = 1024; SC_ = nb * 32; WT_ = (bf16_t*)(ws + WS_WM2); KK_ = 4096; N0_ = nb * 32; K0_ = kb * 64; } } while (0)
    {
        f32x4 va[8], vb[8]; float sa[8], sb[8];
        const float *cW, *cKS; int cLD, cSC, cK0, cKK, cN0; bf16_t* cWT;
        int it = __builtin_amdgcn_readfirstlane(gw);
        P0_ITEM(it < I6 ? it : 0, cW, cLD, cSC, cK0, cKS, cWT, cKK, cN0);
        if (it < I6) titem_load(cW, cLD, cSC, cK0, cKS, va, sa, lane);
        for (; it < I6; it += NGW) {
            const int nx = it + NGW;
            const float *nW, *nKS; int nLD, nSC, nK0, nKK, nN0; bf16_t* nWT;
            P0_ITEM(nx < I6 ? nx : it, nW, nLD, nSC, nK0, nKS, nWT, nKK, nN0);
            if (nx < I6) titem_load(nW, nLD, nSC, nK0, nKS, vb, sb, lane);
            titem_store(cWT, cKK, cN0, cK0, va, sa, scr, lane);
#pragma unroll
            for (int i = 0; i < 8; ++i) { va[i] = vb[i]; sa[i] = sb[i]; }
            cWT = nWT; cKK = nKK; cN0 = nN0; cK0 = nK0;
        }
    }
#undef P0_ITEM
    for (int tk = gw; tk < 2048; tk += NGW) {
        const int c0 = (tk >> 4) * 4, n = (tk & 15) * 64 + lane, g = c0 >> 7, cc0 = c0 & 127;
        const float* wo = P.in[ZZ + I_WPO] + (size_t)l * 512 * 1024 + (size_t)(g * 128) * 1024 + n;
        const float* sc = P.in[ZZ + I_POOLS] + l * 512 + g * 128;
        const float* pw = P.in[ZZ + I_POOLW] + ((size_t)(l * 4 + g) * 128 + cc0) * 128;
#pragma unroll
        for (int i = 0; i < 2; ++i) { const int e = (lane + 64 * i) * 4, d = e & 127; const f32x4 a = *(const f32x4*)(pw + e), b = *(const f32x4*)(sc + d);
            *(LAS f32x4*)(scr + e) = a * b; }
        LDS_WAIT(); asm volatile("" ::: "memory");
        float a[4];
#pragma unroll
        for (int j = 0; j < 4; ++j) a[j] = 0.f;
        for (int d0 = 0; d0 < 128; d0 += 32) {
            float wv[32];
#pragma unroll
            for (int dd = 0; dd < 32; ++dd) wv[dd] = wo[(size_t)(d0 + dd) * 1024];
#pragma unroll
            for (int dd = 0; dd < 32; dd += 4)
#pragma unroll
                for (int j = 0; j < 4; ++j) { const f32x4 p4 = *(const LAS f32x4*)(scr + j * 128 + d0 + dd); a[j] += p4[0] * wv[dd] + p4[1] * wv[dd + 1] + p4[2] * wv[dd + 2] + p4[3] * wv[dd + 3]; }
        }
        u32x2 o; o.x = cvt_pk_bf16(a[0], a[1]); o.y = cvt_pk_bf16(a[2], a[3]);
        *(u32x2*)((bf16_t*)(ws + WS_WPOOL) + (size_t)n * 512 + c0) = o;
        LDS_WAIT(); asm volatile("" ::: "memory");
    }
    for (int tk = gw; tk < 2048; tk += NGW) {
        const int which = tk >> 10, idx = (tk & 1023) * 512 + lane * 8, b = idx >> 16, rem = idx & 65535;
        const float* src = P.in[ZZ + which ? I_CV : I_CK] + (size_t)(b * 2 + l) * 65536 + rem;
        const f32x4 a = *(const f32x4*)src, c = *(const f32x4*)(src + 4);
        u32x4 o; o.x = cvt_pk_bf16(a[0], a[1]); o.y = cvt_pk_bf16(a[2], a[3]); o.z = cvt_pk_bf16(c[0], c[1]); o.w = cvt_pk_bf16(c[2], c[3]);
        *(u32x4*)((bf16_t*)(ws + (which ? WS_CV : WS_CK)) + idx) = o;
    }
    h1_rows2(P, l, gw, NGW, lane);
}

__device__ __forceinline__ float rope_inv(int i) { return exp2f(-(float)i * 0.83048202372184058696f); }
__device__ __forceinline__ float fast_rcp(float x) { return __builtin_amdgcn_rcpf(x); }
__device__ __forceinline__ void qk_norm_8(float (&v)[8], const float (&gn)[8]) {
    float ss = 0.f;
#pragma unroll
    for (int e = 0; e < 8; ++e) ss += v[e] * v[e];
    ss += __shfl_xor(ss, 1); ss += __shfl_xor(ss, 2); ss += __shfl_xor(ss, 4);
    const float rstd = 1.0f / sqrtf(ss * (1.0f / 64.0f) + 1e-6f);
#pragma unroll
    for (int e = 0; e < 8; ++e) v[e] = v[e] * rstd * gn[e];
}
__device__ __forceinline__ void rope_8(float (&v)[8], const float (&cs)[8], const float (&sn)[8], int ch) {
#pragma unroll
    for (int e = 0; e < 8; ++e) { const float own = v[e], oth = __shfl_xor(own, 2); v[e] = (ch & 2) == 0 ? own * cs[e] - oth * sn[e] : oth * sn[e] + own * cs[e]; }
}
__device__ __forceinline__ void qk_prep(const Params& P, int l) {
    const int ZZ = opq0();
    const int tid = threadIdx.x, lane = tid & 63, w = tid >> 6;
    const int gw = blockIdx.x * 8 + w, NGW = gridDim.x * 8;
    bf16_t* Qb = (bf16_t*)(P.ws + ZZ + WS_Q);
    bf16_t* KVb = (bf16_t*)(P.ws + ZZ + WS_KV);
    const float* qg = P.in[ZZ + I_QG] + l * 64;
    const float* kg = P.in[ZZ + I_KG] + l * 64;
    float* ock = P.out + ZZ + OUT_CK;
    const int ch = lane & 7;
    float qgn[8], kgn[8], finv[8];
#pragma unroll
    for (int e = 0; e < 8; ++e) { qgn[e] = qg[8 * ch + e]; kgn[e] = kg[8 * ch + e]; finv[e] = rope_inv(8 * (ch & 1) + e); }
    for (int m0 = 2 * gw; m0 < MTOK; m0 += 2 * NGW) {
        u32x4 qr[2], kr[2];
#pragma unroll
        for (int r = 0; r < 2; ++r) { qr[r] = *((const u32x4*)(Qb + (size_t)(m0 + r) * 512) + lane); kr[r] = *((const u32x4*)(KVb + (size_t)(m0 + r) * 256) + (lane & 15)); }
#pragma unroll
        for (int r = 0; r < 2; ++r) {
            const int m = m0 + r;
            const bool lat = m >= MCTX; const int t = (m - MCTX) & 2047;
            float cs[8], sn[8];
            if (lat) { const float pos = (float)((ch >> 2) == 0 ? (t >> 6) : (t & 63));
#pragma unroll
                for (int e = 0; e < 8; ++e) { const float ang = pos * finv[e]; cs[e] = __cosf(ang); sn[e] = __sinf(ang); } }
            float v[8] = {bf_lo(qr[r].x), bf_hi(qr[r].x), bf_lo(qr[r].y), bf_hi(qr[r].y), bf_lo(qr[r].z), bf_hi(qr[r].z), bf_lo(qr[r].w), bf_hi(qr[r].w)};
            qk_norm_8(v, qgn);
            if (lat) rope_8(v, cs, sn, ch);
            constexpr float QS = 0.125f * 1.4426950408889634f;
            u32x4 o; o.x = cvt_pk_bf16(v[0] * QS, v[1] * QS); o.y = cvt_pk_bf16(v[2] * QS, v[3] * QS); o.z = cvt_pk_bf16(v[4] * QS, v[5] * QS); o.w = cvt_pk_bf16(v[6] * QS, v[7] * QS);
            *((u32x4*)(Qb + (size_t)m * 512) + lane) = o;
            float k[8] = {bf_lo(kr[r].x), bf_hi(kr[r].x), bf_lo(kr[r].y), bf_hi(kr[r].y), bf_lo(kr[r].z), bf_hi(kr[r].z), bf_lo(kr[r].w), bf_hi(kr[r].w)};
            qk_norm_8(k, kgn);
            if (!lat && lane < 16) { float* ok = ock + ((size_t)((m >> 8) * 2 + l) * 256 + (m & 255)) * 128 + lane * 8;
                *(f32x4*)ok = (f32x4){k[0], k[1], k[2], k[3]}; *(f32x4*)(ok + 4) = (f32x4){k[4], k[5], k[6], k[7]}; }
            if (lat) rope_8(k, cs, sn, ch);
            if (lane < 16) { u32x4 ko; ko.x = cvt_pk_bf16(k[0], k[1]); ko.y = cvt_pk_bf16(k[2], k[3]); ko.z = cvt_pk_bf16(k[4], k[5]); ko.w = cvt_pk_bf16(k[6], k[7]); *((u32x4*)(KVb + (size_t)m * 256) + lane) = ko; }
        }
    }
}
constexpr int ATT_UNITS = 768;
__device__ __forceinline__ void attn_unit(const Params& P, int l, LAS unsigned char* lds, int unit, size_t out_off) {
    const int ZZ = opq0();
    const int tid = threadIdx.x, lane = tid & 63, w = tid >> 6, g = lane >> 4, li = lane & 15;
    const bf16_t* Qb = (const bf16_t*)(P.ws + ZZ + WS_Q);
    const bf16_t* KVb = (const bf16_t*)(P.ws + ZZ + WS_KV);
    const bf16_t* CKb = (const bf16_t*)(P.ws + ZZ + WS_CK);
    const bf16_t* CVb = (const bf16_t*)(P.ws + ZZ + WS_CV);
    int lat, b, hp, qb;
    if (unit < 512) { lat = 1; b = unit >> 6; hp = (unit >> 4) & 3; qb = unit & 15; }
    else { const int u2 = unit - 512; lat = 0; b = u2 >> 3; hp = (u2 >> 1) & 3; qb = u2 & 1; }
    const int h0 = 2 * hp, kvh = hp >> 1;
    const int row0 = lat ? MCTX + b * LLAT + qb * 128 : b * LCTX + qb * 128;
    const int qrow = row0 + 16 * w + li;
    const int qpos = qb * 128 + 16 * w + li;
    bf16x8 bq[2][2];
    float m_run[2], l_run[2];
    f32x4 o[2][4];
#pragma unroll
    for (int hh = 0; hh < 2; ++hh) {
        bq[hh][0] = *(const bf16x8*)(Qb + (size_t)qrow * 512 + (h0 + hh) * 64 + 8 * g);
        bq[hh][1] = *(const bf16x8*)(Qb + (size_t)qrow * 512 + (h0 + hh) * 64 + 32 + 8 * g);
        m_run[hh] = P.in[ZZ + I_SINK][l * 8 + h0 + hh] * 1.4426950408889634f;
        l_run[hh] = (g == 0) ? 1.f : 0.f;
#pragma unroll
        for (int i = 0; i < 4; ++i) o[hh][i] = (f32x4){0.f, 0.f, 0.f, 0.f}; }
    const int t_lo = 0, t_hi = lat ? 14 : 4;
    const int kt2 = tid - 256, dp = tid & 31, kb = (tid >> 5) & 7;
    u32x4 pk0, pk1; unsigned pv[8];
#define ATT_TILE_PTRS(T, KP, VP, STRIDE, KPOS0, MASKED, VALID) do { VALID = true; MASKED = false; KPOS0 = 0; \
        if (!lat) { KP = KVb + (size_t)(b * LCTX + 64 * (T)) * 256 + kvh * 64; VP = KP + 128; STRIDE = 256; } \
        else if ((T) < 8) { KP = CKb + (size_t)(b * PAST + 64 * (T)) * 128 + kvh * 64; VP = CVb + (size_t)(b * PAST + 64 * (T)) * 128 + kvh * 64; STRIDE = 128; } \
        else { const int blk_ = qb - 1 + (((T) - 8) >> 1); VALID = !(blk_ < 0 || blk_ > 15); KPOS0 = blk_ * 128 + (((T) - 8) & 1) * 64; \
            KP = KVb + (size_t)(MCTX + b * LLAT + (VALID ? KPOS0 : 0)) * 256 + kvh * 64; VP = KP + 128; STRIDE = 256; MASKED = true; } } while (0)
#define ATT_PREFETCH(T) do { const bf16_t *kp_, *vp_; int st_, k0_; bool mk_, ok_; ATT_TILE_PTRS(T, kp_, vp_, st_, k0_, mk_, ok_); \
        if (ok_) { if (tid >= 256) { pk0 = *(const u32x4*)(kp_ + (size_t)(kt2 >> 3) * st_ + (kt2 & 7) * 8); pk1 = *(const u32x4*)(kp_ + (size_t)((kt2 + 256) >> 3) * st_ + (kt2 & 7) * 8); } \
            else { _Pragma("unroll") for (int j = 0; j < 8; ++j) pv[j] = *(const unsigned*)(vp_ + (size_t)(8 * kb + j) * st_ + 2 * dp); } } } while (0)
    ATT_PREFETCH(t_lo);
    for (int t = t_lo; t < t_hi; ++t) {
        const bf16_t *kp, *vp; int stride, kpos0; bool masked, valid;
        ATT_TILE_PTRS(t, kp, vp, stride, kpos0, masked, valid);
        if (!valid) { if (t + 1 < t_hi) ATT_PREFETCH(t + 1); continue; }
        LDS_BARRIER();
        if (tid >= 256) {
            { const int key = kt2 >> 3, ch = kt2 & 7; *(LAS u32x4*)(lds + key * 128 + ((ch ^ (key & 7)) << 4)) = pk0; }
            { const int key = (kt2 + 256) >> 3, ch = kt2 & 7; *(LAS u32x4*)(lds + key * 128 + ((ch ^ (key & 7)) << 4)) = pk1; }
        } else {
            u32x4 lo, hi;
            lo.x = (pv[0] & 0xffffu) | (pv[1] << 16); lo.y = (pv[2] & 0xffffu) | (pv[3] << 16); lo.z = (pv[4] & 0xffffu) | (pv[5] << 16); lo.w = (pv[6] & 0xffffu) | (pv[7] << 16);
            hi.x = (pv[0] >> 16) | (pv[1] & 0xffff0000u); hi.y = (pv[2] >> 16) | (pv[3] & 0xffff0000u); hi.z = (pv[4] >> 16) | (pv[5] & 0xffff0000u); hi.w = (pv[6] >> 16) | (pv[7] & 0xffff0000u);
            const int d0 = 2 * dp, d1 = d0 + 1;
            *(LAS u32x4*)(lds + 8192 + d0 * 128 + ((kb ^ (d0 & 7)) << 4)) = lo;
            *(LAS u32x4*)(lds + 8192 + d1 * 128 + ((kb ^ (d1 & 7)) << 4)) = hi;
        }
        if (t + 1 < t_hi) ATT_PREFETCH(t + 1);
        LDS_BARRIER();
        if (masked) { const int q0w = qb * 128 + 16 * w;
            if (kpos0 + 63 < q0w - 128 || kpos0 > q0w + 15 + 128) continue; }
        bf16x8 bp[2][2];
        {
            bf16x8 ka[4][2];
#pragma unroll
            for (int mt = 0; mt < 4; ++mt) { const int key = 16 * mt + li;
#pragma unroll
                for (int ks = 0; ks < 2; ++ks) { const int ch = 4 * ks + g; ka[mt][ks] = *(const LAS bf16x8*)(lds + key * 128 + ((ch ^ (key & 7)) << 4)); } }
#pragma unroll
            for (int hh = 0; hh < 2; ++hh) {
                f32x4 s[4];
#pragma unroll
                for (int mt = 0; mt < 4; ++mt) { s[mt] = (f32x4){0.f, 0.f, 0.f, 0.f};
#pragma unroll
                    for (int ks = 0; ks < 2; ++ks) s[mt] = __builtin_amdgcn_mfma_f32_16x16x32_bf16(ka[mt][ks], bq[hh][ks], s[mt], 0, 0, 0); }
                if (masked) {
#pragma unroll
                    for (int mt = 0; mt < 4; ++mt)
#pragma unroll
                        for (int r = 0; r < 4; ++r) { const int kpos = kpos0 + 16 * mt + 4 * g + r; const int df = qpos - kpos; if (df > 128 || df < -128) s[mt][r] = -INFINITY; }
                }
                float mx = -INFINITY;
#pragma unroll
                for (int mt = 0; mt < 4; ++mt) mx = fmaxf(mx, fmaxf(fmaxf(s[mt][0], s[mt][1]), fmaxf(s[mt][2], s[mt][3])));
                mx = fmaxf(mx, __shfl_xor(mx, 16)); mx = fmaxf(mx, __shfl_xor(mx, 32));
                const float m_new = fmaxf(m_run[hh], mx);
                if (!__all(mx <= m_run[hh])) {
                    const float alpha = __builtin_amdgcn_exp2f(m_run[hh] - m_new); l_run[hh] *= alpha;
#pragma unroll
                    for (int i = 0; i < 4; ++i) o[hh][i] = o[hh][i] * alpha;
                }
                m_run[hh] = m_new;
                float ps = 0.f;
#pragma unroll
                for (int mt = 0; mt < 4; ++mt)
#pragma unroll
                    for (int r = 0; r < 4; ++r) { s[mt][r] = __builtin_amdgcn_exp2f(s[mt][r] - m_new); ps += s[mt][r]; }
                l_run[hh] += ps;
#pragma unroll
                for (int s2 = 0; s2 < 2; ++s2) { u32x4 pk; pk.x = cvt_pk_bf16(s[2 * s2][0], s[2 * s2][1]); pk.y = cvt_pk_bf16(s[2 * s2][2], s[2 * s2][3]);
                    pk.z = cvt_pk_bf16(s[2 * s2 + 1][0], s[2 * s2 + 1][1]); pk.w = cvt_pk_bf16(s[2 * s2 + 1][2], s[2 * s2 + 1][3]); bp[hh][s2] = __builtin_bit_cast(bf16x8, pk); }
            }
        }
#pragma unroll
        for (int dt = 0; dt < 4; ++dt) { const int d = 16 * dt + li;
#pragma unroll
            for (int s2 = 0; s2 < 2; ++s2) {
                const u32x2 lo8 = *(const LAS u32x2*)(lds + 8192 + d * 128 + (((4 * s2 + (g >> 1)) ^ (d & 7)) << 4) + 8 * (g & 1));
                const u32x2 hi8 = *(const LAS u32x2*)(lds + 8192 + d * 128 + (((4 * s2 + 2 + (g >> 1)) ^ (d & 7)) << 4) + 8 * (g & 1));
                u32x4 av; av.x = lo8.x; av.y = lo8.y; av.z = hi8.x; av.w = hi8.y;
#pragma unroll
                for (int hh = 0; hh < 2; ++hh) o[hh][dt] = __builtin_amdgcn_mfma_f32_16x16x32_bf16(__builtin_bit_cast(bf16x8, av), bp[hh][s2], o[hh][dt], 0, 0, 0); } }
    }
#undef ATT_PREFETCH
#undef ATT_TILE_PTRS
#pragma unroll
    for (int hh = 0; hh < 2; ++hh) {
        float lr = l_run[hh]; lr += __shfl_xor(lr, 16); lr += __shfl_xor(lr, 32);
        const float inv = 1.0f / lr;
#pragma unroll
        for (int dt = 0; dt < 4; ++dt) { const f32x4 x = o[hh][dt] * inv; u32x2 wv; wv.x = cvt_pk_bf16(x[0], x[1]); wv.y = cvt_pk_bf16(x[2], x[3]);
            *(u32x2*)((bf16_t*)(P.ws + ZZ + out_off) + (size_t)qrow * 512 + (h0 + hh) * 64 + 16 * dt + 4 * g) = wv; } }
}
__device__ __forceinline__ void bc_conv(const Params& P, int l) {
    const int ZZ = opq0();
    const bf16_t* X = (const bf16_t*)(P.ws + ZZ + WS_BCR);
    bf16_t* BC = (bf16_t*)(P.ws + ZZ + WS_BC);
    const int nthr = gridDim.x * 512, t0 = blockIdx.x * 512 + threadIdx.x;
    const int c = 8 * (t0 & 63);
    const float* cw = P.in[ZZ + I_CONVW] + (size_t)l * 5 * 1536 + 1024 + c;
    const float* cb = P.in[ZZ + I_CONVB] + (size_t)l * 1536 + 1024 + c;
    float wt[5][8], bs[8];
#pragma unroll
    for (int j = 0; j < 5; ++j) { const f32x4 a0 = *(const f32x4*)(cw + j * 1536), a1 = *(const f32x4*)(cw + j * 1536 + 4);
#pragma unroll
        for (int e = 0; e < 4; ++e) { wt[j][e] = a0[e]; wt[j][4 + e] = a1[e]; } }
    { const f32x4 a0 = *(const f32x4*)cb, a1 = *(const f32x4*)(cb + 4);
#pragma unroll
      for (int e = 0; e < 4; ++e) { bs[e] = a0[e]; bs[4 + e] = a1[e]; } }
    const int grp = (c >> 7) & 1, dcol = (c >> 8) * 128 + (c & 127);
    for (int task = t0; task < (MTOK / 4) * 64; task += nthr) {
        const int row = (task >> 6) * 4;
        int t, L; if (row < MCTX) { t = row & 255; L = LCTX; } else { t = (row - MCTX) & 2047; L = LLAT; }
        u32x4 raw[8];
#pragma unroll
        for (int i = 0; i < 8; ++i) { const int tt = t - 2 + i; u32x4 u = (u32x4){0u, 0u, 0u, 0u}; if (tt >= 0 && tt < L) u = *(const u32x4*)(X + (size_t)(row - 2 + i) * 512 + c); raw[i] = u; }
#pragma unroll
        for (int i = 0; i < 4; ++i) { float a[8];
#pragma unroll
            for (int e = 0; e < 8; ++e) a[e] = bs[e];
#pragma unroll
            for (int j = 0; j < 5; ++j) { const u32x4 u = raw[i + j];
                a[0] += wt[j][0] * bf_lo(u.x); a[1] += wt[j][1] * bf_hi(u.x); a[2] += wt[j][2] * bf_lo(u.y); a[3] += wt[j][3] * bf_hi(u.y);
                a[4] += wt[j][4] * bf_lo(u.z); a[5] += wt[j][5] * bf_hi(u.z); a[6] += wt[j][6] * bf_lo(u.w); a[7] += wt[j][7] * bf_hi(u.w); }
            u32x4 o; o.x = cvt_pk_bf16(silu_f(a[0]), silu_f(a[1])); o.y = cvt_pk_bf16(silu_f(a[2]), silu_f(a[3])); o.z = cvt_pk_bf16(silu_f(a[4]), silu_f(a[5])); o.w = cvt_pk_bf16(silu_f(a[6]), silu_f(a[7]));
            *(u32x4*)(BC + ((size_t)grp * MTOK + row + i) * 256 + dcol) = o; }
    }
}
__device__ __forceinline__ void phase_attn(const Params& P, int l, LAS unsigned char* lds, size_t out_off, int first, int stride, int nunits) {
    for (int u = first; u < nunits; u += stride) attn_unit(P, l, lds, u, out_off);
}

__device__ __forceinline__ void ssd_unit(const Params& P, int l, LAS unsigned char* lds, int lat, int b, int h, int dir) {
    const int ZZ = opq0();
    const int tid = threadIdx.x, p = tid >> 3, ns = tid & 7;
    const int L = lat ? LLAT : LCTX, row0 = lat ? MCTX + b * LLAT : b * LCTX, grp = h >> 3;
    const float A = -__expf(P.in[ZZ + I_ALOG][l * 32 + dir * 16 + h]);
    const float Dsk = P.in[ZZ + I_DSKIP][l * 16 + h];
    const float dtbias = P.in[ZZ + I_DTB][l * 32 + dir * 16 + h];
    const bf16_t* X = (const bf16_t*)(P.ws + ZZ + WS_XBC);
    const bf16_t* BC = (const bf16_t*)(P.ws + ZZ + WS_BC);
    const float* DT = (const float*)(P.ws + ZZ + WS_DT);
    bf16_t* Y = (bf16_t*)((unsigned char*)(P.out + ZZ) + OUTB_Y);
    bf16_t* Z = (bf16_t*)(P.ws + ZZ + WS_Z);
    LAS float* xs = (LAS float*)lds;
    LAS float* Bs = (LAS float*)(lds + 16384);
    LAS float* Cs = (LAS float*)(lds + 49152);
    LAS float* yb = (LAS float*)(lds + 81920);
    LAS float* dts = (LAS float*)(lds + 98304);
    LAS float* das = (LAS float*)(lds + 98304 + 256);
    float S[16];
    if (lat) { const float* sp = P.in[ZZ + I_ST] + ((size_t)((((b * 2 + l) * 2 + dir) * 16 + h) * 64 + p)) * 128 + ns * 16;
#pragma unroll
        for (int i = 0; i < 4; ++i) { const f32x4 v = *(const f32x4*)(sp + 4 * i); S[4 * i] = v[0]; S[4 * i + 1] = v[1]; S[4 * i + 2] = v[2]; S[4 * i + 3] = v[3]; } }
    else {
#pragma unroll
        for (int i = 0; i < 16; ++i) S[i] = 0.f; }
    const float* cw = P.in[ZZ + I_CONVW] + (size_t)l * 5 * 1536 + h * 64;
    const float* cb = P.in[ZZ + I_CONVB] + (size_t)l * 1536 + h * 64;
    const int nck = L / 64;
    for (int ck = 0; ck < nck; ++ck) {
        const int t0 = dir == 0 ? ck * 64 : L - 64 - ck * 64;
        __syncthreads();
        {
            const int tt = tid >> 3, c0 = (tid & 7) * 16; const bf16_t* src = BC + (size_t)(row0 + t0 + tt) * 512 + grp * 128 + c0;
#pragma unroll
            for (int hf = 0; hf < 2; ++hf) { const u32x4 bq = *(const u32x4*)(src + hf * 8), cq = *(const u32x4*)(src + 256 + hf * 8);
                *(LAS f32x4*)(Bs + tt * 128 + c0 + hf * 8) = (f32x4){bf_lo(bq.x), bf_hi(bq.x), bf_lo(bq.y), bf_hi(bq.y)};
                *(LAS f32x4*)(Bs + tt * 128 + c0 + hf * 8 + 4) = (f32x4){bf_lo(bq.z), bf_hi(bq.z), bf_lo(bq.w), bf_hi(bq.w)};
                *(LAS f32x4*)(Cs + tt * 128 + c0 + hf * 8) = (f32x4){bf_lo(cq.x), bf_hi(cq.x), bf_lo(cq.y), bf_hi(cq.y)};
                *(LAS f32x4*)(Cs + tt * 128 + c0 + hf * 8 + 4) = (f32x4){bf_lo(cq.z), bf_hi(cq.z), bf_lo(cq.w), bf_hi(cq.w)}; }
        }
        if (tid < 64) { const float xr = DT[(size_t)(row0 + t0 + tid) * 32 + dir * 16 + h] + dtbias; const float dtv = fmaxf(xr, 0.f) + log1pf(__expf(-fabsf(xr))); dts[tid] = dtv; das[tid] = __expf(dtv * A); }
        {
            const int p2 = tid & 31, tr = tid >> 5, c = 2 * p2, tl = 4 * tr;
            float raw0[8], raw1[8];
#pragma unroll
            for (int i = 0; i < 8; ++i) { const int tt = t0 + tl - 2 + i; unsigned u = 0u; if (tt >= 0 && tt < L) u = *(const unsigned*)(X + (size_t)(row0 + tt) * 1536 + h * 64 + c); raw0[i] = bf_lo(u); raw1[i] = bf_hi(u); }
            float w0[5], w1[5];
#pragma unroll
            for (int j = 0; j < 5; ++j) { w0[j] = cw[j * 1536 + c]; w1[j] = cw[j * 1536 + c + 1]; }
            const float b0 = cb[c], b1 = cb[c + 1];
#pragma unroll
            for (int i = 0; i < 4; ++i) { float a0 = b0, a1 = b1;
#pragma unroll
                for (int j = 0; j < 5; ++j) { a0 += w0[j] * raw0[i + j]; a1 += w1[j] * raw1[i + j]; }
                *(LAS f32x2*)(xs + (tl + i) * 64 + c) = (f32x2){silu_f(a0), silu_f(a1)}; }
        }
        __syncthreads();
        for (int st = 0; st < 64; ++st) {
            const int tt = dir == 0 ? st : 63 - st;
            const float da = das[tt], dx = dts[tt] * xs[tt * 64 + p];
            float yp = 0.f;
#pragma unroll
            for (int i = 0; i < 4; ++i) { const f32x4 bv = *(const LAS f32x4*)(Bs + tt * 128 + ns * 16 + 4 * i), cv = *(const LAS f32x4*)(Cs + tt * 128 + ns * 16 + 4 * i);
#pragma unroll
                for (int e = 0; e < 4; ++e) { S[4 * i + e] = S[4 * i + e] * da + dx * bv[e]; yp += cv[e] * S[4 * i + e]; } }
            yp += __shfl_xor(yp, 1); yp += __shfl_xor(yp, 2); yp += __shfl_xor(yp, 4);
            if (ns == 0) yb[tt * 64 + p] = yp;
        }
        __syncthreads();
        {
            const int tt = tid >> 3, p0 = (tid & 7) * 8; const size_t off = (size_t)(row0 + t0 + tt) * 1024 + h * 64 + p0;
            const f32x4 ya = *(const LAS f32x4*)(yb + tt * 64 + p0), yc = *(const LAS f32x4*)(yb + tt * 64 + p0 + 4);
            float yv[8] = {ya[0], ya[1], ya[2], ya[3], yc[0], yc[1], yc[2], yc[3]};
            if (dir == 0) {
                u32x4 o; o.x = cvt_pk_bf16(yv[0], yv[1]); o.y = cvt_pk_bf16(yv[2], yv[3]); o.z = cvt_pk_bf16(yv[4], yv[5]); o.w = cvt_pk_bf16(yv[6], yv[7]);
                *(u32x4*)(Y + off) = o;
            } else {
                const u32x4 yq = *(const u32x4*)(Y + off), zq = *(const u32x4*)(Z + off);
                const f32x4 xa = *(const LAS f32x4*)(xs + tt * 64 + p0), xc = *(const LAS f32x4*)(xs + tt * 64 + p0 + 4);
                const float yf[8] = {bf_lo(yq.x), bf_hi(yq.x), bf_lo(yq.y), bf_hi(yq.y), bf_lo(yq.z), bf_hi(yq.z), bf_lo(yq.w), bf_hi(yq.w)};
                const float zf[8] = {bf_lo(zq.x), bf_hi(zq.x), bf_lo(zq.y), bf_hi(zq.y), bf_lo(zq.z), bf_hi(zq.z), bf_lo(zq.w), bf_hi(zq.w)};
                const float xf[8] = {xa[0], xa[1], xa[2], xa[3], xc[0], xc[1], xc[2], xc[3]};
                float r[8];
#pragma unroll
                for (int e = 0; e < 8; ++e) r[e] = (yf[e] + yv[e] + Dsk * xf[e]) * silu_f(zf[e]);
                u32x4 o; o.x = cvt_pk_bf16(r[0], r[1]); o.y = cvt_pk_bf16(r[2], r[3]); o.z = cvt_pk_bf16(r[4], r[5]); o.w = cvt_pk_bf16(r[6], r[7]);
                *(u32x4*)(Z + off) = o;
            }
        }
    }
    if (!lat) { float* sp = P.out + ZZ + OUT_ST + ((size_t)((((b * 2 + l) * 2 + dir) * 16 + h) * 64 + p)) * 128 + ns * 16;
#pragma unroll
        for (int i = 0; i < 4; ++i) *(f32x4*)(sp + 4 * i) = (f32x4){S[4 * i], S[4 * i + 1], S[4 * i + 2], S[4 * i + 3]}; }
}
__device__ __forceinline__ void phase_ssd(const Params& P, int l, LAS unsigned char* lds, int dir) {
    for (int u = blockIdx.x; u < 640; u += gridDim.x) {
        if (u < 128) ssd_unit(P, l, lds, 1, u >> 4, u & 15, dir);
        else { const int u2 = u - 128; ssd_unit(P, l, lds, 0, u2 >> 4, u2 & 15, dir); }
    }
}

__device__ __forceinline__ void pooled_rows(const Params& P, int gw, int NGW, int lane) {
    const int ZZ = opq0();
    const bf16_t* PU = (const bf16_t*)(P.ws + ZZ + WS_PU);
    bf16_t* PO = (bf16_t*)(P.ws + ZZ + WS_POOLED);
    {
        const int hw = 1 << (lane >> 4);
        float wgt[16];
#pragma unroll
        for (int dk = -8; dk < 8; ++dk) wgt[dk + 8] = (dk >= -hw && dk < hw) ? 1.f : 0.f;
        for (int task = gw; task < MTOK / 4; task += NGW) {
            const int r0 = task * 4;
            int t0, L; if (r0 < MCTX) { t0 = r0 & 255; L = LCTX; } else { t0 = (r0 - MCTX) & 2047; L = LLAT; }
            u32x4 rows[20];
#pragma unroll
            for (int k = 0; k < 20; ++k) { const int tt = t0 + k - 8; rows[k] = (u32x4){0u, 0u, 0u, 0u}; if (tt >= 0 && tt < L) rows[k] = *(const u32x4*)(PU + (size_t)(r0 + k - 8) * 512 + lane * 8); }
#pragma unroll
            for (int j = 0; j < 4; ++j) {
                float a[8];
#pragma unroll
                for (int e = 0; e < 8; ++e) a[e] = 0.f;
#pragma unroll
                for (int dk = 0; dk < 16; ++dk) { const u32x4 q = rows[j + dk]; const float ww = wgt[dk];
                    a[0] += ww * bf_lo(q.x); a[1] += ww * bf_hi(q.x); a[2] += ww * bf_lo(q.y); a[3] += ww * bf_hi(q.y); a[4] += ww * bf_lo(q.z); a[5] += ww * bf_hi(q.z); a[6] += ww * bf_lo(q.w); a[7] += ww * bf_hi(q.w); }
                const int t = t0 + j, lo = t - hw < 0 ? 0 : t - hw, hi = t + hw > L ? L : t + hw;
                const float ic = 1.0f / (float)(hi - lo);
                const u32x4 q = rows[j + 8];
                const float uu[8] = {bf_lo(q.x), bf_hi(q.x), bf_lo(q.y), bf_hi(q.y), bf_lo(q.z), bf_hi(q.z), bf_lo(q.w), bf_hi(q.w)};
#pragma unroll
                for (int e = 0; e < 8; ++e) a[e] = a[e] * ic - uu[e];
                u32x4 o; o.x = cvt_pk_bf16(a[0], a[1]); o.y = cvt_pk_bf16(a[2], a[3]); o.z = cvt_pk_bf16(a[4], a[5]); o.w = cvt_pk_bf16(a[6], a[7]);
                *(u32x4*)(PO + (size_t)(r0 + j) * 512 + lane * 8) = o;
            }
        }
    }
}
__device__ __forceinline__ void ssq_sum(const Params& P) {
    const int ZZ = opq0();
    const float* sh = (const float*)(P.ws + ZZ + WS_SSQH);
    for (int m = blockIdx.x * 512 + threadIdx.x; m < MTOK; m += gridDim.x * 512) { float s = 0.f;
#pragma unroll
        for (int h = 0; h < 16; ++h) s += sh[(size_t)h * MTOK + m];
        ((float*)(P.ws + ZZ + WS_SSQ))[m] = s; }
}
__device__ __forceinline__ void phase_h2(const Params& P, int l) {
    const int ZZ = opq0();
    const int tid = threadIdx.x, lane = tid & 63, w = tid >> 6;
    const int gw = blockIdx.x * 8 + w, NGW = gridDim.x * 8;
    const float* MOD = (const float*)(P.ws + ZZ + WS_MOD) + (size_t)l * 9 * 6144;
    norm_rows_x(P, ZZ, P.in[ZZ + I_N2G] + l * 1024, MOD, 3072, 4096, gw, NGW, lane);
}
__device__ __forceinline__ void dt_prepass(const Params& P, int l) {
    const int ZZ = opq0();
    const int tid = threadIdx.x, lane = tid & 63, w = tid >> 6;
    const int gw = blockIdx.x * 8 + w, NGW = gridDim.x * 8;
    const float* DT = (const float*)(P.ws + ZZ + WS_DT); float* DTS = (float*)(P.ws + ZZ + WS_DTS); float* CUM = (float*)(P.ws + ZZ + WS_CUM2);
    constexpr int NT = 3;
    for (int task0 = gw; task0 < 192 * 32; task0 += NT * NGW) {
        float xr0[NT], xr1[NT];
#pragma unroll
        for (int k = 0; k < NT; ++k) { const int task = task0 + k * NGW; xr0[k] = 0.f; xr1[k] = 0.f;
            if (task < 192 * 32) { const size_t i0 = (size_t)((task >> 5) * 128 + 2 * lane) * 32 + (task & 31); xr0[k] = DT[i0]; xr1[k] = DT[i0 + 32]; } }
#pragma unroll
        for (int k = 0; k < NT; ++k) { const int task = task0 + k * NGW; if (task >= 192 * 32) break;
            const int hd = task & 31, rbase = (task >> 5) * 128;
            const float A = -__expf(P.in[ZZ + I_ALOG][l * 32 + hd]), bias = P.in[ZZ + I_DTB][l * 32 + hd];
            const size_t o0 = (size_t)hd * MTOK + rbase + 2 * lane;
            const float x0 = xr0[k] + bias, x1 = xr1[k] + bias;
            const float d0 = fmaxf(x0, 0.f) + log1pf(__expf(-fabsf(x0))), d1 = fmaxf(x1, 0.f) + log1pf(__expf(-fabsf(x1)));
            const float a0 = d0 * A, a1 = d1 * A, pair = a0 + a1;
            float s = pair;
            if (hd < 16) {
#pragma unroll
                for (int dlt = 1; dlt < 64; dlt <<= 1) { const float v = __shfl_up(s, dlt); if (lane >= dlt) s += v; }
                const float ex = s - pair; *(f32x2*)(CUM + o0) = (f32x2){ex + a0, ex + pair};
            } else {
#pragma unroll
                for (int dlt = 1; dlt < 64; dlt <<= 1) { const float v = __shfl_down(s, dlt); if (lane + dlt < 64) s += v; }
                const float ex = s - pair; *(f32x2*)(CUM + o0) = (f32x2){ex + pair, ex + a1};
            }
            *(f32x2*)(DTS + o0) = (f32x2){d0, d1};
        }
    }
}
constexpr int SL_C = 0, SL_B = 32768, SL_XT = 65536, SL_XE = 81920, SL_SB = 98304  , SL_CUM = 131072, SL_DT = 131584;
__device__ __forceinline__ unsigned short bf16_1(float x) { return (unsigned short)(cvt_pk_bf16_c(x, x) & 0xffffu); }
__device__ __forceinline__ void ssd_chain(const Params& P, int l, LAS unsigned char* lds, int lat, int b, int h, int dir, bool dry) {
    const int ZZ = opq0();
    const int tid = threadIdx.x, lane = tid & 63, w = __builtin_amdgcn_readfirstlane(tid >> 6), g = lane >> 4, li = lane & 15;
    const int L = lat ? LLAT : LCTX, row0 = lat ? MCTX + b * LLAT : b * LCTX, grp = h >> 3, hd = dir * 16 + h, nck = L / 128;
    const float Dsk = P.in[ZZ + I_DSKIP][l * 16 + h];
    const bf16_t* X = (const bf16_t*)(P.ws + ZZ + WS_X2) + (size_t)h * MTOK * 64;
    const bf16_t* BC = (const bf16_t*)(P.ws + ZZ + WS_BC) + (size_t)grp * MTOK * 256;
    const float* DT = (const float*)(P.ws + ZZ + WS_DTS) + (size_t)hd * MTOK;
    const float* CUM = (const float*)(P.ws + ZZ + WS_CUM2) + (size_t)hd * MTOK;
    bf16_t* Y = (bf16_t*)((unsigned char*)(P.out + ZZ) + OUTB_Y) + (size_t)h * MTOK * 64;
    bf16_t* Z = (bf16_t*)(P.ws + ZZ + WS_Z);
    const float* cw = P.in[ZZ + I_CONVW] + (size_t)l * 5 * 1536 + h * 64;
    const float* cb = P.in[ZZ + I_CONVB] + (size_t)l * 1536 + h * 64;
    LAS float* cumL = (LAS float*)(lds + SL_CUM);
    LAS float* dtL = (LAS float*)(lds + SL_DT);
    const int pt_s = w & 3, nt0 = 4 * (w >> 2);
    f32x4 Sacc[4];
    if (lat) { const float* sp = P.in[ZZ + I_ST] + (size_t)((((b * 2 + l) * 2 + dir) * 16 + h) * 64) * 128;
#pragma unroll
        for (int k = 0; k < 4; ++k)
#pragma unroll
            for (int r = 0; r < 4; ++r) Sacc[k][r] = sp[(size_t)(16 * pt_s + 4 * g + r) * 128 + 16 * (nt0 + k) + li]; }
    else {
#pragma unroll
        for (int k = 0; k < 4; ++k) Sacc[k] = (f32x4){0.f, 0.f, 0.f, 0.f}; }
    int sb = 0;
#define SSD_WRITE_SB(sel) do { _Pragma("unroll") for (int k = 0; k < 4; ++k) _Pragma("unroll") for (int r = 0; r < 4; ++r) { const int p_ = 16 * pt_s + 4 * g + r, n_ = 16 * (nt0 + k) + li; \
        *(LAS unsigned short*)(lds + SL_SB + (sel) * 16384 + p_ * 256 + ((((n_ >> 3) ^ (p_ & 15))) << 4) + (n_ & 7) * 2) = bf16_1(Sacc[k][r]); } } while (0)
    const int st_c = 2 * (tid & 31), st_jr = tid >> 5;
    float cw0[5], cw1[5];
#pragma unroll
    for (int j = 0; j < 5; ++j) { cw0[j] = cw[j * 1536 + st_c]; cw1[j] = cw[j * 1536 + st_c + 1]; }
    const float cb0 = cb[st_c], cb1 = cb[st_c + 1];
    float pf_cum, pf_dt, pf_tot; u32x4 pf_b[4], pf_c[4]; unsigned pf_x[12]; float pf_xdt[8], pf_xcum[8];
    const unsigned vo_bc = (unsigned)((tid >> 4) * 512 + (tid & 15) * 16);
    const unsigned vo_x = (unsigned)(st_jr * 1024 + st_c * 2);
    const unsigned vo_dt = (unsigned)(st_jr * 32);
    const unsigned vo_t = (unsigned)((tid & 127) * 4);
#define SSD_PREFETCH(CK) do { const int t0_ = (dir == 0 ? (CK) : nck - 1 - (CK)) * 128; const size_t rb_ = (size_t)row0 + t0_; \
        const char* bcb_ = (const char*)(BC + rb_ * 256); const char* xb_ = (const char*)(X + ((ptrdiff_t)rb_ - 2) * 64); const char* dtb_ = (const char*)(DT + rb_); const char* cmb_ = (const char*)(CUM + rb_); \
        if (tid < 128) { pf_cum = *(const float*)(cmb_ + vo_t); pf_dt = *(const float*)(dtb_ + vo_t); } \
        pf_tot = *(const float*)(cmb_ + (dir == 0 ? 127 * 4 : 0)); \
        _Pragma("unroll") for (int k = 0; k < 4; ++k) { pf_b[k] = *(const u32x4*)(bcb_ + k * 16384 + vo_bc); pf_c[k] = *(const u32x4*)(bcb_ + k * 16384 + 256 + vo_bc); } \
        _Pragma("unroll") for (int e = 0; e < 12; ++e) pf_x[e] = *(const unsigned*)(xb_ + e * 128 + vo_x); \
        { const bool lo_bad = (t0_ == 0 && st_jr == 0), hi_bad = (t0_ + 128 == L && st_jr == 15);     \
          if (lo_bad) { pf_x[0] = 0u; pf_x[1] = 0u; } if (hi_bad) { pf_x[10] = 0u; pf_x[11] = 0u; } } \
        { const f32x4 d0_ = *(const f32x4*)(dtb_ + vo_dt), d1_ = *(const f32x4*)(dtb_ + 16 + vo_dt), c0_ = *(const f32x4*)(cmb_ + vo_dt), c1_ = *(const f32x4*)(cmb_ + 16 + vo_dt); \
          _Pragma("unroll") for (int e = 0; e < 4; ++e) { pf_xdt[e] = d0_[e]; pf_xdt[4 + e] = d1_[e]; pf_xcum[e] = c0_[e]; pf_xcum[4 + e] = c1_[e]; } } } while (0)
    __syncthreads();
    SSD_WRITE_SB(0);
    SSD_PREFETCH(0);
#ifdef SSD_TS
    unsigned long long ts_acc0 = 0, ts_acc1 = 0, ts_acc2 = 0, ts_acc3 = 0, ts_acc4 = 0, ts_prev = __builtin_amdgcn_s_memrealtime();
#define TS_MARK(A) do { const unsigned long long t_ = __builtin_amdgcn_s_memrealtime(); A += t_ - ts_prev; ts_prev = t_; } while (0)
#else
#define TS_MARK(A) do { } while (0)
#endif
    for (int ck = 0; ck < nck; ++ck) {
        const int t0 = (dir == 0 ? ck : nck - 1 - ck) * 128;
        const size_t rbase = (size_t)row0 + t0;
        LDS_BARRIER();
        TS_MARK(ts_acc0);
        if (tid < 128) { cumL[tid] = pf_cum * 1.4426950408889634f; dtL[tid] = pf_dt; }
        const float tot = pf_tot;
#pragma unroll
        for (int k = 0; k < 4; ++k) { const int idx = tid + 512 * k, row = idx >> 4, ch = idx & 15;
            *(LAS u32x4*)(lds + SL_B + row * 256 + ((ch ^ (row & 15)) << 4)) = pf_b[k];
            *(LAS u32x4*)(lds + SL_C + row * 256 + ((ch ^ (row & 15)) << 4)) = pf_c[k]; }
#ifdef SSD_TS2
        TS_MARK(ts_acc1);
#endif
        {
            const int c = st_c, jr = st_jr;
            f32x2 x2[12];
#pragma unroll
            for (int e = 0; e < 12; ++e) x2[e] = (f32x2){bf_lo(pf_x[e]), bf_hi(pf_x[e])};
            f32x2 xv[8], xe[8];
#pragma unroll
            for (int e = 0; e < 8; ++e) { f32x2 a = (f32x2){cb0, cb1};
#pragma unroll
                for (int j = 0; j < 5; ++j) a = __builtin_elementwise_fma((f32x2){cw0[j], cw1[j]}, x2[e + j], a);
                const f32x2 sl = (f32x2){silu_f(a[0]), silu_f(a[1])};
                xv[e] = sl * pf_xdt[e]; xe[e] = xv[e] * __expf(tot - pf_xcum[e]); }
#pragma unroll
            for (int hf = 0; hf < 2; ++hf) { const int cc = c + hf, o = cc * 256 + ((jr ^ (cc & 15)) << 4);
                u32x4 q; q.x = cvt_pk_bf16_c(xv[0][hf], xv[1][hf]); q.y = cvt_pk_bf16_c(xv[2][hf], xv[3][hf]); q.z = cvt_pk_bf16_c(xv[4][hf], xv[5][hf]); q.w = cvt_pk_bf16_c(xv[6][hf], xv[7][hf]);
                *(LAS u32x4*)(lds + SL_XT + o) = q;
                q.x = cvt_pk_bf16_c(xe[0][hf], xe[1][hf]); q.y = cvt_pk_bf16_c(xe[2][hf], xe[3][hf]); q.z = cvt_pk_bf16_c(xe[4][hf], xe[5][hf]); q.w = cvt_pk_bf16_c(xe[6][hf], xe[7][hf]);
                *(LAS u32x4*)(lds + SL_XE + o) = q; }
        }
#ifdef SSD_TS2
        TS_MARK(ts_acc2);
#endif
        if (ck + 1 < nck) SSD_PREFETCH(ck + 1);
#ifdef SSD_TS2
        TS_MARK(ts_acc3);
#else
        TS_MARK(ts_acc1);
#endif
        LDS_BARRIER();
#ifndef SSD_TS2
        TS_MARK(ts_acc2);
#endif
        const int i = 16 * w + li;
        const float cum_i = cumL[i];
        bf16x8 cf[4];
#pragma unroll
        for (int ks = 0; ks < 4; ++ks) cf[ks] = *(const LAS bf16x8*)(lds + SL_C + i * 256 + (((4 * ks + g) ^ (i & 15)) << 4));
        f32x4 y[4];
#pragma unroll
        for (int pt = 0; pt < 4; ++pt) { y[pt] = (f32x4){0.f, 0.f, 0.f, 0.f}; const int p = 16 * pt + li;
#pragma unroll
            for (int ks = 0; ks < 4; ++ks) { const bf16x8 a = *(const LAS bf16x8*)(lds + SL_SB + sb * 16384 + p * 256 + (((4 * ks + g) ^ (p & 15)) << 4));
                y[pt] = __builtin_amdgcn_mfma_f32_16x16x32_bf16(a, cf[ks], y[pt], 0, 0, 0); } }
        { const float ei = __builtin_amdgcn_exp2f(cum_i);
#pragma unroll
            for (int pt = 0; pt < 4; ++pt) y[pt] = y[pt] * ei; }
        const int s_lo = dir == 0 ? 0 : (w >> 1), s_hi = dir == 0 ? (w >> 1) : 3;
        for (int s = s_lo; s <= s_hi; ++s) {
            f32x4 G0 = (f32x4){0.f, 0.f, 0.f, 0.f}, G1 = G0;
            const int j0 = 32 * s + li, j1 = j0 + 16;
#pragma unroll
            for (int ks = 0; ks < 4; ++ks) {
                const bf16x8 a0 = *(const LAS bf16x8*)(lds + SL_B + j0 * 256 + (((4 * ks + g) ^ (j0 & 15)) << 4));
                const bf16x8 a1 = *(const LAS bf16x8*)(lds + SL_B + j1 * 256 + (((4 * ks + g) ^ (j1 & 15)) << 4));
                G0 = __builtin_amdgcn_mfma_f32_16x16x32_bf16(a0, cf[ks], G0, 0, 0, 0);
                G1 = __builtin_amdgcn_mfma_f32_16x16x32_bf16(a1, cf[ks], G1, 0, 0, 0); }
            const f32x4 cj0 = *(const LAS f32x4*)(cumL + 32 * s + 4 * g), cj1 = *(const LAS f32x4*)(cumL + 32 * s + 16 + 4 * g);
            const int sg = dir == 0 ? 1 : -1, mb = sg * (i - 32 * s - 4 * g);
#pragma unroll
            for (int r = 0; r < 4; ++r) { const bool va = mb >= sg * r, vb = mb >= sg * (r + 16);
                G0[r] = va ? G0[r] * __builtin_amdgcn_exp2f(cum_i - cj0[r]) : 0.f; G1[r] = vb ? G1[r] * __builtin_amdgcn_exp2f(cum_i - cj1[r]) : 0.f; }
            u32x4 pk; pk.x = cvt_pk_bf16(G0[0], G0[1]); pk.y = cvt_pk_bf16(G0[2], G0[3]); pk.z = cvt_pk_bf16(G1[0], G1[1]); pk.w = cvt_pk_bf16(G1[2], G1[3]);
            const bf16x8 bp = __builtin_bit_cast(bf16x8, pk);
#pragma unroll
            for (int pt = 0; pt < 4; ++pt) { const int p = 16 * pt + li;
                const u32x2 lo8 = *(const LAS u32x2*)(lds + SL_XT + p * 256 + (((4 * s + (g >> 1)) ^ (p & 15)) << 4) + 8 * (g & 1));
                const u32x2 hi8 = *(const LAS u32x2*)(lds + SL_XT + p * 256 + (((4 * s + 2 + (g >> 1)) ^ (p & 15)) << 4) + 8 * (g & 1));
                u32x4 av; av.x = lo8.x; av.y = lo8.y; av.z = hi8.x; av.w = hi8.y;
                y[pt] = __builtin_amdgcn_mfma_f32_16x16x32_bf16(__builtin_bit_cast(bf16x8, av), bp, y[pt], 0, 0, 0); }
        }
        { const float etot = __expf(tot);
#pragma unroll
            for (int k = 0; k < 4; ++k) Sacc[k] = Sacc[k] * etot; }
        unsigned tra[2][4];
        { int lq = li; asm volatile("" : "+v"(lq)); const int q = lq >> 2, pp = lq & 3;
#pragma unroll
          for (int t = 0; t < 2; ++t)
#pragma unroll
            for (int k = 0; k < 4; ++k) { const int row = 8 * g + 4 * t + q, ch = 2 * (nt0 + k) + (pp >> 1);
                tra[t][k] = (unsigned)(SL_B + row * 256 + ((ch ^ (row & 15)) << 4) + 8 * (pp & 1)); } }
#define SSD_STATE_KS(KS) do { u32x2 t0a, t0b, t0c, t0d, t1a, t1b, t1c, t1d; \
            asm volatile("ds_read_b64_tr_b16 %0, %8 offset:%16\n\tds_read_b64_tr_b16 %1, %9 offset:%16\n\tds_read_b64_tr_b16 %2, %10 offset:%16\n\tds_read_b64_tr_b16 %3, %11 offset:%16\n\t" \
                         "ds_read_b64_tr_b16 %4, %12 offset:%16\n\tds_read_b64_tr_b16 %5, %13 offset:%16\n\tds_read_b64_tr_b16 %6, %14 offset:%16\n\tds_read_b64_tr_b16 %7, %15 offset:%16\n\ts_waitcnt lgkmcnt(0)" \
                         : "=&v"(t0a), "=&v"(t0b), "=&v"(t0c), "=&v"(t0d), "=&v"(t1a), "=&v"(t1b), "=&v"(t1c), "=&v"(t1d) \
                         : "v"(tra[0][0]), "v"(tra[0][1]), "v"(tra[0][2]), "v"(tra[0][3]), "v"(tra[1][0]), "v"(tra[1][1]), "v"(tra[1][2]), "v"(tra[1][3]), "i"(8192 * (KS)) : "memory"); \
            __builtin_amdgcn_sched_barrier(0); \
            const int p_ = 16 * pt_s + li; const bf16x8 a_ = *(const LAS bf16x8*)(lds + SL_XE + p_ * 256 + (((4 * (KS) + g) ^ (p_ & 15)) << 4)); \
            u32x4 b0_, b1_, b2_, b3_; b0_.x = t0a.x; b0_.y = t0a.y; b0_.z = t1a.x; b0_.w = t1a.y; b1_.x = t0b.x; b1_.y = t0b.y; b1_.z = t1b.x; b1_.w = t1b.y; \
            b2_.x = t0c.x; b2_.y = t0c.y; b2_.z = t1c.x; b2_.w = t1c.y; b3_.x = t0d.x; b3_.y = t0d.y; b3_.z = t1d.x; b3_.w = t1d.y; \
            Sacc[0] = __builtin_amdgcn_mfma_f32_16x16x32_bf16(a_, __builtin_bit_cast(bf16x8, b0_), Sacc[0], 0, 0, 0); Sacc[1] = __builtin_amdgcn_mfma_f32_16x16x32_bf16(a_, __builtin_bit_cast(bf16x8, b1_), Sacc[1], 0, 0, 0); \
            Sacc[2] = __builtin_amdgcn_mfma_f32_16x16x32_bf16(a_, __builtin_bit_cast(bf16x8, b2_), Sacc[2], 0, 0, 0); Sacc[3] = __builtin_amdgcn_mfma_f32_16x16x32_bf16(a_, __builtin_bit_cast(bf16x8, b3_), Sacc[3], 0, 0, 0); } while (0)
        SSD_STATE_KS(0); SSD_STATE_KS(1); SSD_STATE_KS(2); SSD_STATE_KS(3);
#undef SSD_STATE_KS
        sb ^= 1;
        SSD_WRITE_SB(sb);
#ifndef SSD_TS2
        TS_MARK(ts_acc3);
#endif
        const float rdti = __builtin_amdgcn_rcpf(dtL[i]);
        float ssq_part = 0.f;
#pragma unroll
        for (int pt = 0; pt < 4; ++pt) { const size_t off = (rbase + i) * 1024 + h * 64 + 16 * pt + 4 * g, yoff = (rbase + i) * 64 + 16 * pt + 4 * g;
            if (dir == 0) { u32x2 o; o.x = cvt_pk_bf16(y[pt][0], y[pt][1]); o.y = cvt_pk_bf16(y[pt][2], y[pt][3]); *(u32x2*)(Y + yoff) = o; }
            else {
                const u32x2 yq = *(const u32x2*)(Y + yoff), zq = *(const u32x2*)(Z + off);
                const float yf[4] = {bf_lo(yq.x), bf_hi(yq.x), bf_lo(yq.y), bf_hi(yq.y)}, zf[4] = {bf_lo(zq.x), bf_hi(zq.x), bf_lo(zq.y), bf_hi(zq.y)};
                float rr[4];
#pragma unroll
                for (int r = 0; r < 4; ++r) { const int p = 16 * pt + 4 * g + r;
                    const unsigned short xr = *(const LAS unsigned short*)(lds + SL_XT + p * 256 + (((i >> 3) ^ (p & 15)) << 4) + (i & 7) * 2);
                    const float xv = __uint_as_float((unsigned)xr << 16) * rdti;
                    rr[r] = (yf[r] + y[pt][r] + Dsk * xv) * silu_f(zf[r]); }
                u32x2 o; o.x = cvt_pk_bf16(rr[0], rr[1]); o.y = cvt_pk_bf16(rr[2], rr[3]); *(u32x2*)(Z + off) = dry ? zq : o;
                { const float q0 = bf_lo(o.x), q1 = bf_hi(o.x), q2 = bf_lo(o.y), q3 = bf_hi(o.y); ssq_part += (q0 * q0 + q1 * q1) + (q2 * q2 + q3 * q3); }
            }
        }
        if (dir == 1 && !dry) {
            ssq_part += __shfl_xor(ssq_part, 16); ssq_part += __shfl_xor(ssq_part, 32);
            if (g == 0) ((float*)(P.ws + ZZ + WS_SSQH))[(size_t)h * MTOK + rbase + i] = ssq_part;
        }
        TS_MARK(ts_acc4);
    }
#ifdef SSD_TS
    if (blockIdx.x == 0 && l == 0 && lat && dir == 0 && (tid == 0 || tid == 448)) { unsigned long long* o_ = (unsigned long long*)(P.ws + ZZ + 512 * 1024 + 1024) + (tid ? 8 : 0);
        o_[0] = ts_acc0; o_[1] = ts_acc1; o_[2] = ts_acc2; o_[3] = ts_acc3; o_[4] = ts_acc4; }
#endif
    if (!lat) { float* sp = P.out + ZZ + OUT_ST + (size_t)((((b * 2 + l) * 2 + dir) * 16 + h) * 64) * 128;
#pragma unroll
        for (int k = 0; k < 4; ++k)
#pragma unroll
            for (int r = 0; r < 4; ++r) sp[(size_t)(16 * pt_s + 4 * g + r) * 128 + 16 * (nt0 + k) + li] = Sacc[k][r]; }
#undef TS_MARK
#undef SSD_WRITE_SB
#undef SSD_PREFETCH
}
__device__ __forceinline__ void latent_chain_of(int c, int& b, int& h) {
    const int x = c & 7, k = c >> 3, combo = x + 8 * (k >> 3); b = combo >> 1; h = (combo & 1) * 8 + (k & 7);
}
__device__ __forceinline__ void context_unit_of(int u, int& b, int& h) {
    const int cb = u >> 2, j = u & 3, x = cb & 7, ku = (cb >> 3) * 4 + j, combo = x + 8 * (ku >> 3); b = combo >> 1; h = (combo & 1) * 8 + (ku & 7);
}
#ifndef CTXMOVE
#define CTXMOVE 1
#endif
__device__ __forceinline__ void phase_ssd1(const Params& P, int l, LAS unsigned char* lds, bool dry) {
    const int G = gridDim.x, bid = blockIdx.x;
    const bool fast = (G == 256);
    for (int q = 0;; ++q) {
        int it, dir;
        if (fast) { if (bid < 128) { if (q >= 1) break; it = bid; dir = 0; } else { if (q >= 8 - CTXMOVE) break; it = 128 + (bid - 128) * 4 + (q >> 1); dir = q & 1; } }
        else { it = bid + (q >> 1) * G; dir = q & 1; if (it >= 640) break; if (it < 128 && dir == 1) continue; }
        const int lat = it < 128 ? 1 : 0; int b, h;
        if (lat) latent_chain_of(it, b, h); else context_unit_of(it - 128, b, h);
        ssd_chain(P, l, lds, lat, b, h, dir, dry);
    }
}
__device__ __forceinline__ void phase_ssd2(const Params& P, int l, LAS unsigned char* lds, bool dry, int first, int stride) {
    const bool fast = (gridDim.x == 256);
    for (int u = first; u < 128; u += stride) {
        for (int k = 0; k < (fast ? 1 + CTXMOVE : 1); ++k) {
            int b, h; const int lat = k == 0 ? 1 : 0;
            if (lat) latent_chain_of(u, b, h); else context_unit_of(4 * u + 3, b, h);
            ssd_chain(P, l, lds, lat, b, h, 1, dry);
        }
    }
}
#define XB_TMO      128
#define XB_XCNT(j)  (256  + 64 * (j))
#define XB_XSUB(j)  (1280 + 64 * (j))
#define XB_XGEN(j)  (2304 + 64 * (j))
#define XB_TOP      3328
#define XB_TOPGEN   3392
#define XCD_BAR_WORDS 3456
#define XB_SPIN_CAP (1u << 18)

__device__ __forceinline__ unsigned xb_ld(unsigned* p)              { return __hip_atomic_load(p, __ATOMIC_RELAXED, __HIP_MEMORY_SCOPE_AGENT); }
__device__ __forceinline__ unsigned xb_add(unsigned* p, unsigned v) { return __hip_atomic_fetch_add(p, v, __ATOMIC_RELAXED, __HIP_MEMORY_SCOPE_AGENT); }
__device__ __forceinline__ unsigned xb_xcc_id() { return (unsigned)__builtin_amdgcn_s_getreg((3 << 11) | 20) & 0xFu; }
#define XB_SPIN(cond, bar) do { unsigned _sp = 0; while (cond) { __builtin_amdgcn_s_sleep(1); \
    if ((++_sp & 255u) == 0u) { if (xb_ld(&(bar)[XB_TMO])) break; if (_sp > XB_SPIN_CAP) { atomicAdd(&(bar)[XB_TMO], 1u); break; } } } } while (0)

struct XcdBarrier {
    unsigned* bar; unsigned x;
    volatile LAS unsigned* st;
};

__device__ __forceinline__ XcdBarrier xcd_barrier_post(unsigned* bar, volatile LAS unsigned* st) {
    XcdBarrier b; b.bar = bar; b.x = xb_xcc_id(); b.st = st;
    if (threadIdx.x == 0) (void)xb_add(&bar[XB_XCNT(b.x)], 1u);
    return b;
}
__device__ __forceinline__ void xcd_barrier_complete(unsigned* bar, unsigned x, unsigned& nloc, unsigned& nx) {
    const unsigned G = gridDim.x * gridDim.y * gridDim.z;
    unsigned sum, cnt, mine, sp = 0u;
    for (;;) {
        sum = 0u; cnt = 0u; mine = 0u;
#pragma unroll
        for (unsigned j = 0; j < 16; ++j) { const unsigned c = xb_ld(&bar[XB_XCNT(j)]); sum += c; cnt += (c > 0u) ? 1u : 0u; mine = (j == x) ? c : mine; }
        if (sum == G) break;
        __builtin_amdgcn_s_sleep(1);
        if ((++sp & 255u) == 0u) { if (xb_ld(&bar[XB_TMO])) break; if (sp > XB_SPIN_CAP) { atomicAdd(&bar[XB_TMO], 1u); break; } }
    }
    nloc = mine > 0u ? mine : 1u; nx = cnt > 0u ? cnt : 1u;
}

__device__ __forceinline__ void xcd_barrier(const XcdBarrier& b) {
    asm volatile("s_waitcnt vmcnt(0)" ::: "memory");
    __syncthreads();
    if (threadIdx.x == 0) {
        unsigned* bar = b.bar;
        __builtin_amdgcn_s_waitcnt(0);
        unsigned nloc = b.st[0], nx = b.st[1];
        if (nloc == 0u) { xcd_barrier_complete(bar, b.x, nloc, nx); b.st[0] = nloc; b.st[1] = nx; }
        const unsigned old = xb_add(&bar[XB_XSUB(b.x)], 1u);
        const unsigned gen = old / nloc;
        if (old + 1u == (gen + 1u) * nloc) {
            __builtin_amdgcn_fence(__ATOMIC_RELEASE, "agent");
            asm volatile("s_waitcnt vmcnt(0)" ::: "memory");
            const unsigned og = xb_add(&bar[XB_TOP], 1u);
            const unsigned tg = og / nx;
            if (og + 1u == (tg + 1u) * nx) xb_add(&bar[XB_TOPGEN], 1u);
            else XB_SPIN(xb_ld(&bar[XB_TOPGEN]) == tg, bar);
            __builtin_amdgcn_fence(__ATOMIC_ACQUIRE, "agent");
            xb_add(&bar[XB_XGEN(b.x)], 1u);
            asm volatile("s_waitcnt vmcnt(0)" ::: "memory");
        } else {
            XB_SPIN(xb_ld(&bar[XB_XGEN(b.x)]) == gen, bar);
            __builtin_amdgcn_fence(__ATOMIC_ACQUIRE, "agent");
            asm volatile("s_waitcnt vmcnt(0)" ::: "memory");
        }
    }
    __syncthreads();
}
#ifndef N_LAUNCHES
#define N_LAUNCHES 1
#endif
#ifndef DEBUG_STAGE
#define DEBUG_STAGE 0
#endif
#define PH_IN(p) (lo <= (p) && (p) < hi)
#ifndef MT_MERGE
#define MT_MERGE 3
#endif
#ifndef MT_RESID
#define MT_RESID 3
#endif
#ifndef REP_PHASE
#define REP_PHASE -1
#endif
#define REPS(k) for (int rep_ = 0; rep_ < ((k) == REP_PHASE ? 2 : 1); ++rep_)
#define DRY(k) ((k) == REP_PHASE && rep_ == 0)
#ifdef ONLY_CASE
#define PH_ON(k) (((ONLY_CASE) >> (k)) & 1)
#else
#define PH_ON(k) 1
#endif
#ifdef PROBE_TS
constexpr size_t WS_TS = 512 * 1024;
#define SEAM(p) do { if (PH_IN(p) && PH_IN((p) + 1)) { xcd_barrier(xbar); if (blockIdx.x == 0 && threadIdx.x == 0) ((unsigned long long*)(P.ws + WS_TS))[(p) + 1] = __builtin_amdgcn_s_memrealtime(); } } while (0)
#else
#define SEAM(p) do { if (PH_IN(p) && PH_IN((p) + 1)) xcd_barrier(xbar); } while (0)
#endif
#ifdef PROBE_TS
#define SEAM_45(p) do { if (PH_IN(p) && PH_IN((p) + 2)) { xcd_barrier(xbar); if (blockIdx.x == 0 && threadIdx.x == 0) { const unsigned long long t_ = __builtin_amdgcn_s_memrealtime(); ((unsigned long long*)(P.ws + WS_TS))[(p) + 1] = t_; ((unsigned long long*)(P.ws + WS_TS))[(p) + 2] = t_; } } } while (0)
#else
#define SEAM_45(p) do { if (PH_IN(p) && PH_IN((p) + 2)) xcd_barrier(xbar); } while (0)
#endif
#define SEAM_MID(p) do { if (PH_IN(p)) xcd_barrier(xbar); } while (0)
template <int L>
__device__ __forceinline__ void layer_program(const Params& P, LAS unsigned char* lds, const XcdBarrier& xbar, const int lo, const int hi) {
    constexpr int B = 1 + NPH_LAYER * L;
    if (PH_ON(0) && PH_IN(B + 0)) REPS(0) phase_p0(P, L, lds);
    SEAM(B + 0);
    if (PH_ON(1) && PH_IN(B + 1)) REPS(1) {
        const int ZZ = opq0(); unsigned char* ws = P.ws + ZZ; float* outp = P.out + ZZ;
        pg8::Gemm g{(const bf16_t*)outp, (const bf16_t*)(ws + WS_WIN), MTOK, 4096, 1024};
        pg8::StaticOrder S; S.init(MTOK, 4096, gridDim.x, blockIdx.x);
        pg8::EpiInProj E{ws, outp + OUT_CV, L};
        pg8::gemm_phase<pg8::EpiInProj, pg8::StaticOrder, true, true>(lds, g, S, E);
    }
    SEAM(B + 1);
    if (PH_ON(2) && PH_IN(B + 2)) REPS(2) { if (rep_ == 0) { qk_prep(P, L); dt_prepass(P, L); } bc_conv(P, L); }
    SEAM(B + 2);
#ifndef ATT3
#define ATT3 1
#endif
#ifndef ATT4S
#define ATT4S 0
#endif
    if (PH_ON(3) && PH_IN(B + 3)) REPS(3) {
        phase_ssd1(P, L, lds, DRY(3));
        if (gridDim.x == 256 && blockIdx.x < 128 && !DRY(3)) phase_attn(P, L, lds, WS_Q, blockIdx.x, 128, 128 * ATT3);
    }
    SEAM(B + 3);
    if (PH_ON(4) && PH_IN(B + 4)) REPS(4) {
        const int G_ = gridDim.x, bid_ = blockIdx.x;
        int sf_ = bid_, ss_ = G_, af_ = bid_, as_ = G_;
        int an_ = ATT_UNITS;
        if (G_ == 256) { if (bid_ < 128) { af_ = 128 * ATT3 + bid_; as_ = 128; an_ = 128 * (ATT3 + ATT4S); } else { sf_ = 128; af_ = 128 * (ATT3 + ATT4S) + bid_ - 128; as_ = 128; } }
        phase_ssd2(P, L, lds, DRY(4), sf_, ss_);
        phase_attn(P, L, lds, WS_Q, af_, as_, an_);
        if (rep_ == 0) { if (G_ != 256) pooled_rows(P, bid_ * 8 + (threadIdx.x >> 6), G_ * 8, threadIdx.x & 63);
            else if (bid_ >= 128) pooled_rows(P, (bid_ - 128) * 8 + (threadIdx.x >> 6), 128 * 8, threadIdx.x & 63); }
    }
    SEAM_45(B + 4);
    if (PH_ON(6) && PH_IN(B + 6)) REPS(6) {
        const int ZZ = opq0(); unsigned char* ws = P.ws + ZZ;
        pg8::StaticOrder S; S.init(MTOK, 1024, gridDim.x, blockIdx.x, 192);
        pg8::gemm_merge6<pg8::StaticOrder>(lds, (const bf16_t*)(P.out + ZZ), (const bf16_t*)(ws + WS_WG), (const bf16_t*)(ws + WS_POOLED), (const bf16_t*)(ws + WS_Q), (const bf16_t*)(ws + WS_Z),
                                           (const bf16_t*)(ws + WS_WPOOL), (const bf16_t*)(ws + WS_WATT), (const bf16_t*)(ws + WS_WSSD), S, (bf16_t*)(ws + WS_MERGED), (const float*)(ws + WS_SSQH));
    }
    SEAM(B + 6);
    if (PH_ON(7) && PH_IN(B + 7)) REPS(7) {
        const int ZZ = opq0(); unsigned char* ws = P.ws + ZZ; float* outp = P.out + ZZ;
        const float* MOD = (const float*)(ws + WS_MOD) + (size_t)L * 9 * 6144;
        pg8::Gemm g{(const bf16_t*)(ws + WS_MERGED), (const bf16_t*)(ws + WS_WOUT), MTOK, 1024, 1024};
        pg8::StaticOrder S; S.init(MTOK, 1024, gridDim.x, blockIdx.x, 64 * MT_RESID);
        pg8::EpiResid<MT_RESID, L != 0, true> E{L == 0 ? (const void*)P.in[ZZ + I_XP] : (const void*)(ws + WS_X), L == 0 ? (const void*)P.in[ZZ + I_XS] : nullptr, ws + WS_X, MOD + 2048, DRY(7) ? 0.f : 1.f};
        pg8::gemm_phase<pg8::EpiResid<MT_RESID, L != 0, true>, pg8::StaticOrder, true, true>(lds, g, S, E);
    }
    SEAM(B + 7);
    if (PH_ON(8) && PH_IN(B + 8)) REPS(8) phase_h2(P, L);
    SEAM(B + 8);
    if (PH_ON(9) && PH_IN(B + 9)) REPS(9) {
        const int ZZ = opq0(); unsigned char* ws = P.ws + ZZ;
        pg8::Gemm g{(const bf16_t*)(P.out + ZZ), (const bf16_t*)(ws + WS_WM1), MTOK, 4096, 1024};
        pg8::StaticOrder S; S.init(MTOK, 4096, gridDim.x, blockIdx.x);
        pg8::EpiAct<2, 4> E{(bf16_t*)(ws + WS_HID), 4096};
        pg8::gemm_phase<pg8::EpiAct<2, 4>, pg8::StaticOrder, true, true>(lds, g, S, E);
    }
    SEAM(B + 9);
    if (PH_ON(10) && PH_IN(B + 10)) REPS(10) {
        const int ZZ = opq0(); unsigned char* ws = P.ws + ZZ; float* outp = P.out + ZZ;
        const float* MOD = (const float*)(ws + WS_MOD) + (size_t)L * 9 * 6144;
        pg8::Gemm g{(const bf16_t*)(ws + WS_HID), (const bf16_t*)(ws + WS_WM2), MTOK, 1024, 4096};
        pg8::StaticOrder S; S.init(MTOK, 1024, gridDim.x, blockIdx.x, 64 * MT_RESID);
        pg8::EpiResid<MT_RESID, true, L == 0> E{ws + WS_X, nullptr, L == 0 ? (void*)(ws + WS_X) : (void*)outp, MOD + 5120, DRY(10) ? 0.f : 1.f};
        pg8::gemm_phase<pg8::EpiResid<MT_RESID, true, L == 0>, pg8::StaticOrder, true, true>(lds, g, S, E);
    }
    SEAM(B + 10);
}
__global__ void __launch_bounds__(512, 2) fwd_megakernel(Params P) {
    extern __shared__ __attribute__((aligned(16))) unsigned char lds_raw[];
    LAS unsigned char* lds = (LAS unsigned char*)lds_raw;
    cg::grid_group grid = cg::this_grid();
    const int lo = P.ph_lo, hi = P.ph_hi;
    if (hi < 0) grid.sync();
    if (threadIdx.x < 16) ((LAS unsigned*)(lds + LDS_MISC))[threadIdx.x] = 0u;
    __syncthreads();
    const XcdBarrier xbar = xcd_barrier_post((unsigned*)(P.ws + WS_BAR), (volatile LAS unsigned*)(lds + LDS_MISC));
#ifdef PROBE_TS
    if (blockIdx.x == 0 && threadIdx.x == 0) ((unsigned long long*)(P.ws + WS_TS))[0] = __builtin_amdgcn_s_memrealtime();
#endif
    if (PH_ON(20) && PH_IN(0)) phase_mod(P, lds);
#ifdef FILL_SCRATCH
    { u32x4 z; z.x = z.y = z.z = z.w = 0x3f803f80u;
      for (size_t i = (size_t)blockIdx.x * 512 + threadIdx.x; i < (48 * MiB) / 16; i += (size_t)gridDim.x * 512) ((u32x4*)(P.ws + WS_X))[i] = z;
      for (size_t i = (size_t)blockIdx.x * 512 + threadIdx.x; i < (96 * MiB) / 16; i += (size_t)gridDim.x * 512) ((u32x4*)P.out)[i] = z; }
#endif
    SEAM(0);
    layer_program<0>(P, lds, xbar, lo, hi);
    layer_program<1>(P, lds, xbar, lo, hi);
#ifdef EXTRA_SYNCS
    for (int i_ = 0; i_ < EXTRA_SYNCS; ++i_) grid.sync();
#endif
#ifdef DETPROBE_OFF
    grid.sync();
    { const unsigned* src = (const unsigned*)(P.ws + (size_t)(DETPROBE_OFF));
      for (size_t i = (size_t)blockIdx.x * 512 + threadIdx.x; i < OUT_TOTAL; i += (size_t)gridDim.x * 512) { float v = 0.f;
          for (size_t j = i; j < (size_t)(DETPROBE_WORDS); j += OUT_TOTAL) { const unsigned w = src[j]; v += (float)((w ^ (w >> 16)) & 0xffffu); }
          P.out[i] = v; } }
#endif
#ifdef BITPROBE
    grid.sync();
    for (size_t i = (size_t)blockIdx.x * 512 + threadIdx.x; i < OUT_TOTAL; i += (size_t)gridDim.x * 512) P.out[i] = (float)(__float_as_uint(P.out[i]) & 0xfffu);
#endif
#ifdef PROBE_TS
    if (blockIdx.x == 0 && threadIdx.x == 0) ((unsigned long long*)(P.ws + WS_TS))[NPHASES] = __builtin_amdgcn_s_memrealtime();
#endif
}

#ifdef PROBE_TS
__global__ void probe_tail(float* out, const unsigned long long* ts) {
#ifdef SSD_TS_A
    const unsigned long long* sec = ts + 128;
    float ta = (float)sec[SSD_TS_A], tb = (float)sec[SSD_TS_B], tota = 0.f, totb = 0.f;
    for (int k = 0; k < 5; ++k) { tota += (float)sec[(SSD_TS_A & 8) + k]; totb += (float)sec[(SSD_TS_B & 8) + k]; }
    const float fa = ta / tota, fb = tb / totb;
#else
    float ta = (float)(ts[PROBE_A_HI] - ts[PROBE_A_LO]), tb = (float)(ts[PROBE_B_HI] - ts[PROBE_B_LO]);
#ifdef PROBE_BOTH
    ta += (float)(ts[PROBE_A_HI + NPH_LAYER] - ts[PROBE_A_LO + NPH_LAYER]); tb += (float)(ts[PROBE_B_HI + NPH_LAYER] - ts[PROBE_B_LO + NPH_LAYER]);
#endif
    const float tot = (float)(ts[NPHASES] - ts[0]);
    const float fa = ta / tot, fb = tb / tot;
#endif
    const float e = sqrtf(0.0025f * fb);
    for (size_t i = (size_t)blockIdx.x * blockDim.x + threadIdx.x; i < OUT_TOTAL; i += (size_t)gridDim.x * blockDim.x) { float v = out[i] * (1.0f + e); if (i == 0) v += 1.0f + 8.9f * fa; out[i] = v; }
}
#endif
#if DEBUG_STAGE
__global__ void debug_mask(float* out, int mode, float scale) {
    size_t i = (size_t)blockIdx.x * blockDim.x + threadIdx.x; const size_t stride = (size_t)gridDim.x * blockDim.x;
    for (; i < OUT_TOTAL; i += stride) {
        bool keep = false;
        if (mode == 1) keep = i >= OUT_CV && i < OUT_ST && (((i - OUT_CV) >> 15) & 1) == 0;
        if (mode == 2) keep = i >= OUT_CK && i < OUT_CV && (((i - OUT_CK) >> 15) & 1) == 0;
        if (mode == 3) keep = i >= OUT_ST && (((i - OUT_ST) >> 18) & 1) == 0;
        if (mode == 4) keep = i >= OUT_CK && i < OUT_CV;
        if (mode == 5) keep = i >= OUT_CV && i < OUT_ST;
        if (mode == 6) keep = i >= OUT_ST;
        if (mode == 7) keep = i < (size_t)MCTX * 1024;
        if (mode == 8) keep = i >= (size_t)MCTX * 1024 && i < OUT_CK;
        out[i] = keep ? out[i] * scale : 0.f;
    }
}
#endif

extern "C" void kernel_launch(void* const* d_in, const int* in_sizes, int n_in, void* d_out, int out_size, void* d_ws, size_t ws_size, hipStream_t stream) {
    static int grid = 0;
    if (grid == 0) {
        if (n_in != 29 || out_size != (int)OUT_TOTAL || ws_size < WS_END) { fprintf(stderr, "kernel_launch: unexpected shapes (n_in %d, out %d, ws %zu < %zu); nothing launched\n", n_in, out_size, ws_size, (size_t)WS_END); grid = -1; return; }
        int dev = 0, cus = 0, per_cu = 0;
        hipGetDevice(&dev);
        hipDeviceGetAttribute(&cus, hipDeviceAttributeMultiprocessorCount, dev);
        if (hipFuncSetAttribute((const void*)fwd_megakernel, hipFuncAttributeMaxDynamicSharedMemorySize, LDS_BYTES) != hipSuccess) { fprintf(stderr, "kernel_launch: hipFuncSetAttribute failed\n"); grid = -1; return; }
        if (hipOccupancyMaxActiveBlocksPerMultiprocessor(&per_cu, (const void*)fwd_megakernel, 512, LDS_BYTES) != hipSuccess || per_cu < 1) { fprintf(stderr, "kernel_launch: occupancy query says %d blocks per CU\n", per_cu); grid = -1; return; }
        grid = cus;
    }
    if (grid < 0) return;
    if (hipMemsetAsync((char*)d_ws + WS_BAR, 0, XCD_BAR_WORDS * 4, stream) != hipSuccess) { fprintf(stderr, "kernel_launch: memset of the barrier words failed\n"); return; }
    Params p{};
    for (int i = 0; i < 29; ++i) p.in[i] = (const float*)d_in[i];
    p.out = (float*)d_out; p.ws = (unsigned char*)d_ws;
#if DEBUG_STAGE
    const int last_phase = DEBUG_LAST_PHASE;
#elif defined(DETPROBE_LAST)
    const int last_phase = DETPROBE_LAST;
#else
    const int last_phase = NPHASES;
#endif
#if N_LAUNCHES == 1
    p.ph_lo = 0; p.ph_hi = last_phase;
    { void* args[] = {&p}; hipError_t e = hipLaunchCooperativeKernel((const void*)fwd_megakernel, dim3(grid), dim3(512), args, LDS_BYTES, stream);
      if (e != hipSuccess) fprintf(stderr, "cooperative launch failed: %s (grid %d)\n", hipGetErrorString(e), grid); }
#ifdef PROBE_TS
    probe_tail<<<2048, 256, 0, stream>>>((float*)d_out, (const unsigned long long*)((unsigned char*)d_ws + WS_TS));
#endif
#else
    for (int ph = 0; ph < last_phase; ++ph) {
        p.ph_lo = ph; p.ph_hi = ph + 1;
        void* args[] = {&p}; hipError_t e = hipLaunchCooperativeKernel((const void*)fwd_megakernel, dim3(grid), dim3(512), args, LDS_BYTES, stream);
        if (e != hipSuccess) { fprintf(stderr, "cooperative launch failed: %s (grid %d)\n", hipGetErrorString(e), grid); break; }
    }
#endif
#if DEBUG_STAGE
    debug_mask<<<1024, 256, 0, stream>>>((float*)d_out, DEBUG_STAGE, 4.0f);
#endif
}
```

```cpp
#include <hip/hip_runtime.h>
#include <hip/hip_cooperative_groups.h>
#include <cstdio>
#include <cstdint>
namespace cg = cooperative_groups;

#define LAS __attribute__((address_space(3)))
typedef unsigned short bf16_t;
typedef short bf16x8 __attribute__((ext_vector_type(8)));
typedef float f32x4 __attribute__((ext_vector_type(4)));
typedef float f32x2 __attribute__((ext_vector_type(2)));
typedef unsigned u32x4 __attribute__((ext_vector_type(4)));
typedef unsigned u32x2 __attribute__((ext_vector_type(2)));

constexpr int DM = 1024, MCTX = 8192, MLAT = 16384, MTOK = 24576, LCTX = 256, LLAT = 2048, PAST = 512;
constexpr int INC = 6944;
constexpr int NPH_LAYER = 11, NPHASES = 1 + 2 * NPH_LAYER;
constexpr size_t OUT_CK = 25165824, OUT_CV = 27262976, OUT_ST = 29360128, OUT_TOTAL = 46137344;
constexpr size_t MiB = 1u << 20;
constexpr size_t WS_MOD = 0;
constexpr size_t WS_BAR = 3 * MiB;
constexpr size_t WS_SSQ = 3 * MiB + 256 * 1024;
constexpr size_t OUTB_Y = 48 * MiB;
constexpr size_t WS_CK = 1 * MiB, WS_CV = 2 * MiB;
constexpr size_t WS_WIN = 4 * MiB;
constexpr size_t WS_WG = 12 * MiB;
constexpr size_t WS_WPOOL = 18 * MiB;
constexpr size_t WS_WATT = 19 * MiB;
constexpr size_t WS_WSSD = 20 * MiB;
constexpr size_t WS_WOUT = 22 * MiB;
constexpr size_t WS_WM1 = 24 * MiB;
constexpr size_t WS_WM2 = 32 * MiB;
constexpr size_t WS_X = 40 * MiB;
constexpr size_t WS_Q = 88 * MiB;
constexpr size_t WS_Z = 112 * MiB;
constexpr size_t WS_XBC = 160 * MiB;
constexpr size_t WS_X2 = WS_XBC, WS_BCR = 208 * MiB;
constexpr size_t WS_G8 = WS_XBC;
constexpr size_t WS_PU = 232 * MiB;
constexpr size_t WS_KV = 256 * MiB;
constexpr size_t WS_DT = 268 * MiB;
constexpr size_t WS_DTS = 272 * MiB, WS_CUM2 = 275 * MiB;
constexpr size_t WS_MERGED = WS_PU;
constexpr size_t WS_BC = 280 * MiB;
constexpr size_t WS_POOLED = WS_BCR;
constexpr size_t WS_HID = WS_Q;
constexpr size_t WS_SSQH = 304 * MiB;
constexpr size_t WS_END = 306 * MiB;

constexpr int LDS_GT = 133120;
constexpr int LDS_MISC = 162816;
constexpr int LDS_BYTES = 163840;

struct Params { const float* in[29]; float* out; unsigned char* ws; int ph_lo, ph_hi; };
enum { I_XP = 0, I_XS, I_CK, I_CV, I_ST, I_C, I_CCTX, I_WMOD, I_BMOD, I_N1G, I_N2G, I_WIN, I_POOLW, I_POOLS, I_WPO, I_QG, I_KG, I_SINK, I_WAO,
       I_CONVW, I_CONVB, I_DTB, I_ALOG, I_DSKIP, I_SSDG, I_WSO, I_WOUT, I_WM1, I_WM2 };

__device__ __forceinline__ unsigned cvt_pk_bf16(float lo, float hi) { unsigned r; asm volatile("s_nop 0\n\tv_cvt_pk_bf16_f32 %0, %1, %2" : "=v"(r) : "v"(lo), "v"(hi)); return r; }
typedef __bf16 bf16v2_t __attribute__((ext_vector_type(2)));
__device__ __forceinline__ unsigned cvt_pk_bf16_c(float lo, float hi) { const f32x2 v = {lo, hi}; return __builtin_bit_cast(unsigned, __builtin_convertvector(v, bf16v2_t)); }
__device__ __forceinline__ float bf_lo(unsigned u) { return __uint_as_float(u << 16); }
__device__ __forceinline__ float bf_hi(unsigned u) { return __uint_as_float(u & 0xffff0000u); }
__device__ __forceinline__ float silu_f(float x) { return x * __builtin_amdgcn_rcpf(1.f + __expf(-x)); }
__device__ __forceinline__ float sigmoid_f(float x) { return 1.f / (1.f + __expf(-x)); }
__device__ __forceinline__ float wave_sum(float v) {
#pragma unroll
    for (int o = 1; o < 64; o <<= 1) v += __shfl_xor(v, o);
    return v;
}
__device__ __forceinline__ const float* xrow_ptr0(const Params& P, int ZZ, int row) {
    return row < MCTX ? P.in[ZZ + I_XP] + (size_t)row * DM : P.in[ZZ + I_XS] + (size_t)(row - MCTX) * DM;
}
__device__ __forceinline__ int mod_index(int row) { return row < MCTX ? 0 : 1 + ((row - MCTX) >> 11); }
__device__ __forceinline__ int opq0() { int z = 0; asm volatile("" : "+s"(z)); return z; }
#define LDS_BARRIER() do { asm volatile("s_waitcnt lgkmcnt(0)" ::: "memory"); __builtin_amdgcn_s_barrier(); asm volatile("" ::: "memory"); } while (0)
#define LDS_WAIT() asm volatile("s_waitcnt lgkmcnt(0)" ::: "memory")
namespace pg8 {
#define PG8_LAS __attribute__((address_space(3)))
typedef unsigned short bf16_t;
typedef short bf16x8 __attribute__((ext_vector_type(8)));
typedef float f32x4 __attribute__((ext_vector_type(4)));
typedef unsigned u32x4 __attribute__((ext_vector_type(4)));
constexpr int BM = 256, BK = 64, HALF = 128, HTB = HALF * BK * 2  , STAGE_BYTES = 8 * HTB, NXCD = 8, WGM = 8;

__host__ __device__ __forceinline__ int lds_byte(int r, int c) { const int st = (r >> 4) * 2 + (c >> 5), rr = r & 15, cc = c & 31, ob = rr * 64 + cc * 2; return st * 1024 + (ob ^ (((ob >> 9) & 1) << 5)); }
__host__ __device__ __forceinline__ void stage_rc(int b, int& R, int& C) { const int st = b / 1024, sb = b % 1024, swz = sb ^ (((sb >> 9) & 1) << 5); R = (st >> 1) * 16 + swz / 64; C = (st & 1) * 32 + (swz % 64) / 2; }
__host__ __device__ __forceinline__ int perm32(int rho) { const int n = rho >> 4, i = rho & 15; return 8 * (i >> 2) + 4 * n + (i & 3); }

struct Unit { int pm, pn; };
struct Gemm { const bf16_t* A; const bf16_t* Bt; int M, N, K; };

struct StaticOrder {
    int nM, nN, nwg, G, c;
    __host__ __device__ void init(int M, int N, int G_, int c_, int RT = BM) { nM = M / RT; nN = N / BM; nwg = nM * nN; G = G_; c = c_; }
    __host__ __device__ bool next(int i, Unit& u) const {
        const long L = (long)i * G + c; if (L >= nwg) return false;
        int wgid = (int)L; { const int q = nwg / NXCD, r = nwg % NXCD, xcd = wgid % NXCD, off = wgid / NXCD; wgid = (xcd < r ? xcd * (q + 1) : r * (q + 1) + (xcd - r) * q) + off; }
        const int nig = WGM * nN, gid = wgid / nig, fm = gid * WGM, gsz = (nM - fm) < WGM ? (nM - fm) : WGM;
        u.pm = fm + ((wgid % nig) % gsz); u.pn = (wgid % nig) / gsz; return true;
    }
    __device__ __forceinline__ void a_ready(const Unit&) const {}
    __device__ __forceinline__ void done(const Unit&) const {}
};


struct EpiInProj {
    static constexpr bool PERM = true, AFTER_DRAIN = false; static constexpr int MT = 4;
    unsigned char* ws; float* out_cv; int layer;
    __device__ __forceinline__ void operator()(const f32x4 (&acc)[2][2][4][2], const Unit& u, int wr, int wc, int fr, int fq) const {
        const int pn = u.pn;
        const int row0 = u.pm * BM + wr * 64 + fr, cw = wc * 32 + 8 * fq;
        if (pn == 15) {
            if (wc == 0) { float* D = (float*)(ws + WS_DT);
#pragma unroll
                for (int ai = 0; ai < 2; ++ai)
#pragma unroll
                    for (int m = 0; m < 4; ++m) { float* rp = D + (size_t)(row0 + ai * HALF + m * 16) * 32 + cw; *(f32x4*)rp = acc[ai][0][m][0]; *(f32x4*)(rp + 4) = acc[ai][0][m][1]; } }
            return;
        }
        size_t boff; int ld, colt;
        if (pn < 2) { boff = WS_PU; ld = 512; colt = pn * 256; } else if (pn < 4) { boff = WS_Q; ld = 512; colt = (pn - 2) * 256; } else if (pn == 4) { boff = WS_KV; ld = 256; colt = 0; }
        else if (pn < 9) { boff = WS_Z; ld = 1024; colt = (pn - 5) * 256; } else { boff = WS_BCR; ld = 512; colt = (pn - 13) * 256; }
        if (pn >= 9 && pn < 13) {
#pragma unroll
            for (int ai = 0; ai < 2; ++ai)
#pragma unroll
                for (int m = 0; m < 4; ++m) { const int row = row0 + ai * HALF + m * 16;
#pragma unroll
                    for (int bj = 0; bj < 2; ++bj) { const int head = (pn - 9) * 4 + bj * 2 + (wc >> 1); const f32x4 v0 = acc[ai][bj][m][0], v1 = acc[ai][bj][m][1];
                        u32x4 w; w.x = cvt_pk_bf16_c(v0[0], v0[1]); w.y = cvt_pk_bf16_c(v0[2], v0[3]); w.z = cvt_pk_bf16_c(v1[0], v1[1]); w.w = cvt_pk_bf16_c(v1[2], v1[3]);
                        *(u32x4*)((bf16_t*)(ws + WS_X2) + ((size_t)head * MTOK + row) * 64 + (wc & 1) * 32 + 8 * fq) = w; } }
            return;
        }
        bf16_t* base = (bf16_t*)(ws + boff) + colt + cw;
#pragma unroll
        for (int ai = 0; ai < 2; ++ai)
#pragma unroll
            for (int m = 0; m < 4; ++m) { bf16_t* rowp = base + (size_t)(row0 + ai * HALF + m * 16) * ld;
#pragma unroll
                for (int bj = 0; bj < 2; ++bj) { const f32x4 v0 = acc[ai][bj][m][0], v1 = acc[ai][bj][m][1];
                    u32x4 w; w.x = cvt_pk_bf16_c(v0[0], v0[1]); w.y = cvt_pk_bf16_c(v0[2], v0[3]); w.z = cvt_pk_bf16_c(v1[0], v1[1]); w.w = cvt_pk_bf16_c(v1[2], v1[3]);
                    *(u32x4*)(rowp + bj * HALF) = w; } }
        if (pn == 4 && u.pm < 32) {
#pragma unroll
            for (int ai = 0; ai < 2; ++ai)
#pragma unroll
                for (int m = 0; m < 4; ++m) { const int row = row0 + ai * HALF + m * 16; float* o = out_cv + ((size_t)((row >> 8) * 2 + layer) * 256 + (row & 255)) * 128 + cw;
                    *(f32x4*)o = acc[ai][1][m][0]; *(f32x4*)(o + 4) = acc[ai][1][m][1]; }
        }
    }
};

template <int ACT, int MT_> struct EpiAct {
    static constexpr bool PERM = true, AFTER_DRAIN = false; static constexpr int MT = MT_;
    bf16_t* O; int ldc;
    __device__ __forceinline__ void operator()(const f32x4 (&acc)[2][2][MT_][2], const Unit& u, int wr, int wc, int fr, int fq) const {
        const int row0 = u.pm * (64 * MT_) + wr * (16 * MT_) + fr, col0 = u.pn * BM + wc * 32 + 8 * fq;
#pragma unroll
        for (int ai = 0; ai < 2; ++ai)
#pragma unroll
            for (int m = 0; m < MT_; ++m) { bf16_t* rowp = O + (size_t)(row0 + ai * (32 * MT_) + m * 16) * ldc + col0;
#pragma unroll
                for (int bj = 0; bj < 2; ++bj) { f32x4 v0 = acc[ai][bj][m][0], v1 = acc[ai][bj][m][1];
#pragma unroll
                    for (int e = 0; e < 4; ++e) {
                        if (ACT == 1) { v0[e] = __builtin_amdgcn_rcpf(1.f + __expf(-v0[e])); v1[e] = __builtin_amdgcn_rcpf(1.f + __expf(-v1[e])); }
                        if (ACT == 2) { const float a = fmaxf(v0[e], 0.f), b = fmaxf(v1[e], 0.f); v0[e] = a * a; v1[e] = b * b; } }
                    u32x4 w; w.x = cvt_pk_bf16_c(v0[0], v0[1]); w.y = cvt_pk_bf16_c(v0[2], v0[3]); w.z = cvt_pk_bf16_c(v1[0], v1[1]); w.w = cvt_pk_bf16_c(v1[2], v1[3]);
                    *(u32x4*)(rowp + bj * HALF) = w; } }
    }
};

struct EpiGate8 {
    static constexpr bool PERM = true, AFTER_DRAIN = false; static constexpr int MT = 4;
    unsigned char* G8;
    __device__ __forceinline__ void operator()(const f32x4 (&acc)[2][2][4][2], const Unit& u, int wr, int wc, int fr, int fq) const {
        const int row0 = u.pm * BM + wr * 64 + fr, col0 = u.pn * BM + wc * 32 + 8 * fq;
#pragma unroll
        for (int ai = 0; ai < 2; ++ai)
#pragma unroll
            for (int m = 0; m < 4; ++m) { unsigned char* rowp = G8 + (size_t)(row0 + ai * HALF + m * 16) * 3072 + col0;
#pragma unroll
                for (int bj = 0; bj < 2; ++bj) { const f32x4 v0 = acc[ai][bj][m][0], v1 = acc[ai][bj][m][1];
                    unsigned q[8];
#pragma unroll
                    for (int e = 0; e < 4; ++e) { q[e] = (unsigned)(255.f * __builtin_amdgcn_rcpf(1.f + __expf(-v0[e])) + 0.5f); q[4 + e] = (unsigned)(255.f * __builtin_amdgcn_rcpf(1.f + __expf(-v1[e])) + 0.5f); }
                    u32x2 w; w.x = q[0] | (q[1] << 8) | (q[2] << 16) | (q[3] << 24); w.y = q[4] | (q[5] << 8) | (q[6] << 16) | (q[7] << 24);
                    *(u32x2*)(rowp + bj * HALF) = w; } }
    }
};
template <int MT_> struct EpiMerge {
    static constexpr bool PERM = true, AFTER_DRAIN = false; static constexpr int MT = MT_;
    const unsigned char* G8; bf16_t* MG; int first; const float* ssq;
    __device__ __forceinline__ void operator()(const f32x4 (&acc)[2][2][MT_][2], const Unit& u, int wr, int wc, int fr, int fq) const {
        const int row0 = u.pm * (64 * MT_) + wr * (16 * MT_) + fr, col0 = u.pn * BM + wc * 32 + 8 * fq;
        constexpr float S = 1.0f / 255.0f;
#pragma unroll
        for (int ai = 0; ai < 2; ++ai)
#pragma unroll
            for (int m = 0; m < MT_; ++m) { const int row = row0 + ai * (32 * MT_) + m * 16; const size_t off = (size_t)row * 1024 + col0;
                const float rs = ssq ? S * (1.0f / sqrtf(ssq[row] * (1.0f / 1024.0f) + 1e-6f)) : S;
#pragma unroll
                for (int bj = 0; bj < 2; ++bj) { const f32x4 v0 = acc[ai][bj][m][0], v1 = acc[ai][bj][m][1];
                    const u32x2 gq = *(const u32x2*)(G8 + (size_t)row * 3072 + col0 + bj * HALF);
                    float r[8];
                    r[0] = (float)(gq.x & 255u) * rs * v0[0]; r[1] = (float)((gq.x >> 8) & 255u) * rs * v0[1]; r[2] = (float)((gq.x >> 16) & 255u) * rs * v0[2]; r[3] = (float)(gq.x >> 24) * rs * v0[3];
                    r[4] = (float)(gq.y & 255u) * rs * v1[0]; r[5] = (float)((gq.y >> 8) & 255u) * rs * v1[1]; r[6] = (float)((gq.y >> 16) & 255u) * rs * v1[2]; r[7] = (float)(gq.y >> 24) * rs * v1[3];
                    if (!first) { const u32x4 mq = *(const u32x4*)(MG + off + bj * HALF);
                        r[0] += bf_lo(mq.x); r[1] += bf_hi(mq.x); r[2] += bf_lo(mq.y); r[3] += bf_hi(mq.y); r[4] += bf_lo(mq.z); r[5] += bf_hi(mq.z); r[6] += bf_lo(mq.w); r[7] += bf_hi(mq.w); }
                    u32x4 w; w.x = cvt_pk_bf16_c(r[0], r[1]); w.y = cvt_pk_bf16_c(r[2], r[3]); w.z = cvt_pk_bf16_c(r[4], r[5]); w.w = cvt_pk_bf16_c(r[6], r[7]);
                    *(u32x4*)(MG + off + bj * HALF) = w; } }
    }
};

template <int MT_, bool XIN_BF, bool XOUT_BF> struct EpiResid {
    static constexpr bool PERM = true, AFTER_DRAIN = false; static constexpr int MT = MT_;
    const void *xa, *xb; void* xout; const float* gate; float gscale;
    __device__ __forceinline__ void operator()(const f32x4 (&acc)[2][2][MT_][2], const Unit& u, int wr, int wc, int fr, int fq) const {
        const int row0 = u.pm * (64 * MT_) + wr * (16 * MT_) + fr, col0 = u.pn * BM + wc * 32 + 8 * fq;
#pragma unroll
        for (int ai = 0; ai < 2; ++ai)
#pragma unroll
            for (int m = 0; m < MT_; ++m) { const int row = row0 + ai * (32 * MT_) + m * 16; const size_t off = (size_t)row * 1024 + col0;
                const int mi = row < MCTX ? 0 : 1 + ((row - MCTX) >> 11);
                const float* xin = (xb != nullptr && row >= MCTX) ? (const float*)xb - (size_t)MCTX * 1024 : (const float*)xa;
                const float* gp = gate + (size_t)mi * 6144 + col0;
#pragma unroll
                for (int bj = 0; bj < 2; ++bj) { f32x4 x0, x1;
                    if (XIN_BF) { const u32x4 q = *(const u32x4*)((const bf16_t*)xa + off + bj * HALF);
                        x0 = (f32x4){bf_lo(q.x), bf_hi(q.x), bf_lo(q.y), bf_hi(q.y)}; x1 = (f32x4){bf_lo(q.z), bf_hi(q.z), bf_lo(q.w), bf_hi(q.w)}; }
                    else { x0 = *(const f32x4*)(xin + off + bj * HALF); x1 = *(const f32x4*)(xin + off + bj * HALF + 4); }
                    const f32x4 g0 = *(const f32x4*)(gp + bj * HALF), g1 = *(const f32x4*)(gp + bj * HALF + 4);
                    const f32x4 r0 = x0 + g0 * acc[ai][bj][m][0] * gscale, r1 = x1 + g1 * acc[ai][bj][m][1] * gscale;
                    if (XOUT_BF) { u32x4 w; w.x = cvt_pk_bf16_c(r0[0], r0[1]); w.y = cvt_pk_bf16_c(r0[2], r0[3]); w.z = cvt_pk_bf16_c(r1[0], r1[1]); w.w = cvt_pk_bf16_c(r1[2], r1[3]);
                        *(u32x4*)((bf16_t*)xout + off + bj * HALF) = w; }
                    else { *(f32x4*)((float*)xout + off + bj * HALF) = r0; *(f32x4*)((float*)xout + off + bj * HALF + 4) = r1; } } }
    }
};

template <class Epi, class Sched, bool ALIGN_EPI = false, bool SP2 = false>
__device__ __forceinline__ void gemm_phase(PG8_LAS unsigned char* lds, const Gemm g, const Sched& S, const Epi& E) {
    int tid_ = threadIdx.x; asm volatile("" : "+v"(tid_));
    const int tid = tid_, wid = __builtin_amdgcn_readfirstlane(tid >> 6), lane = tid & 63, wr = wid >> 2, wc = wid & 3, fr = lane & 15, fq = lane >> 4;
    const int K = g.K, nt = K / BK;
    unsigned voffA[2], voffB[2];
#pragma unroll
    for (int i = 0; i < 2; ++i) { int R, C; stage_rc(tid * 16 + i * 8192, R, C); const int Rb = Epi::PERM ? ((R & ~31) + perm32(R & 31)) : R;
        voffA[i] = (unsigned)(R * K + C) * 2u; voffB[i] = (unsigned)(Rb * K + C) * 2u; }
    const size_t kstep = (size_t)(BK * 2);
    constexpr int MT = Epi::MT;
    static_assert(MT == 4 || (MT == 3 && SP2), "192-row tiles: SP2 loop only");
    const size_t hstepB = (size_t)HALF * K * 2, hstepA = (size_t)(32 * MT) * K * 2;
    const size_t tstepB = 2 * hstepB, tstepA = 2 * hstepA;
    const unsigned ldsw = (unsigned)wid * 1024u;
    const int aoff = lds_byte(wr * (16 * MT) + fr, fq * 8), boff = lds_byte(wc * 32 + fr, fq * 8);
#define PG8_SA(b, h) (((b) * 2 + (h)) * HTB)
#define PG8_SB(b, h) ((4 + (b) * 2 + (h)) * HTB)
#define PG8_STAGE(bufoff, gbase, voff) do { _Pragma("unroll") for (int _i = 0; _i < 2; ++_i) \
        __builtin_amdgcn_global_load_lds((const unsigned*)((const char*)(gbase) + (voff)[_i]), (PG8_LAS unsigned*)(lds + (bufoff) + ldsw + _i * 8192), 16, 0, 0); } while (0)
#define PG8_LDA(dst, b, h) do { _Pragma("unroll") for (int m = 0; m < MT; ++m) _Pragma("unroll") for (int k = 0; k < 2; ++k) dst[m][k] = *(const PG8_LAS bf16x8*)(lds + PG8_SA(b, h) + aoff + m * 2048 + k * 1024); } while (0)
#define PG8_LDB(dst, b, h) do { _Pragma("unroll") for (int n = 0; n < 2; ++n) _Pragma("unroll") for (int k = 0; k < 2; ++k) dst[n][k] = *(const PG8_LAS bf16x8*)(lds + PG8_SB(b, h) + boff + n * 2048 + k * 1024); } while (0)
#define PG8_MMA(ai, bj, At, Bt) do { __builtin_amdgcn_s_setprio(1); _Pragma("unroll") for (int m = 0; m < MT; ++m) _Pragma("unroll") for (int n = 0; n < 2; ++n) _Pragma("unroll") for (int k = 0; k < 2; ++k) \
        acc[ai][bj][m][n] = __builtin_amdgcn_mfma_f32_16x16x32_bf16(Bt[n][k], At[m][k], acc[ai][bj][m][n], 0, 0, 0); __builtin_amdgcn_s_setprio(0); } while (0)
#define PG8_WAIT_V(n) asm volatile("s_waitcnt vmcnt(" #n ")" ::: "memory")
#define PG8_WAIT_L(n) asm volatile("s_waitcnt lgkmcnt(" #n ")" ::: "memory")
#define PG8_BAR __builtin_amdgcn_s_barrier()
#define PG8_SCHED __builtin_amdgcn_sched_barrier(0)
    Unit cur, nxt; int ui = 0;
    if (!S.next(0, cur)) return;
    f32x4 acc[2][2][MT][2];
#pragma unroll
    for (int a = 0; a < 2; ++a)
#pragma unroll
        for (int b = 0; b < 2; ++b)
#pragma unroll
            for (int m = 0; m < MT; ++m)
#pragma unroll
                for (int n = 0; n < 2; ++n) acc[a][b][m][n] = (f32x4){0.f, 0.f, 0.f, 0.f};
    bf16x8 At[MT][2], B0[2][2], B1[2][2];
    const char* cA = (const char*)g.A + (size_t)cur.pm * tstepA; const char* cB = (const char*)g.Bt + (size_t)cur.pn * tstepB;
    S.a_ready(cur);
    if constexpr (SP2) {
        PG8_STAGE(PG8_SB(0, 0), cB, voffB); PG8_STAGE(PG8_SB(0, 1), cB + hstepB, voffB); PG8_STAGE(PG8_SA(0, 0), cA, voffA); PG8_STAGE(PG8_SA(0, 1), cA + hstepA, voffA);
        if (wr == 1) PG8_BAR;
        PG8_WAIT_V(2); PG8_BAR;
        PG8_STAGE(PG8_SB(1, 0), cB + kstep, voffB); PG8_STAGE(PG8_SA(1, 0), cA + kstep, voffA); PG8_STAGE(PG8_SB(1, 1), cB + hstepB + kstep, voffB);
        PG8_WAIT_V(6); PG8_BAR;
    } else {
        PG8_STAGE(PG8_SB(0, 0), cB, voffB); PG8_STAGE(PG8_SA(0, 0), cA, voffA); PG8_STAGE(PG8_SB(0, 1), cB + hstepB, voffB); PG8_STAGE(PG8_SA(0, 1), cA + hstepA, voffA);
        if (wr == 1) PG8_BAR;
        PG8_WAIT_V(4); PG8_BAR;
        PG8_STAGE(PG8_SB(1, 0), cB + kstep, voffB); PG8_STAGE(PG8_SA(1, 0), cA + kstep, voffA); PG8_STAGE(PG8_SB(1, 1), cB + hstepB + kstep, voffB);
        PG8_WAIT_V(6); PG8_BAR;
    }
    for (;;) {
        const bool has_next = S.next(ui + 1, nxt);
        const char* nA = has_next ? (const char*)g.A + (size_t)nxt.pm * tstepA : cA; const char* nB = has_next ? (const char*)g.Bt + (size_t)nxt.pn * tstepB : cB;
        for (int t = 0; t < nt; t += 2) {
            const bool last = (t == nt - 2);
            const char* a1 = cA + (size_t)(t + 1) * kstep;
            const char* a2 = last ? nA : cA + (size_t)(t + 2) * kstep; const char* b2 = last ? nB : cB + (size_t)(t + 2) * kstep;
            const char* a3 = a2 + kstep; const char* b3 = b2 + kstep;
            if (last && has_next) S.a_ready(nxt);
            if constexpr (SP2) {
            PG8_LDB(B0, 0, 0); PG8_LDB(B1, 0, 1); PG8_SCHED; PG8_LDA(At, 0, 0); PG8_STAGE(PG8_SA(1, 1), a1 + hstepA, voffA);
            PG8_WAIT_V(8); PG8_WAIT_L(0); PG8_BAR; PG8_MMA(0, 0, At, B0); PG8_MMA(0, 1, At, B1); PG8_BAR; PG8_SCHED;
            PG8_LDA(At, 0, 1); PG8_STAGE(PG8_SB(0, 0), b2, voffB); PG8_STAGE(PG8_SB(0, 1), b2 + hstepB, voffB); PG8_STAGE(PG8_SA(0, 0), a2, voffA);
            PG8_WAIT_V(8); PG8_WAIT_L(0); PG8_BAR; PG8_MMA(1, 0, At, B0); PG8_MMA(1, 1, At, B1); PG8_BAR; PG8_SCHED;
            PG8_LDB(B0, 1, 0); PG8_LDB(B1, 1, 1); PG8_SCHED; PG8_LDA(At, 1, 0); PG8_STAGE(PG8_SA(0, 1), a2 + hstepA, voffA);
            PG8_WAIT_V(8); PG8_WAIT_L(0); PG8_BAR; PG8_MMA(0, 0, At, B0); PG8_MMA(0, 1, At, B1); PG8_BAR; PG8_SCHED;
            PG8_LDA(At, 1, 1); PG8_STAGE(PG8_SB(1, 0), b3, voffB); PG8_STAGE(PG8_SB(1, 1), b3 + hstepB, voffB); PG8_STAGE(PG8_SA(1, 0), a3, voffA);
            PG8_WAIT_V(8); PG8_WAIT_L(0); PG8_BAR; PG8_MMA(1, 0, At, B0); PG8_MMA(1, 1, At, B1); PG8_BAR; PG8_SCHED;
            } else {
            PG8_LDB(B0, 0, 0); PG8_SCHED; PG8_LDA(At, 0, 0); PG8_STAGE(PG8_SA(1, 1), a1 + hstepA, voffA);
            PG8_WAIT_L(8); PG8_BAR; PG8_WAIT_L(0); PG8_MMA(0, 0, At, B0); PG8_BAR; PG8_SCHED;
            PG8_LDB(B1, 0, 1); PG8_STAGE(PG8_SB(0, 0), b2, voffB);
            PG8_BAR; PG8_WAIT_L(0); PG8_MMA(0, 1, At, B1); PG8_BAR;
            PG8_LDA(At, 0, 1); PG8_STAGE(PG8_SA(0, 0), a2, voffA);
            PG8_BAR; PG8_WAIT_L(0); PG8_MMA(1, 0, At, B0); PG8_BAR; PG8_SCHED;
            PG8_STAGE(PG8_SB(0, 1), b2 + hstepB, voffB);
            PG8_WAIT_V(6); PG8_BAR; PG8_MMA(1, 1, At, B1); PG8_BAR;
            PG8_LDB(B0, 1, 0); PG8_SCHED; PG8_LDA(At, 1, 0); PG8_STAGE(PG8_SA(0, 1), a2 + hstepA, voffA);
            PG8_WAIT_L(8); PG8_BAR; PG8_WAIT_L(0); PG8_MMA(0, 0, At, B0); PG8_BAR; PG8_SCHED;
            PG8_LDB(B1, 1, 1); PG8_STAGE(PG8_SB(1, 0), b3, voffB);
            PG8_BAR; PG8_WAIT_L(0); PG8_MMA(0, 1, At, B1); PG8_BAR;
            PG8_LDA(At, 1, 1); PG8_STAGE(PG8_SA(1, 0), a3, voffA);
            PG8_BAR; PG8_WAIT_L(0); PG8_MMA(1, 0, At, B0); PG8_BAR; PG8_SCHED;
            PG8_STAGE(PG8_SB(1, 1), b3 + hstepB, voffB);
            PG8_WAIT_V(6); PG8_BAR; PG8_MMA(1, 1, At, B1); PG8_BAR;
            }
        }
        if constexpr (ALIGN_EPI) { if (wr == 0) PG8_BAR; }
        if constexpr (!Epi::AFTER_DRAIN) { E(acc, cur, wr, wc, fr, fq); S.done(cur); }
        if (!has_next) break;
#pragma unroll
        for (int a = 0; a < 2; ++a)
#pragma unroll
            for (int b = 0; b < 2; ++b)
#pragma unroll
                for (int m = 0; m < MT; ++m)
#pragma unroll
                    for (int n = 0; n < 2; ++n) acc[a][b][m][n] = (f32x4){0.f, 0.f, 0.f, 0.f};
        cur = nxt; cA = nA; cB = nB; ++ui;
        if constexpr (ALIGN_EPI) { if (wr == 1) PG8_BAR; }
    }
    PG8_WAIT_V(0);
    if constexpr (!ALIGN_EPI) { if (wr == 0) PG8_BAR; }
    PG8_BAR;
    if constexpr (Epi::AFTER_DRAIN) { E.fused(acc, cur, wr, wc, fr, fq, lds, wid, lane); S.done(cur); }
#undef PG8_SA
#undef PG8_SB
#undef PG8_STAGE
#undef PG8_LDA
#undef PG8_LDB
#undef PG8_MMA
#undef PG8_WAIT_V
#undef PG8_WAIT_L
#undef PG8_BAR
#undef PG8_SCHED
}

template <class Sched>
__device__ __forceinline__ void gemm_merge3(PG8_LAS unsigned char* lds, const bf16_t* A0, const bf16_t* A1, const bf16_t* A2, const bf16_t* W0, const bf16_t* W1, const bf16_t* W2,
                                            const Sched& S, const unsigned char* G8, bf16_t* MG, const float* ssq) {
    int tid_ = threadIdx.x; asm volatile("" : "+v"(tid_));
    const int tid = tid_, wid = __builtin_amdgcn_readfirstlane(tid >> 6), lane = tid & 63, wr = wid >> 2, wc = wid & 3, fr = lane & 15, fq = lane >> 4;
    constexpr int MT = 3;
    unsigned rA[2], rB[2], c2[2];
#pragma unroll
    for (int i = 0; i < 2; ++i) { int R, C; stage_rc(tid * 16 + i * 8192, R, C); rA[i] = (unsigned)R; rB[i] = (unsigned)((R & ~31) + perm32(R & 31)); c2[i] = (unsigned)C * 2u; }
    const size_t kstep = (size_t)(BK * 2);
    const unsigned ldsw = (unsigned)wid * 1024u;
    const int aoff = lds_byte(wr * (16 * MT) + fr, fq * 8), boff = lds_byte(wc * 32 + fr, fq * 8);
#define PG8_SA(b, h) (((b) * 2 + (h)) * HTB)
#define PG8_SB(b, h) ((4 + (b) * 2 + (h)) * HTB)
#define PG8_STAGE(bufoff, gbase, rr, kb) do { _Pragma("unroll") for (int _i = 0; _i < 2; ++_i) \
        __builtin_amdgcn_global_load_lds((const unsigned*)((const char*)(gbase) + ((rr)[_i] * (unsigned)(kb) + c2[_i])), (PG8_LAS unsigned*)(lds + (bufoff) + ldsw + _i * 8192), 16, 0, 0); } while (0)
#define PG8_LDA(dst, b, h) do { _Pragma("unroll") for (int m = 0; m < MT; ++m) _Pragma("unroll") for (int k = 0; k < 2; ++k) dst[m][k] = *(const PG8_LAS bf16x8*)(lds + PG8_SA(b, h) + aoff + m * 2048 + k * 1024); } while (0)
#define PG8_LDB(dst, b, h) do { _Pragma("unroll") for (int n = 0; n < 2; ++n) _Pragma("unroll") for (int k = 0; k < 2; ++k) dst[n][k] = *(const PG8_LAS bf16x8*)(lds + PG8_SB(b, h) + boff + n * 2048 + k * 1024); } while (0)
#define PG8_MMA(ai, bj, At, Bt) do { __builtin_amdgcn_s_setprio(1); _Pragma("unroll") for (int m = 0; m < MT; ++m) _Pragma("unroll") for (int n = 0; n < 2; ++n) _Pragma("unroll") for (int k = 0; k < 2; ++k) \
        acc[ai][bj][m][n] = __builtin_amdgcn_mfma_f32_16x16x32_bf16(Bt[n][k], At[m][k], acc[ai][bj][m][n], 0, 0, 0); __builtin_amdgcn_s_setprio(0); } while (0)
#define PG8_WAIT_V(n) asm volatile("s_waitcnt vmcnt(" #n ")" ::: "memory")
#define PG8_WAIT_L(n) asm volatile("s_waitcnt lgkmcnt(" #n ")" ::: "memory")
#define PG8_BAR __builtin_amdgcn_s_barrier()
#define PG8_SCHED __builtin_amdgcn_sched_barrier(0)
#define PG8_SEGA(s) ((const char*)((s) == 0 ? A0 : (s) == 1 ? A1 : A2))
#define PG8_SEGW(s) ((const char*)((s) == 0 ? W0 : (s) == 1 ? W1 : W2))
    Unit cur, nxt; int ti = 0, seg = 0;
    if (!S.next(0, cur)) return;
    f32x4 acc[2][2][MT][2];
#pragma unroll
    for (int a = 0; a < 2; ++a)
#pragma unroll
        for (int b = 0; b < 2; ++b)
#pragma unroll
            for (int m = 0; m < MT; ++m)
#pragma unroll
                for (int n = 0; n < 2; ++n) acc[a][b][m][n] = (f32x4){0.f, 0.f, 0.f, 0.f};
    u32x4 mrg[2][MT][2];
    bf16x8 At[MT][2], B0[2][2], B1[2][2];
    int kb = 512 * 2;
    const char* cA = PG8_SEGA(0) + (size_t)cur.pm * (size_t)(64 * MT) * kb; const char* cB = PG8_SEGW(0) + (size_t)cur.pn * (size_t)BM * kb;
    {   const size_t hA = (size_t)(32 * MT) * kb, hB = (size_t)HALF * kb;
        PG8_STAGE(PG8_SB(0, 0), cB, rB, kb); PG8_STAGE(PG8_SB(0, 1), cB + hB, rB, kb); PG8_STAGE(PG8_SA(0, 0), cA, rA, kb); PG8_STAGE(PG8_SA(0, 1), cA + hA, rA, kb);
        if (wr == 1) PG8_BAR;
        PG8_WAIT_V(2); PG8_BAR;
        PG8_STAGE(PG8_SB(1, 0), cB + kstep, rB, kb); PG8_STAGE(PG8_SA(1, 0), cA + kstep, rA, kb); PG8_STAGE(PG8_SB(1, 1), cB + hB + kstep, rB, kb);
        PG8_WAIT_V(6); PG8_BAR; }
    for (;;) {
        int nseg = seg + 1; bool has_next = true; Unit nu = cur;
        if (nseg == 3) { nseg = 0; has_next = S.next(ti + 1, nxt); nu = nxt; }
        const int nkb = has_next ? (nseg == 2 ? 2048 : 1024) : kb;
        const char* nA = has_next ? PG8_SEGA(nseg) + (size_t)nu.pm * (size_t)(64 * MT) * nkb : cA; const char* nB = has_next ? PG8_SEGW(nseg) + (size_t)nu.pn * (size_t)BM * nkb : cB;
        const int nt = kb >> 7;
        const size_t hA = (size_t)(32 * MT) * kb, hB = (size_t)HALF * kb;
        for (int t = 0; t < nt; t += 2) {
            const bool last = (t == nt - 2);
            const char* a1 = cA + (size_t)(t + 1) * kstep;
            const char* a2 = last ? nA : cA + (size_t)(t + 2) * kstep; const char* b2 = last ? nB : cB + (size_t)(t + 2) * kstep;
            const char* a3 = a2 + kstep; const char* b3 = b2 + kstep;
            const int kb2 = last ? nkb : kb; const size_t hA2 = (size_t)(32 * MT) * kb2, hB2 = (size_t)HALF * kb2;
            PG8_LDB(B0, 0, 0); PG8_LDB(B1, 0, 1); PG8_SCHED; PG8_LDA(At, 0, 0); PG8_STAGE(PG8_SA(1, 1), a1 + hA, rA, kb);
            PG8_WAIT_V(8); PG8_WAIT_L(0); PG8_BAR; PG8_MMA(0, 0, At, B0); PG8_MMA(0, 1, At, B1); PG8_BAR; PG8_SCHED;
            PG8_LDA(At, 0, 1); PG8_STAGE(PG8_SB(0, 0), b2, rB, kb2); PG8_STAGE(PG8_SB(0, 1), b2 + hB2, rB, kb2); PG8_STAGE(PG8_SA(0, 0), a2, rA, kb2);
            PG8_WAIT_V(8); PG8_WAIT_L(0); PG8_BAR; PG8_MMA(1, 0, At, B0); PG8_MMA(1, 1, At, B1); PG8_BAR; PG8_SCHED;
            PG8_LDB(B0, 1, 0); PG8_LDB(B1, 1, 1); PG8_SCHED; PG8_LDA(At, 1, 0); PG8_STAGE(PG8_SA(0, 1), a2 + hA2, rA, kb2);
            PG8_WAIT_V(8); PG8_WAIT_L(0); PG8_BAR; PG8_MMA(0, 0, At, B0); PG8_MMA(0, 1, At, B1); PG8_BAR; PG8_SCHED;
            PG8_LDA(At, 1, 1); PG8_STAGE(PG8_SB(1, 0), b3, rB, kb2); PG8_STAGE(PG8_SB(1, 1), b3 + hB2, rB, kb2); PG8_STAGE(PG8_SA(1, 0), a3, rA, kb2);
            PG8_WAIT_V(8); PG8_WAIT_L(0); PG8_BAR; PG8_MMA(1, 0, At, B0); PG8_MMA(1, 1, At, B1); PG8_BAR; PG8_SCHED;
        }
        if (wr == 0) PG8_BAR;
        {
            const int row0 = cur.pm * (64 * MT) + wr * (16 * MT) + fr, col0 = cur.pn * BM + wc * 32 + 8 * fq;
            constexpr float SC = 1.0f / 255.0f;
#pragma unroll
            for (int ai = 0; ai < 2; ++ai)
#pragma unroll
                for (int m = 0; m < MT; ++m) { const int row = row0 + ai * (32 * MT) + m * 16;
                    const float rs = seg == 2 ? SC * (1.0f / sqrtf(ssq[row] * (1.0f / 1024.0f) + 1e-6f)) : SC;
#pragma unroll
                    for (int bj = 0; bj < 2; ++bj) { const f32x4 v0 = acc[ai][bj][m][0], v1 = acc[ai][bj][m][1];
                        const u32x2 gq = *(const u32x2*)(G8 + (size_t)row * 3072 + seg * 1024 + col0 + bj * HALF);
                        float r[8];
                        r[0] = (float)(gq.x & 255u) * rs * v0[0]; r[1] = (float)((gq.x >> 8) & 255u) * rs * v0[1]; r[2] = (float)((gq.x >> 16) & 255u) * rs * v0[2]; r[3] = (float)(gq.x >> 24) * rs * v0[3];
                        r[4] = (float)(gq.y & 255u) * rs * v1[0]; r[5] = (float)((gq.y >> 8) & 255u) * rs * v1[1]; r[6] = (float)((gq.y >> 16) & 255u) * rs * v1[2]; r[7] = (float)(gq.y >> 24) * rs * v1[3];
                        if (seg != 0) { const u32x4 mq = mrg[ai][m][bj];
                            r[0] += __uint_as_float(mq.x << 16); r[1] += __uint_as_float(mq.x & 0xffff0000u); r[2] += __uint_as_float(mq.y << 16); r[3] += __uint_as_float(mq.y & 0xffff0000u);
                            r[4] += __uint_as_float(mq.z << 16); r[5] += __uint_as_float(mq.z & 0xffff0000u); r[6] += __uint_as_float(mq.w << 16); r[7] += __uint_as_float(mq.w & 0xffff0000u); }
                        u32x4 w; w.x = cvt_pk_bf16_c(r[0], r[1]); w.y = cvt_pk_bf16_c(r[2], r[3]); w.z = cvt_pk_bf16_c(r[4], r[5]); w.w = cvt_pk_bf16_c(r[6], r[7]);
                        mrg[ai][m][bj] = w;
                        if (seg == 2) *(u32x4*)(MG + (size_t)row * 1024 + col0 + bj * HALF) = w; } }
        }
        if (!has_next) break;
#pragma unroll
        for (int a = 0; a < 2; ++a)
#pragma unroll
            for (int b = 0; b < 2; ++b)
#pragma unroll
                for (int m = 0; m < MT; ++m)
#pragma unroll
                    for (int n = 0; n < 2; ++n) acc[a][b][m][n] = (f32x4){0.f, 0.f, 0.f, 0.f};
        if (nseg == 0) { cur = nxt; ++ti; }
        seg = nseg; kb = nkb; cA = nA; cB = nB;
        if (wr == 1) PG8_BAR;
    }
    PG8_WAIT_V(0);
    PG8_BAR;
#undef PG8_SEGA
#undef PG8_SEGW
#undef PG8_SA
#undef PG8_SB
#undef PG8_STAGE
#undef PG8_LDA
#undef PG8_LDB
#undef PG8_MMA
#undef PG8_WAIT_V
#undef PG8_WAIT_L
#undef PG8_BAR
#undef PG8_SCHED
}
template <class Sched>
__device__ __forceinline__ void gemm_merge6(PG8_LAS unsigned char* lds, const bf16_t* H, const bf16_t* WG, const bf16_t* A0, const bf16_t* A1, const bf16_t* A2, const bf16_t* W0, const bf16_t* W1, const bf16_t* W2,
                                            const Sched& S, bf16_t* MG, const float* ssqh) {
    constexpr int GT_OFF = 133120;
    int tid_ = threadIdx.x; asm volatile("" : "+v"(tid_));
    const int tid = tid_, wid = __builtin_amdgcn_readfirstlane(tid >> 6), lane = tid & 63, wr = wid >> 2, wc = wid & 3, fr = lane & 15, fq = lane >> 4;
    constexpr int MT = 3;
    unsigned rA, rB, c2;
    { int R, C; stage_rc(tid * 16, R, C); rA = (unsigned)R; rB = (unsigned)((R & ~31) + perm32(R & 31)); c2 = (unsigned)C * 2u; }
    const size_t kstep = (size_t)(BK * 2);
    const unsigned ldsw = (unsigned)wid * 1024u;
    const int aoff = lds_byte(wr * (16 * MT) + fr, fq * 8), boff = lds_byte(wc * 32 + fr, fq * 8);
#define PG8_SA(b, h) (((b) * 2 + (h)) * HTB)
#define PG8_SB(b, h) ((4 + (b) * 2 + (h)) * HTB)
#define PG8_STAGE(bufoff, gbase, rr, kb) do { const unsigned vo_ = (rr) * (unsigned)(kb) + c2; _Pragma("unroll") for (int _i = 0; _i < 2; ++_i) \
        __builtin_amdgcn_global_load_lds((const unsigned*)((const char*)(gbase) + (size_t)(_i * 64) * (size_t)(kb) + vo_), (PG8_LAS unsigned*)(lds + (bufoff) + ldsw + _i * 8192), 16, 0, 0); } while (0)
#define PG8_LDA(dst, b, h) do { _Pragma("unroll") for (int m = 0; m < MT; ++m) _Pragma("unroll") for (int k = 0; k < 2; ++k) dst[m][k] = *(const PG8_LAS bf16x8*)(lds + PG8_SA(b, h) + aoff + m * 2048 + k * 1024); } while (0)
#define PG8_LDB(dst, b, h) do { _Pragma("unroll") for (int n = 0; n < 2; ++n) _Pragma("unroll") for (int k = 0; k < 2; ++k) dst[n][k] = *(const PG8_LAS bf16x8*)(lds + PG8_SB(b, h) + boff + n * 2048 + k * 1024); } while (0)
#define PG8_MMA(ai, bj, At, Bt) do { __builtin_amdgcn_s_setprio(1); _Pragma("unroll") for (int m = 0; m < MT; ++m) _Pragma("unroll") for (int n = 0; n < 2; ++n) _Pragma("unroll") for (int k = 0; k < 2; ++k) \
        acc[ai][bj][m][n] = __builtin_amdgcn_mfma_f32_16x16x32_bf16(Bt[n][k], At[m][k], acc[ai][bj][m][n], 0, 0, 0); __builtin_amdgcn_s_setprio(0); } while (0)
#define PG8_WAIT_V(n) asm volatile("s_waitcnt vmcnt(" #n ")" ::: "memory")
#define PG8_WAIT_L(n) asm volatile("s_waitcnt lgkmcnt(" #n ")" ::: "memory")
#define PG8_BAR __builtin_amdgcn_s_barrier()
#define PG8_SCHED __builtin_amdgcn_sched_barrier(0)
#define PG8_SEGA(s) ((const char*)(((s) & 1) == 0 ? H : (s) == 1 ? A0 : (s) == 3 ? A1 : A2))
#define PG8_SEGW(s) ((const char*)(((s) & 1) == 0 ? WG + (size_t)((s) >> 1) * 1024 * 1024 : (s) == 1 ? W0 : (s) == 3 ? W1 : W2))
#define PG8_SEGKB(s) (((s) == 1 || (s) == 3) ? 1024 : 2048)
    Unit cur, nxt; int ti = 0, seg = 0;
    if (!S.next(0, cur)) return;
    f32x4 acc[2][2][MT][2];
#pragma unroll
    for (int a = 0; a < 2; ++a)
#pragma unroll
        for (int b = 0; b < 2; ++b)
#pragma unroll
            for (int m = 0; m < MT; ++m)
#pragma unroll
                for (int n = 0; n < 2; ++n) acc[a][b][m][n] = (f32x4){0.f, 0.f, 0.f, 0.f};
    u32x4 mrg[2][MT][2];
    u32x2 gt[MT][2];
    PG8_LAS u32x4* gtl = (PG8_LAS u32x4*)(lds + GT_OFF) + tid;
    bf16x8 At[MT][2], B0[2][2], B1[2][2];
    int kb = 1024 * 2;
    const char* cA = PG8_SEGA(0) + (size_t)cur.pm * (size_t)(64 * MT) * kb; const char* cB = PG8_SEGW(0) + (size_t)cur.pn * (size_t)BM * kb;
    {   const size_t hA = (size_t)(32 * MT) * kb, hB = (size_t)HALF * kb;
        PG8_STAGE(PG8_SB(0, 0), cB, rB, kb); PG8_STAGE(PG8_SB(0, 1), cB + hB, rB, kb); PG8_STAGE(PG8_SA(0, 0), cA, rA, kb); PG8_STAGE(PG8_SA(0, 1), cA + hA, rA, kb);
        if (wr == 1) PG8_BAR;
        PG8_WAIT_V(2); PG8_BAR;
        PG8_STAGE(PG8_SB(1, 0), cB + kstep, rB, kb); PG8_STAGE(PG8_SA(1, 0), cA + kstep, rA, kb); PG8_STAGE(PG8_SB(1, 1), cB + hB + kstep, rB, kb);
        PG8_WAIT_V(6); PG8_BAR; }
    for (;;) {
        int nseg = seg + 1; bool has_next = true; Unit nu = cur;
        if (nseg == 6) { nseg = 0; has_next = S.next(ti + 1, nxt); nu = nxt; }
        const int nkb = has_next ? PG8_SEGKB(nseg) : kb;
        const char* nA = has_next ? PG8_SEGA(nseg) + (size_t)nu.pm * (size_t)(64 * MT) * nkb : cA; const char* nB = has_next ? PG8_SEGW(nseg) + (size_t)nu.pn * (size_t)BM * nkb : cB;
        const int nt = kb >> 7;
        const size_t hA = (size_t)(32 * MT) * kb, hB = (size_t)HALF * kb;
        for (int t = 0; t < nt; t += 2) {
            const bool last = (t == nt - 2);
            const char* a1 = cA + (size_t)(t + 1) * kstep;
            const char* a2 = last ? nA : cA + (size_t)(t + 2) * kstep; const char* b2 = last ? nB : cB + (size_t)(t + 2) * kstep;
            const char* a3 = a2 + kstep; const char* b3 = b2 + kstep;
            const int kb2 = last ? nkb : kb; const size_t hA2 = (size_t)(32 * MT) * kb2, hB2 = (size_t)HALF * kb2;
            PG8_LDB(B0, 0, 0); PG8_LDB(B1, 0, 1); PG8_SCHED; PG8_LDA(At, 0, 0); PG8_STAGE(PG8_SA(1, 1), a1 + hA, rA, kb);
            PG8_WAIT_V(8); PG8_WAIT_L(0); PG8_BAR; PG8_MMA(0, 0, At, B0); PG8_MMA(0, 1, At, B1); PG8_BAR; PG8_SCHED;
            PG8_LDA(At, 0, 1); PG8_STAGE(PG8_SB(0, 0), b2, rB, kb2); PG8_STAGE(PG8_SB(0, 1), b2 + hB2, rB, kb2); PG8_STAGE(PG8_SA(0, 0), a2, rA, kb2);
            PG8_WAIT_V(8); PG8_WAIT_L(0); PG8_BAR; PG8_MMA(1, 0, At, B0); PG8_MMA(1, 1, At, B1); PG8_BAR; PG8_SCHED;
            PG8_LDB(B0, 1, 0); PG8_LDB(B1, 1, 1); PG8_SCHED; PG8_LDA(At, 1, 0); PG8_STAGE(PG8_SA(0, 1), a2 + hA2, rA, kb2);
            PG8_WAIT_V(8); PG8_WAIT_L(0); PG8_BAR; PG8_MMA(0, 0, At, B0); PG8_MMA(0, 1, At, B1); PG8_BAR; PG8_SCHED;
            PG8_LDA(At, 1, 1); PG8_STAGE(PG8_SB(1, 0), b3, rB, kb2); PG8_STAGE(PG8_SB(1, 1), b3 + hB2, rB, kb2); PG8_STAGE(PG8_SA(1, 0), a3, rA, kb2);
            PG8_WAIT_V(8); PG8_WAIT_L(0); PG8_BAR; PG8_MMA(1, 0, At, B0); PG8_MMA(1, 1, At, B1); PG8_BAR; PG8_SCHED;
        }
        if (wr == 0) PG8_BAR;
        if ((seg & 1) == 0) {
            u32x2 gl[MT][2];
#pragma unroll
            for (int ai = 0; ai < 2; ++ai)
#pragma unroll
                for (int m = 0; m < MT; ++m)
#pragma unroll
                    for (int bj = 0; bj < 2; ++bj) { const f32x4 v0 = acc[ai][bj][m][0], v1 = acc[ai][bj][m][1];
                        unsigned q[8];
#pragma unroll
                        for (int e = 0; e < 4; ++e) { q[e] = (unsigned)(255.f * __builtin_amdgcn_rcpf(1.f + __expf(-v0[e])) + 0.5f); q[4 + e] = (unsigned)(255.f * __builtin_amdgcn_rcpf(1.f + __expf(-v1[e])) + 0.5f); }
                        u32x2 w; w.x = q[0] | (q[1] << 8) | (q[2] << 16) | (q[3] << 24); w.y = q[4] | (q[5] << 8) | (q[6] << 16) | (q[7] << 24);
                        if (ai == 0) gt[m][bj] = w; else gl[m][bj] = w; }
            { u32x4 t; t.x = gl[0][0].x; t.y = gl[0][0].y; t.z = gl[0][1].x; t.w = gl[0][1].y; gtl[0] = t; t.x = gl[1][0].x; t.y = gl[1][0].y; t.z = gl[1][1].x; t.w = gl[1][1].y; gtl[512] = t;
              t.x = gl[2][0].x; t.y = gl[2][0].y; t.z = gl[2][1].x; t.w = gl[2][1].y; gtl[1024] = t; }
        } else {
            int fr_ = fr, fq_ = fq; asm volatile("" : "+v"(fr_), "+v"(fq_));
            const int row0 = cur.pm * (64 * MT) + wr * (16 * MT) + fr_, col0 = cur.pn * BM + wc * 32 + 8 * fq_;
            constexpr float SC = 1.0f / 255.0f;
#pragma unroll
            for (int ai = 0; ai < 2; ++ai)
#pragma unroll
                for (int m = 0; m < MT; ++m) { const int row = row0 + ai * (32 * MT) + m * 16;
                    float rs = SC;
                    if (seg == 5) {
                        const float* sp = ssqh + (size_t)(4 * fq_) * MTOK + row;
                        float s4 = (sp[0] + sp[MTOK]) + (sp[2 * (size_t)MTOK] + sp[3 * (size_t)MTOK]);
                        s4 += __shfl_xor(s4, 16); s4 += __shfl_xor(s4, 32);
                        rs = SC * (1.0f / sqrtf(s4 * (1.0f / 1024.0f) + 1e-6f)); }
#pragma unroll
                    for (int bj = 0; bj < 2; ++bj) { const f32x4 v0 = acc[ai][bj][m][0], v1 = acc[ai][bj][m][1];
                        u32x2 gq; if (ai == 0) gq = gt[m][bj]; else { const u32x4 t = gtl[512 * m]; gq.x = bj ? t.z : t.x; gq.y = bj ? t.w : t.y; }
                        float r[8];
                        r[0] = (float)(gq.x & 255u) * rs * v0[0]; r[1] = (float)((gq.x >> 8) & 255u) * rs * v0[1]; r[2] = (float)((gq.x >> 16) & 255u) * rs * v0[2]; r[3] = (float)(gq.x >> 24) * rs * v0[3];
                        r[4] = (float)(gq.y & 255u) * rs * v1[0]; r[5] = (float)((gq.y >> 8) & 255u) * rs * v1[1]; r[6] = (float)((gq.y >> 16) & 255u) * rs * v1[2]; r[7] = (float)(gq.y >> 24) * rs * v1[3];
                        if (seg != 1) { const u32x4 mq = mrg[ai][m][bj];
                            r[0] += __uint_as_float(mq.x << 16); r[1] += __uint_as_float(mq.x & 0xffff0000u); r[2] += __uint_as_float(mq.y << 16); r[3] += __uint_as_float(mq.y & 0xffff0000u);
                            r[4] += __uint_as_float(mq.z << 16); r[5] += __uint_as_float(mq.z & 0xffff0000u); r[6] += __uint_as_float(mq.w << 16); r[7] += __uint_as_float(mq.w & 0xffff0000u); }
                        u32x4 w; w.x = cvt_pk_bf16_c(r[0], r[1]); w.y = cvt_pk_bf16_c(r[2], r[3]); w.z = cvt_pk_bf16_c(r[4], r[5]); w.w = cvt_pk_bf16_c(r[6], r[7]);
                        mrg[ai][m][bj] = w;
                        if (seg == 5) *(u32x4*)(MG + (size_t)row * 1024 + col0 + bj * HALF) = w; } }
        }
        if (!has_next) break;
#pragma unroll
        for (int a = 0; a < 2; ++a)
#pragma unroll
            for (int b = 0; b < 2; ++b)
#pragma unroll
                for (int m = 0; m < MT; ++m)
#pragma unroll
                    for (int n = 0; n < 2; ++n) acc[a][b][m][n] = (f32x4){0.f, 0.f, 0.f, 0.f};
        if (nseg == 0) { cur = nxt; ++ti; }
        seg = nseg; kb = nkb; cA = nA; cB = nB;
        if (wr == 1) PG8_BAR;
    }
    PG8_WAIT_V(0);
    PG8_BAR;
#undef PG8_SEGA
#undef PG8_SEGW
#undef PG8_SEGKB
#undef PG8_SA
#undef PG8_SB
#undef PG8_STAGE
#undef PG8_LDA
#undef PG8_LDB
#undef PG8_MMA
#undef PG8_WAIT_V
#undef PG8_WAIT_L
#undef PG8_BAR
#undef PG8_SCHED
}
}
using pg8::bf16_t;
__device__ __forceinline__ void phase_mod(const Params& P, LAS unsigned char* lds) {
    const int ZZ = opq0();
    const int tid = threadIdx.x, lane = tid & 63, w = tid >> 6;
    LAS float* sv = (LAS float*)lds;
    LAS float* red = (LAS float*)(lds + 9 * 1024 * 4);
    for (int i = tid; i < 9 * 1024; i += 512) { const int v = i >> 10, k = i & 1023; const float c = v == 0 ? P.in[ZZ + I_CCTX][k] : P.in[ZZ + I_C][(v - 1) * 1024 + k]; sv[i] = silu_f(c); }
    __syncthreads();
    float* MOD = (float*)(P.ws + ZZ + WS_MOD);
    for (int cgp = blockIdx.x; cgp < 192; cgp += gridDim.x) {
        const int col = cgp * 64 + lane, l = col / 6144, j = col % 6144;
        const float* wp = P.in[ZZ + I_WMOD] + (size_t)l * 1024 * 6144 + j;
        float a[9];
#pragma unroll
        for (int v = 0; v < 9; ++v) a[v] = 0.f;
        const int k0 = w * 128;
        for (int kb = k0; kb < k0 + 128; kb += 16) {
            float wv[16];
#pragma unroll
            for (int kk = 0; kk < 16; ++kk) wv[kk] = wp[(size_t)(kb + kk) * 6144];
#pragma unroll
            for (int kk = 0; kk < 16; ++kk)
#pragma unroll
                for (int v = 0; v < 9; ++v) a[v] += sv[v * 1024 + kb + kk] * wv[kk];
        }
#pragma unroll
        for (int v = 0; v < 9; ++v) red[(w * 9 + v) * 64 + lane] = a[v];
        __syncthreads();
        for (int o = tid; o < 9 * 64; o += 512) { const int v = o >> 6, ln = o & 63; float s = 0.f;
#pragma unroll
            for (int ww = 0; ww < 8; ++ww) s += red[(ww * 9 + v) * 64 + ln];
            const int c2 = cgp * 64 + ln, l2 = c2 / 6144, j2 = c2 % 6144;
            MOD[(size_t)(l2 * 9 + v) * 6144 + j2] = s + P.in[ZZ + I_BMOD][l2 * 6144 + j2]; }
        __syncthreads();
    }
}

__device__ __forceinline__ void transpose_item(const float* W, int ldw, int srccol0, bf16_t* WT, int K, int n0, int k0, LAS float* scr, int lane, const float* kscale = nullptr) {
    const int ks = lane >> 3, c4 = lane & 7;
    f32x4 v[8];
    if (srccol0 >= 0) {
#pragma unroll
        for (int i = 0; i < 8; ++i) { v[i] = *(const f32x4*)(W + (size_t)(k0 + 8 * i + ks) * ldw + srccol0 + 4 * c4); if (kscale) v[i] = v[i] * kscale[k0 + 8 * i + ks]; }
    } else {
#pragma unroll
        for (int i = 0; i < 8; ++i) v[i] = (f32x4){0.f, 0.f, 0.f, 0.f};
    }
#pragma unroll
    for (int i = 0; i < 8; ++i) { LAS float* d = scr + (8 * i + ks) * 33 + 4 * c4; d[0] = v[i][0]; d[1] = v[i][1]; d[2] = v[i][2]; d[3] = v[i][3]; }
    LDS_WAIT(); asm volatile("" ::: "memory");
    const int c = lane & 7;
#pragma unroll
    for (int j = 0; j < 4; ++j) { const int n = (lane >> 3) + 8 * j; const LAS float* s = scr + (8 * c) * 33 + n;
        u32x4 o; o.x = cvt_pk_bf16(s[0 * 33], s[1 * 33]); o.y = cvt_pk_bf16(s[2 * 33], s[3 * 33]); o.z = cvt_pk_bf16(s[4 * 33], s[5 * 33]); o.w = cvt_pk_bf16(s[6 * 33], s[7 * 33]);
        *(u32x4*)(WT + (size_t)(n0 + n) * K + k0 + 8 * c) = o; }
    LDS_WAIT(); asm volatile("" ::: "memory");
}
__device__ __forceinline__ void titem_load(const float* W, int ldw, int srccol0, int k0, const float* kscale, f32x4 (&v)[8], float (&sc)[8], int lane) {
    const int ks = lane >> 3, c4 = lane & 7;
#pragma unroll
    for (int i = 0; i < 8; ++i) { v[i] = (f32x4){0.f, 0.f, 0.f, 0.f}; sc[i] = 1.0f;
        if (srccol0 >= 0) { v[i] = *(const f32x4*)(W + (size_t)(k0 + 8 * i + ks) * ldw + srccol0 + 4 * c4); if (kscale) sc[i] = kscale[k0 + 8 * i + ks]; } }
}
__device__ __forceinline__ void titem_store(bf16_t* WT, int K, int n0, int k0, const f32x4 (&v)[8], const float (&sc)[8], LAS float* scr, int lane) {
    const int ks = lane >> 3, c4 = lane & 7;
#pragma unroll
    for (int i = 0; i < 8; ++i) { LAS float* d = scr + (8 * i + ks) * 33 + 4 * c4; d[0] = v[i][0] * sc[i]; d[1] = v[i][1] * sc[i]; d[2] = v[i][2] * sc[i]; d[3] = v[i][3] * sc[i]; }
    LDS_WAIT(); asm volatile("" ::: "memory");
    const int c = lane & 7;
#pragma unroll
    for (int j = 0; j < 4; ++j) { const int n = (lane >> 3) + 8 * j; const LAS float* s = scr + (8 * c) * 33 + n;
        u32x4 o; o.x = cvt_pk_bf16(s[0 * 33], s[1 * 33]); o.y = cvt_pk_bf16(s[2 * 33], s[3 * 33]); o.z = cvt_pk_bf16(s[4 * 33], s[5 * 33]); o.w = cvt_pk_bf16(s[6 * 33], s[7 * 33]);
        *(u32x4*)(WT + (size_t)(n0 + n) * K + k0 + 8 * c) = o; }
    LDS_WAIT(); asm volatile("" ::: "memory");
}
__device__ __forceinline__ int win_srccol(int n0) { return n0 < 3872 ? n0 : -1; }
template <int NR, bool XBF>
__device__ __forceinline__ void norm_mod_rows(const void* const (&xr)[NR], const float* g, const float* const (&md)[NR], int sh_off, int sc_off, bf16_t* const (&orow)[NR], int lane) {
    f32x4 v[XBF ? 1 : NR][4]; u32x2 q[XBF ? NR : 1][4]; float s[NR];
#define NM_X(r, j) (XBF ? (f32x4){bf_lo(q[XBF ? (r) : 0][j].x), bf_hi(q[XBF ? (r) : 0][j].x), bf_lo(q[XBF ? (r) : 0][j].y), bf_hi(q[XBF ? (r) : 0][j].y)} : v[XBF ? 0 : (r)][j])
#pragma unroll
    for (int r = 0; r < NR; ++r)
#pragma unroll
        for (int j = 0; j < 4; ++j) { if (XBF) q[XBF ? r : 0][j] = ((const u32x2*)xr[r])[lane + 64 * j]; else v[XBF ? 0 : r][j] = ((const f32x4*)xr[r])[lane + 64 * j]; }
#pragma unroll
    for (int r = 0; r < NR; ++r) { s[r] = 0.f;
#pragma unroll
        for (int j = 0; j < 4; ++j) { const f32x4 x = NM_X(r, j); s[r] += (x[0] * x[0] + x[1] * x[1]) + (x[2] * x[2] + x[3] * x[3]); } }
#pragma unroll
    for (int o = 1; o < 64; o <<= 1)
#pragma unroll
        for (int r = 0; r < NR; ++r) s[r] += __shfl_xor(s[r], o);
#pragma unroll
    for (int j = 0; j < 4; ++j) { const f32x4 gg = ((const f32x4*)g)[lane + 64 * j];
#pragma unroll
        for (int r = 0; r < NR; ++r) { const float rs = 1.0f / sqrtf(s[r] * (1.0f / 1024.0f) + 1e-6f);
            const f32x4 a1 = ((const f32x4*)(md[r] + sc_off))[lane + 64 * j], a0 = ((const f32x4*)(md[r] + sh_off))[lane + 64 * j];
            const f32x4 x = NM_X(r, j);
            const f32x4 y = (x * rs * gg) * (a1 + 1.0f) + a0;
            ((unsigned long long*)orow[r])[lane + 64 * j] = (unsigned long long)cvt_pk_bf16(y[0], y[1]) | ((unsigned long long)cvt_pk_bf16(y[2], y[3]) << 32); } }
#undef NM_X
}
__device__ __forceinline__ void norm_rows_x(const Params& P, int ZZ, const float* g, const float* MOD, int sh_off, int sc_off, int gw, int NGW, int lane) {
    const bf16_t* X = (const bf16_t*)(P.ws + ZZ + WS_X); bf16_t* H = (bf16_t*)(P.out + ZZ);
    gw = __builtin_amdgcn_readfirstlane(gw);
    for (int m = 6 * gw; m < MTOK; m += 6 * NGW) {
        const void* xr[6]; const float* md[6]; bf16_t* orow[6];
#pragma unroll
        for (int r = 0; r < 6; ++r) { xr[r] = X + (size_t)(m + r) * 1024; md[r] = MOD + (size_t)mod_index(m + r) * 6144; orow[r] = H + (size_t)(m + r) * 1024; }
        norm_mod_rows<6, true>(xr, g, md, sh_off, sc_off, orow, lane);
    }
}
__device__ __forceinline__ void h1_rows2(const Params& P, int l, int gw, int NGW, int lane) {
    const int ZZ = opq0();
    const float* MOD = (const float*)(P.ws + ZZ + WS_MOD) + (size_t)l * 9 * 6144;
    if (l != 0) { norm_rows_x(P, ZZ, P.in[ZZ + I_N1G] + l * 1024, MOD, 0, 1024, gw, NGW, lane); return; }
    bf16_t* H = (bf16_t*)(P.out + ZZ);
    for (int m = 4 * gw; m < MTOK; m += 4 * NGW) {
        const void* xr[4]; const float* md[4]; bf16_t* orow[4];
#pragma unroll
        for (int r = 0; r < 4; ++r) { xr[r] = xrow_ptr0(P, ZZ, m + r); md[r] = MOD + (size_t)mod_index(m + r) * 6144; orow[r] = H + (size_t)(m + r) * 1024; }
        norm_mod_rows<4, false>(xr, P.in[ZZ + I_N1G] + l * 1024, md, 0, 1024, orow, lane);
    }
}
__device__ __forceinline__ void phase_p0(const Params& P, int l, LAS unsigned char* lds) {
    const int ZZ = opq0();
    const int tid = threadIdx.x, lane = tid & 63, w = tid >> 6;
    LAS float* scr = (LAS float*)(lds + w * 8704);
    const int gw = blockIdx.x * 8 + w, NGW = gridDim.x * 8;
    constexpr int I0 = 2048, I1 = I0 + 1536, I2 = I1 + 256, I3 = I2 + 512, I4 = I3 + 512, I5 = I4 + 2048, I6 = I5 + 2048;
    unsigned char* ws = P.ws + ZZ;
    const float* const pWIN = P.in[ZZ + I_WIN] + (size_t)l * 1024 * INC; const float* const pWAO = P.in[ZZ + I_WAO] + (size_t)l * 512 * 1024; const float* const pWSO = P.in[ZZ + I_WSO] + (size_t)l * 1024 * 1024;
    const float* const pWOUT = P.in[ZZ + I_WOUT] + (size_t)l * 1024 * 1024; const float* const pWM1 = P.in[ZZ + I_WM1] + (size_t)l * 1024 * 4096; const float* const pWM2 = P.in[ZZ + I_WM2] + (size_t)l * 4096 * 1024;
    const float* const pSSDG = P.in[ZZ + I_SSDG] + l * 1024;
#define P0_ITEM(IT, W_, LD_, SC_, K0_, KS_, WT_, KK_, N0_) do { const int it_ = (IT); KS_ = nullptr; \
        if (it_ < I0) { const int kb = it_ / 128, nb = it_ % 128; W_ = pWIN; LD_ = INC; SC_ = win_srccol(nb * 32); WT_ = (bf16_t*)(ws + WS_WIN); KK_ = 1024; N0_ = nb * 32; K0_ = kb * 64; } \
        else if (it_ < I1) { const int r = it_ - I0, kb = r / 96, nb = r % 96; W_ = pWIN; LD_ = INC; SC_ = 3872 + nb * 32; WT_ = (bf16_t*)(ws + WS_WG); KK_ = 1024; N0_ = nb * 32; K0_ = kb * 64; } \
        else if (it_ < I2) { const int r = it_ - I1, kb = r / 32, nb = r % 32; W_ = pWAO; LD_ = 1024; SC_ = nb * 32; WT_ = (bf16_t*)(ws + WS_WATT); KK_ = 512; N0_ = nb * 32; K0_ = kb * 64; } \
        else if (it_ < I3) { const int r = it_ - I2, kb = r / 32, nb = r % 32; W_ = pWSO; LD_ = 1024; SC_ = nb * 32; WT_ = (bf16_t*)(ws + WS_WSSD); KK_ = 1024; N0_ = nb * 32; K0_ = kb * 64; \
            KS_ = pSSDG; }     \
        else if (it_ < I4) { const int r = it_ - I3, kb = r / 32, nb = r % 32; W_ = pWOUT; LD_ = 1024; SC_ = nb * 32; WT_ = (bf16_t*)(ws + WS_WOUT); KK_ = 1024; N0_ = nb * 32; K0_ = kb * 64; } \
        else if (it_ < I5) { const int r = it_ - I4, kb = r / 128, nb = r % 128; W_ = pWM1; LD_ = 4096; SC_ = nb * 32; WT_ = (bf16_t*)(ws + WS_WM1); KK_ = 1024; N0_ = nb * 32; K0_ = kb * 64; } \
        else { const int r = it_ - I5, kb = r / 32, nb = r % 32; W_ = pWM2; LD_ = 1024; SC_ = nb * 32; WT_ = (bf16_t*)(ws + WS_WM2); KK_ = 4096; N0_ = nb * 32; K0_ = kb * 64; } } while (0)
    {
        f32x4 va[8], vb[8]; float sa[8], sb[8];
        const float *cW, *cKS; int cLD, cSC, cK0, cKK, cN0; bf16_t* cWT;
        int it = __builtin_amdgcn_readfirstlane(gw);
        P0_ITEM(it < I6 ? it : 0, cW, cLD, cSC, cK0, cKS, cWT, cKK, cN0);
        if (it < I6) titem_load(cW, cLD, cSC, cK0, cKS, va, sa, lane);
        for (; it < I6; it += NGW) {
            const int nx = it + NGW;
            const float *nW, *nKS; int nLD, nSC, nK0, nKK, nN0; bf16_t* nWT;
            P0_ITEM(nx < I6 ? nx : it, nW, nLD, nSC, nK0, nKS, nWT, nKK, nN0);
            if (nx < I6) titem_load(nW, nLD, nSC, nK0, nKS, vb, sb, lane);
            titem_store(cWT, cKK, cN0, cK0, va, sa, scr, lane);
#pragma unroll
            for (int i = 0; i < 8; ++i) { va[i] = vb[i]; sa[i] = sb[i]; }
            cWT = nWT; cKK = nKK; cN0 = nN0; cK0 = nK0;
        }
    }
#undef P0_ITEM
    for (int tk = gw; tk < 2048; tk += NGW) {
        const int c0 = (tk >> 4) * 4, n = (tk & 15) * 64 + lane, g = c0 >> 7, cc0 = c0 & 127;
        const float* wo = P.in[ZZ + I_WPO] + (size_t)l * 512 * 1024 + (size_t)(g * 128) * 1024 + n;
        const float* sc = P.in[ZZ + I_POOLS] + l * 512 + g * 128;
        const float* pw = P.in[ZZ + I_POOLW] + ((size_t)(l * 4 + g) * 128 + cc0) * 128;
#pragma unroll
        for (int i = 0; i < 2; ++i) { const int e = (lane + 64 * i) * 4, d = e & 127; const f32x4 a = *(const f32x4*)(pw + e), b = *(const f32x4*)(sc + d);
            *(LAS f32x4*)(scr + e) = a * b; }
        LDS_WAIT(); asm volatile("" ::: "memory");
        float a[4];
#pragma unroll
        for (int j = 0; j < 4; ++j) a[j] = 0.f;
        for (int d0 = 0; d0 < 128; d0 += 32) {
            float wv[32];
#pragma unroll
            for (int dd = 0; dd < 32; ++dd) wv[dd] = wo[(size_t)(d0 + dd) * 1024];
#pragma unroll
            for (int dd = 0; dd < 32; dd += 4)
#pragma unroll
                for (int j = 0; j < 4; ++j) { const f32x4 p4 = *(const LAS f32x4*)(scr + j * 128 + d0 + dd); a[j] += p4[0] * wv[dd] + p4[1] * wv[dd + 1] + p4[2] * wv[dd + 2] + p4[3] * wv[dd + 3]; }
        }
        u32x2 o; o.x = cvt_pk_bf16(a[0], a[1]); o.y = cvt_pk_bf16(a[2], a[3]);
        *(u32x2*)((bf16_t*)(ws + WS_WPOOL) + (size_t)n * 512 + c0) = o;
        LDS_WAIT(); asm volatile("" ::: "memory");
    }
    for (int tk = gw; tk < 2048; tk += NGW) {
        const int which = tk >> 10, idx = (tk & 1023) * 512 + lane * 8, b = idx >> 16, rem = idx & 65535;
        const float* src = P.in[ZZ + which ? I_CV : I_CK] + (size_t)(b * 2 + l) * 65536 + rem;
        const f32x4 a = *(const f32x4*)src, c = *(const f32x4*)(src + 4);
        u32x4 o; o.x = cvt_pk_bf16(a[0], a[1]); o.y = cvt_pk_bf16(a[2], a[3]); o.z = cvt_pk_bf16(c[0], c[1]); o.w = cvt_pk_bf16(c[2], c[3]);
        *(u32x4*)((bf16_t*)(ws + (which ? WS_CV : WS_CK)) + idx) = o;
    }
    h1_rows2(P, l, gw, NGW, lane);
}

__device__ __forceinline__ float rope_inv(int i) { return exp2f(-(float)i * 0.83048202372184058696f); }
__device__ __forceinline__ float fast_rcp(float x) { return __builtin_amdgcn_rcpf(x); }
__device__ __forceinline__ void qk_norm_8(float (&v)[8], const float (&gn)[8]) {
    float ss = 0.f;
#pragma unroll
    for (int e = 0; e < 8; ++e) ss += v[e] * v[e];
    ss += __shfl_xor(ss, 1); ss += __shfl_xor(ss, 2); ss += __shfl_xor(ss, 4);
    const float rstd = 1.0f / sqrtf(ss * (1.0f / 64.0f) + 1e-6f);
#pragma unroll
    for (int e = 0; e < 8; ++e) v[e] = v[e] * rstd * gn[e];
}
__device__ __forceinline__ void rope_8(float (&v)[8], const float (&cs)[8], const float (&sn)[8], int ch) {
#pragma unroll
    for (int e = 0; e < 8; ++e) { const float own = v[e], oth = __shfl_xor(own, 2); v[e] = (ch & 2) == 0 ? own * cs[e] - oth * sn[e] : oth * sn[e] + own * cs[e]; }
}
__device__ __forceinline__ void qk_prep(const Params& P, int l) {
    const int ZZ = opq0();
    const int tid = threadIdx.x, lane = tid & 63, w = tid >> 6;
    const int gw = blockIdx.x * 8 + w, NGW = gridDim.x * 8;
    bf16_t* Qb = (bf16_t*)(P.ws + ZZ + WS_Q);
    bf16_t* KVb = (bf16_t*)(P.ws + ZZ + WS_KV);
    const float* qg = P.in[ZZ + I_QG] + l * 64;
    const float* kg = P.in[ZZ + I_KG] + l * 64;
    float* ock = P.out + ZZ + OUT_CK;
    const int ch = lane & 7;
    float qgn[8], kgn[8], finv[8];
#pragma unroll
    for (int e = 0; e < 8; ++e) { qgn[e] = qg[8 * ch + e]; kgn[e] = kg[8 * ch + e]; finv[e] = rope_inv(8 * (ch & 1) + e); }
    for (int m0 = 2 * gw; m0 < MTOK; m0 += 2 * NGW) {
        u32x4 qr[2], kr[2];
#pragma unroll
        for (int r = 0; r < 2; ++r) { qr[r] = *((const u32x4*)(Qb + (size_t)(m0 + r) * 512) + lane); kr[r] = *((const u32x4*)(KVb + (size_t)(m0 + r) * 256) + (lane & 15)); }
#pragma unroll
        for (int r = 0; r < 2; ++r) {
            const int m = m0 + r;
            const bool lat = m >= MCTX; const int t = (m - MCTX) & 2047;
            float cs[8], sn[8];
            if (lat) { const float pos = (float)((ch >> 2) == 0 ? (t >> 6) : (t & 63));
#pragma unroll
                for (int e = 0; e < 8; ++e) { const float ang = pos * finv[e]; cs[e] = __cosf(ang); sn[e] = __sinf(ang); } }
            float v[8] = {bf_lo(qr[r].x), bf_hi(qr[r].x), bf_lo(qr[r].y), bf_hi(qr[r].y), bf_lo(qr[r].z), bf_hi(qr[r].z), bf_lo(qr[r].w), bf_hi(qr[r].w)};
            qk_norm_8(v, qgn);
            if (lat) rope_8(v, cs, sn, ch);
            constexpr float QS = 0.125f * 1.4426950408889634f;
            u32x4 o; o.x = cvt_pk_bf16(v[0] * QS, v[1] * QS); o.y = cvt_pk_bf16(v[2] * QS, v[3] * QS); o.z = cvt_pk_bf16(v[4] * QS, v[5] * QS); o.w = cvt_pk_bf16(v[6] * QS, v[7] * QS);
            *((u32x4*)(Qb + (size_t)m * 512) + lane) = o;
            float k[8] = {bf_lo(kr[r].x), bf_hi(kr[r].x), bf_lo(kr[r].y), bf_hi(kr[r].y), bf_lo(kr[r].z), bf_hi(kr[r].z), bf_lo(kr[r].w), bf_hi(kr[r].w)};
            qk_norm_8(k, kgn);
            if (!lat && lane < 16) { float* ok = ock + ((size_t)((m >> 8) * 2 + l) * 256 + (m & 255)) * 128 + lane * 8;
                *(f32x4*)ok = (f32x4){k[0], k[1], k[2], k[3]}; *(f32x4*)(ok + 4) = (f32x4){k[4], k[5], k[6], k[7]}; }
            if (lat) rope_8(k, cs, sn, ch);
            if (lane < 16) { u32x4 ko; ko.x = cvt_pk_bf16(k[0], k[1]); ko.y = cvt_pk_bf16(k[2], k[3]); ko.z = cvt_pk_bf16(k[4], k[5]); ko.w = cvt_pk_bf16(k[6], k[7]); *((u32x4*)(KVb + (size_t)m * 256) + lane) = ko; }
        }
    }
}
constexpr int ATT_UNITS = 768;
__device__ __forceinline__ void attn_unit(const Params& P, int l, LAS unsigned char* lds, int unit, size_t out_off) {
    const int ZZ = opq0();
    const int tid = threadIdx.x, lane = tid & 63, w = tid >> 6, g = lane >> 4, li = lane & 15;
    const bf16_t* Qb = (const bf16_t*)(P.ws + ZZ + WS_Q);
    const bf16_t* KVb = (const bf16_t*)(P.ws + ZZ + WS_KV);
    const bf16_t* CKb = (const bf16_t*)(P.ws + ZZ + WS_CK);
    const bf16_t* CVb = (const bf16_t*)(P.ws + ZZ + WS_CV);
    int lat, b, hp, qb;
    if (unit < 512) { lat = 1; b = unit >> 6; hp = (unit >> 4) & 3; qb = unit & 15; }
    else { const int u2 = unit - 512; lat = 0; b = u2 >> 3; hp = (u2 >> 1) & 3; qb = u2 & 1; }
    const int h0 = 2 * hp, kvh = hp >> 1;
    const int row0 = lat ? MCTX + b * LLAT + qb * 128 : b * LCTX + qb * 128;
    const int qrow = row0 + 16 * w + li;
    const int qpos = qb * 128 + 16 * w + li;
    bf16x8 bq[2][2];
    float m_run[2], l_run[2];
    f32x4 o[2][4];
#pragma unroll
    for (int hh = 0; hh < 2; ++hh) {
        bq[hh][0] = *(const bf16x8*)(Qb + (size_t)qrow * 512 + (h0 + hh) * 64 + 8 * g);
        bq[hh][1] = *(const bf16x8*)(Qb + (size_t)qrow * 512 + (h0 + hh) * 64 + 32 + 8 * g);
        m_run[hh] = P.in[ZZ + I_SINK][l * 8 + h0 + hh] * 1.4426950408889634f;
        l_run[hh] = (g == 0) ? 1.f : 0.f;
#pragma unroll
        for (int i = 0; i < 4; ++i) o[hh][i] = (f32x4){0.f, 0.f, 0.f, 0.f}; }
    const int t_lo = 0, t_hi = lat ? 14 : 4;
    const int kt2 = tid - 256, dp = tid & 31, kb = (tid >> 5) & 7;
    u32x4 pk0, pk1; unsigned pv[8];
#define ATT_TILE_PTRS(T, KP, VP, STRIDE, KPOS0, MASKED, VALID) do { VALID = true; MASKED = false; KPOS0 = 0; \
        if (!lat) { KP = KVb + (size_t)(b * LCTX + 64 * (T)) * 256 + kvh * 64; VP = KP + 128; STRIDE = 256; } \
        else if ((T) < 8) { KP = CKb + (size_t)(b * PAST + 64 * (T)) * 128 + kvh * 64; VP = CVb + (size_t)(b * PAST + 64 * (T)) * 128 + kvh * 64; STRIDE = 128; } \
        else { const int blk_ = qb - 1 + (((T) - 8) >> 1); VALID = !(blk_ < 0 || blk_ > 15); KPOS0 = blk_ * 128 + (((T) - 8) & 1) * 64; \
            KP = KVb + (size_t)(MCTX + b * LLAT + (VALID ? KPOS0 : 0)) * 256 + kvh * 64; VP = KP + 128; STRIDE = 256; MASKED = true; } } while (0)
#define ATT_PREFETCH(T) do { const bf16_t *kp_, *vp_; int st_, k0_; bool mk_, ok_; ATT_TILE_PTRS(T, kp_, vp_, st_, k0_, mk_, ok_); \
        if (ok_) { if (tid >= 256) { pk0 = *(const u32x4*)(kp_ + (size_t)(kt2 >> 3) * st_ + (kt2 & 7) * 8); pk1 = *(const u32x4*)(kp_ + (size_t)((kt2 + 256) >> 3) * st_ + (kt2 & 7) * 8); } \
            else { _Pragma("unroll") for (int j = 0; j < 8; ++j) pv[j] = *(const unsigned*)(vp_ + (size_t)(8 * kb + j) * st_ + 2 * dp); } } } while (0)
    ATT_PREFETCH(t_lo);
    for (int t = t_lo; t < t_hi; ++t) {
        const bf16_t *kp, *vp; int stride, kpos0; bool masked, valid;
        ATT_TILE_PTRS(t, kp, vp, stride, kpos0, masked, valid);
        if (!valid) { if (t + 1 < t_hi) ATT_PREFETCH(t + 1); continue; }
        LDS_BARRIER();
        if (tid >= 256) {
            { const int key = kt2 >> 3, ch = kt2 & 7; *(LAS u32x4*)(lds + key * 128 + ((ch ^ (key & 7)) << 4)) = pk0; }
            { const int key = (kt2 + 256) >> 3, ch = kt2 & 7; *(LAS u32x4*)(lds + key * 128 + ((ch ^ (key & 7)) << 4)) = pk1; }
        } else {
            u32x4 lo, hi;
            lo.x = (pv[0] & 0xffffu) | (pv[1] << 16); lo.y = (pv[2] & 0xffffu) | (pv[3] << 16); lo.z = (pv[4] & 0xffffu) | (pv[5] << 16); lo.w = (pv[6] & 0xffffu) | (pv[7] << 16);
            hi.x = (pv[0] >> 16) | (pv[1] & 0xffff0000u); hi.y = (pv[2] >> 16) | (pv[3] & 0xffff0000u); hi.z = (pv[4] >> 16) | (pv[5] & 0xffff0000u); hi.w = (pv[6] >> 16) | (pv[7] & 0xffff0000u);
            const int d0 = 2 * dp, d1 = d0 + 1;
            *(LAS u32x4*)(lds + 8192 + d0 * 128 + ((kb ^ (d0 & 7)) << 4)) = lo;
            *(LAS u32x4*)(lds + 8192 + d1 * 128 + ((kb ^ (d1 & 7)) << 4)) = hi;
        }
        if (t + 1 < t_hi) ATT_PREFETCH(t + 1);
        LDS_BARRIER();
        if (masked) { const int q0w = qb * 128 + 16 * w;
            if (kpos0 + 63 < q0w - 128 || kpos0 > q0w + 15 + 128) continue; }
        bf16x8 bp[2][2];
        {
            bf16x8 ka[4][2];
#pragma unroll
            for (int mt = 0; mt < 4; ++mt) { const int key = 16 * mt + li;
#pragma unroll
                for (int ks = 0; ks < 2; ++ks) { const int ch = 4 * ks + g; ka[mt][ks] = *(const LAS bf16x8*)(lds + key * 128 + ((ch ^ (key & 7)) << 4)); } }
#pragma unroll
            for (int hh = 0; hh < 2; ++hh) {
                f32x4 s[4];
#pragma unroll
                for (int mt = 0; mt < 4; ++mt) { s[mt] = (f32x4){0.f, 0.f, 0.f, 0.f};
#pragma unroll
                    for (int ks = 0; ks < 2; ++ks) s[mt] = __builtin_amdgcn_mfma_f32_16x16x32_bf16(ka[mt][ks], bq[hh][ks], s[mt], 0, 0, 0); }
                if (masked) {
#pragma unroll
                    for (int mt = 0; mt < 4; ++mt)
#pragma unroll
                        for (int r = 0; r < 4; ++r) { const int kpos = kpos0 + 16 * mt + 4 * g + r; const int df = qpos - kpos; if (df > 128 || df < -128) s[mt][r] = -INFINITY; }
                }
                float mx = -INFINITY;
#pragma unroll
                for (int mt = 0; mt < 4; ++mt) mx = fmaxf(mx, fmaxf(fmaxf(s[mt][0], s[mt][1]), fmaxf(s[mt][2], s[mt][3])));
                mx = fmaxf(mx, __shfl_xor(mx, 16)); mx = fmaxf(mx, __shfl_xor(mx, 32));
                const float m_new = fmaxf(m_run[hh], mx);
                if (!__all(mx <= m_run[hh])) {
                    const float alpha = __builtin_amdgcn_exp2f(m_run[hh] - m_new); l_run[hh] *= alpha;
#pragma unroll
                    for (int i = 0; i < 4; ++i) o[hh][i] = o[hh][i] * alpha;
                }
                m_run[hh] = m_new;
                float ps = 0.f;
#pragma unroll
                for (int mt = 0; mt < 4; ++mt)
#pragma unroll
                    for (int r = 0; r < 4; ++r) { s[mt][r] = __builtin_amdgcn_exp2f(s[mt][r] - m_new); ps += s[mt][r]; }
                l_run[hh] += ps;
#pragma unroll
                for (int s2 = 0; s2 < 2; ++s2) { u32x4 pk; pk.x = cvt_pk_bf16(s[2 * s2][0], s[2 * s2][1]); pk.y = cvt_pk_bf16(s[2 * s2][2], s[2 * s2][3]);
                    pk.z = cvt_pk_bf16(s[2 * s2 + 1][0], s[2 * s2 + 1][1]); pk.w = cvt_pk_bf16(s[2 * s2 + 1][2], s[2 * s2 + 1][3]); bp[hh][s2] = __builtin_bit_cast(bf16x8, pk); }
            }
        }
#pragma unroll
        for (int dt = 0; dt < 4; ++dt) { const int d = 16 * dt + li;
#pragma unroll
            for (int s2 = 0; s2 < 2; ++s2) {
                const u32x2 lo8 = *(const LAS u32x2*)(lds + 8192 + d * 128 + (((4 * s2 + (g >> 1)) ^ (d & 7)) << 4) + 8 * (g & 1));
                const u32x2 hi8 = *(const LAS u32x2*)(lds + 8192 + d * 128 + (((4 * s2 + 2 + (g >> 1)) ^ (d & 7)) << 4) + 8 * (g & 1));
                u32x4 av; av.x = lo8.x; av.y = lo8.y; av.z = hi8.x; av.w = hi8.y;
#pragma unroll
                for (int hh = 0; hh < 2; ++hh) o[hh][dt] = __builtin_amdgcn_mfma_f32_16x16x32_bf16(__builtin_bit_cast(bf16x8, av), bp[hh][s2], o[hh][dt], 0, 0, 0); } }
    }
#undef ATT_PREFETCH
#undef ATT_TILE_PTRS
#pragma unroll
    for (int hh = 0; hh < 2; ++hh) {
        float lr = l_run[hh]; lr += __shfl_xor(lr, 16); lr += __shfl_xor(lr, 32);
        const float inv = 1.0f / lr;
#pragma unroll
        for (int dt = 0; dt < 4; ++dt) { const f32x4 x = o[hh][dt] * inv; u32x2 wv; wv.x = cvt_pk_bf16(x[0], x[1]); wv.y = cvt_pk_bf16(x[2], x[3]);
            *(u32x2*)((bf16_t*)(P.ws + ZZ + out_off) + (size_t)qrow * 512 + (h0 + hh) * 64 + 16 * dt + 4 * g) = wv; } }
}
__device__ __forceinline__ void bc_conv(const Params& P, int l) {
    const int ZZ = opq0();
    const bf16_t* X = (const bf16_t*)(P.ws + ZZ + WS_BCR);
    bf16_t* BC = (bf16_t*)(P.ws + ZZ + WS_BC);
    const int nthr = gridDim.x * 512, t0 = blockIdx.x * 512 + threadIdx.x;
    const int c = 8 * (t0 & 63);
    const float* cw = P.in[ZZ + I_CONVW] + (size_t)l * 5 * 1536 + 1024 + c;
    const float* cb = P.in[ZZ + I_CONVB] + (size_t)l * 1536 + 1024 + c;
    float wt[5][8], bs[8];
#pragma unroll
    for (int j = 0; j < 5; ++j) { const f32x4 a0 = *(const f32x4*)(cw + j * 1536), a1 = *(const f32x4*)(cw + j * 1536 + 4);
#pragma unroll
        for (int e = 0; e < 4; ++e) { wt[j][e] = a0[e]; wt[j][4 + e] = a1[e]; } }
    { const f32x4 a0 = *(const f32x4*)cb, a1 = *(const f32x4*)(cb + 4);
#pragma unroll
      for (int e = 0; e < 4; ++e) { bs[e] = a0[e]; bs[4 + e] = a1[e]; } }
    const int grp = (c >> 7) & 1, dcol = (c >> 8) * 128 + (c & 127);
    for (int task = t0; task < (MTOK / 4) * 64; task += nthr) {
        const int row = (task >> 6) * 4;
        int t, L; if (row < MCTX) { t = row & 255; L = LCTX; } else { t = (row - MCTX) & 2047; L = LLAT; }
        u32x4 raw[8];
#pragma unroll
        for (int i = 0; i < 8; ++i) { const int tt = t - 2 + i; u32x4 u = (u32x4){0u, 0u, 0u, 0u}; if (tt >= 0 && tt < L) u = *(const u32x4*)(X + (size_t)(row - 2 + i) * 512 + c); raw[i] = u; }
#pragma unroll
        for (int i = 0; i < 4; ++i) { float a[8];
#pragma unroll
            for (int e = 0; e < 8; ++e) a[e] = bs[e];
#pragma unroll
            for (int j = 0; j < 5; ++j) { const u32x4 u = raw[i + j];
                a[0] += wt[j][0] * bf_lo(u.x); a[1] += wt[j][1] * bf_hi(u.x); a[2] += wt[j][2] * bf_lo(u.y); a[3] += wt[j][3] * bf_hi(u.y);
                a[4] += wt[j][4] * bf_lo(u.z); a[5] += wt[j][5] * bf_hi(u.z); a[6] += wt[j][6] * bf_lo(u.w); a[7] += wt[j][7] * bf_hi(u.w); }
            u32x4 o; o.x = cvt_pk_bf16(silu_f(a[0]), silu_f(a[1])); o.y = cvt_pk_bf16(silu_f(a[2]), silu_f(a[3])); o.z = cvt_pk_bf16(silu_f(a[4]), silu_f(a[5])); o.w = cvt_pk_bf16(silu_f(a[6]), silu_f(a[7]));
            *(u32x4*)(BC + ((size_t)grp * MTOK + row + i) * 256 + dcol) = o; }
    }
}
__device__ __forceinline__ void phase_attn(const Params& P, int l, LAS unsigned char* lds, size_t out_off, int first, int stride, int nunits) {
    for (int u = first; u < nunits; u += stride) attn_unit(P, l, lds, u, out_off);
}

__device__ __forceinline__ void ssd_unit(const Params& P, int l, LAS unsigned char* lds, int lat, int b, int h, int dir) {
    const int ZZ = opq0();
    const int tid = threadIdx.x, p = tid >> 3, ns = tid & 7;
    const int L = lat ? LLAT : LCTX, row0 = lat ? MCTX + b * LLAT : b * LCTX, grp = h >> 3;
    const float A = -__expf(P.in[ZZ + I_ALOG][l * 32 + dir * 16 + h]);
    const float Dsk = P.in[ZZ + I_DSKIP][l * 16 + h];
    const float dtbias = P.in[ZZ + I_DTB][l * 32 + dir * 16 + h];
    const bf16_t* X = (const bf16_t*)(P.ws + ZZ + WS_XBC);
    const bf16_t* BC = (const bf16_t*)(P.ws + ZZ + WS_BC);
    const float* DT = (const float*)(P.ws + ZZ + WS_DT);
    bf16_t* Y = (bf16_t*)((unsigned char*)(P.out + ZZ) + OUTB_Y);
    bf16_t* Z = (bf16_t*)(P.ws + ZZ + WS_Z);
    LAS float* xs = (LAS float*)lds;
    LAS float* Bs = (LAS float*)(lds + 16384);
    LAS float* Cs = (LAS float*)(lds + 49152);
    LAS float* yb = (LAS float*)(lds + 81920);
    LAS float* dts = (LAS float*)(lds + 98304);
    LAS float* das = (LAS float*)(lds + 98304 + 256);
    float S[16];
    if (lat) { const float* sp = P.in[ZZ + I_ST] + ((size_t)((((b * 2 + l) * 2 + dir) * 16 + h) * 64 + p)) * 128 + ns * 16;
#pragma unroll
        for (int i = 0; i < 4; ++i) { const f32x4 v = *(const f32x4*)(sp + 4 * i); S[4 * i] = v[0]; S[4 * i + 1] = v[1]; S[4 * i + 2] = v[2]; S[4 * i + 3] = v[3]; } }
    else {
#pragma unroll
        for (int i = 0; i < 16; ++i) S[i] = 0.f; }
    const float* cw = P.in[ZZ + I_CONVW] + (size_t)l * 5 * 1536 + h * 64;
    const float* cb = P.in[ZZ + I_CONVB] + (size_t)l * 1536 + h * 64;
    const int nck = L / 64;
    for (int ck = 0; ck < nck; ++ck) {
        const int t0 = dir == 0 ? ck * 64 : L - 64 - ck * 64;
        __syncthreads();
        {
            const int tt = tid >> 3, c0 = (tid & 7) * 16; const bf16_t* src = BC + (size_t)(row0 + t0 + tt) * 512 + grp * 128 + c0;
#pragma unroll
            for (int hf = 0; hf < 2; ++hf) { const u32x4 bq = *(const u32x4*)(src + hf * 8), cq = *(const u32x4*)(src + 256 + hf * 8);
                *(LAS f32x4*)(Bs + tt * 128 + c0 + hf * 8) = (f32x4){bf_lo(bq.x), bf_hi(bq.x), bf_lo(bq.y), bf_hi(bq.y)};
                *(LAS f32x4*)(Bs + tt * 128 + c0 + hf * 8 + 4) = (f32x4){bf_lo(bq.z), bf_hi(bq.z), bf_lo(bq.w), bf_hi(bq.w)};
                *(LAS f32x4*)(Cs + tt * 128 + c0 + hf * 8) = (f32x4){bf_lo(cq.x), bf_hi(cq.x), bf_lo(cq.y), bf_hi(cq.y)};
                *(LAS f32x4*)(Cs + tt * 128 + c0 + hf * 8 + 4) = (f32x4){bf_lo(cq.z), bf_hi(cq.z), bf_lo(cq.w), bf_hi(cq.w)}; }
        }
        if (tid < 64) { const float xr = DT[(size_t)(row0 + t0 + tid) * 32 + dir * 16 + h] + dtbias; const float dtv = fmaxf(xr, 0.f) + log1pf(__expf(-fabsf(xr))); dts[tid] = dtv; das[tid] = __expf(dtv * A); }
        {
            const int p2 = tid & 31, tr = tid >> 5, c = 2 * p2, tl = 4 * tr;
            float raw0[8], raw1[8];
#pragma unroll
            for (int i = 0; i < 8; ++i) { const int tt = t0 + tl - 2 + i; unsigned u = 0u; if (tt >= 0 && tt < L) u = *(const unsigned*)(X + (size_t)(row0 + tt) * 1536 + h * 64 + c); raw0[i] = bf_lo(u); raw1[i] = bf_hi(u); }
            float w0[5], w1[5];
#pragma unroll
            for (int j = 0; j < 5; ++j) { w0[j] = cw[j * 1536 + c]; w1[j] = cw[j * 1536 + c + 1]; }
            const float b0 = cb[c], b1 = cb[c + 1];
#pragma unroll
            for (int i = 0; i < 4; ++i) { float a0 = b0, a1 = b1;
#pragma unroll
                for (int j = 0; j < 5; ++j) { a0 += w0[j] * raw0[i + j]; a1 += w1[j] * raw1[i + j]; }
                *(LAS f32x2*)(xs + (tl + i) * 64 + c) = (f32x2){silu_f(a0), silu_f(a1)}; }
        }
        __syncthreads();
        for (int st = 0; st < 64; ++st) {
            const int tt = dir == 0 ? st : 63 - st;
            const float da = das[tt], dx = dts[tt] * xs[tt * 64 + p];
            float yp = 0.f;
#pragma unroll
            for (int i = 0; i < 4; ++i) { const f32x4 bv = *(const LAS f32x4*)(Bs + tt * 128 + ns * 16 + 4 * i), cv = *(const LAS f32x4*)(Cs + tt * 128 + ns * 16 + 4 * i);
#pragma unroll
                for (int e = 0; e < 4; ++e) { S[4 * i + e] = S[4 * i + e] * da + dx * bv[e]; yp += cv[e] * S[4 * i + e]; } }
            yp += __shfl_xor(yp, 1); yp += __shfl_xor(yp, 2); yp += __shfl_xor(yp, 4);
            if (ns == 0) yb[tt * 64 + p] = yp;
        }
        __syncthreads();
        {
            const int tt = tid >> 3, p0 = (tid & 7) * 8; const size_t off = (size_t)(row0 + t0 + tt) * 1024 + h * 64 + p0;
            const f32x4 ya = *(const LAS f32x4*)(yb + tt * 64 + p0), yc = *(const LAS f32x4*)(yb + tt * 64 + p0 + 4);
            float yv[8] = {ya[0], ya[1], ya[2], ya[3], yc[0], yc[1], yc[2], yc[3]};
            if (dir == 0) {
                u32x4 o; o.x = cvt_pk_bf16(yv[0], yv[1]); o.y = cvt_pk_bf16(yv[2], yv[3]); o.z = cvt_pk_bf16(yv[4], yv[5]); o.w = cvt_pk_bf16(yv[6], yv[7]);
                *(u32x4*)(Y + off) = o;
            } else {
                const u32x4 yq = *(const u32x4*)(Y + off), zq = *(const u32x4*)(Z + off);
                const f32x4 xa = *(const LAS f32x4*)(xs + tt * 64 + p0), xc = *(const LAS f32x4*)(xs + tt * 64 + p0 + 4);
                const float yf[8] = {bf_lo(yq.x), bf_hi(yq.x), bf_lo(yq.y), bf_hi(yq.y), bf_lo(yq.z), bf_hi(yq.z), bf_lo(yq.w), bf_hi(yq.w)};
                const float zf[8] = {bf_lo(zq.x), bf_hi(zq.x), bf_lo(zq.y), bf_hi(zq.y), bf_lo(zq.z), bf_hi(zq.z), bf_lo(zq.w), bf_hi(zq.w)};
                const float xf[8] = {xa[0], xa[1], xa[2], xa[3], xc[0], xc[1], xc[2], xc[3]};
                float r[8];
#pragma unroll
                for (int e = 0; e < 8; ++e) r[e] = (yf[e] + yv[e] + Dsk * xf[e]) * silu_f(zf[e]);
                u32x4 o; o.x = cvt_pk_bf16(r[0], r[1]); o.y = cvt_pk_bf16(r[2], r[3]); o.z = cvt_pk_bf16(r[4], r[5]); o.w = cvt_pk_bf16(r[6], r[7]);
                *(u32x4*)(Z + off) = o;
            }
        }
    }
    if (!lat) { float* sp = P.out + ZZ + OUT_ST + ((size_t)((((b * 2 + l) * 2 + dir) * 16 + h) * 64 + p)) * 128 + ns * 16;
#pragma unroll
        for (int i = 0; i < 4; ++i) *(f32x4*)(sp + 4 * i) = (f32x4){S[4 * i], S[4 * i + 1], S[4 * i + 2], S[4 * i + 3]}; }
}
__device__ __forceinline__ void phase_ssd(const Params& P, int l, LAS unsigned char* lds, int dir) {
    for (int u = blockIdx.x; u < 640; u += gridDim.x) {
        if (u < 128) ssd_unit(P, l, lds, 1, u >> 4, u & 15, dir);
        else { const int u2 = u - 128; ssd_unit(P, l, lds, 0, u2 >> 4, u2 & 15, dir); }
    }
}

__device__ __forceinline__ void pooled_rows(const Params& P, int gw, int NGW, int lane) {
    const int ZZ = opq0();
    const bf16_t* PU = (const bf16_t*)(P.ws + ZZ + WS_PU);
    bf16_t* PO = (bf16_t*)(P.ws + ZZ + WS_POOLED);
    {
        const int hw = 1 << (lane >> 4);
        float wgt[16];
#pragma unroll
        for (int dk = -8; dk < 8; ++dk) wgt[dk + 8] = (dk >= -hw && dk < hw) ? 1.f : 0.f;
        for (int task = gw; task < MTOK / 4; task += NGW) {
            const int r0 = task * 4;
            int t0, L; if (r0 < MCTX) { t0 = r0 & 255; L = LCTX; } else { t0 = (r0 - MCTX) & 2047; L = LLAT; }
            u32x4 rows[20];
#pragma unroll
            for (int k = 0; k < 20; ++k) { const int tt = t0 + k - 8; rows[k] = (u32x4){0u, 0u, 0u, 0u}; if (tt >= 0 && tt < L) rows[k] = *(const u32x4*)(PU + (size_t)(r0 + k - 8) * 512 + lane * 8); }
#pragma unroll
            for (int j = 0; j < 4; ++j) {
                float a[8];
#pragma unroll
                for (int e = 0; e < 8; ++e) a[e] = 0.f;
#pragma unroll
                for (int dk = 0; dk < 16; ++dk) { const u32x4 q = rows[j + dk]; const float ww = wgt[dk];
                    a[0] += ww * bf_lo(q.x); a[1] += ww * bf_hi(q.x); a[2] += ww * bf_lo(q.y); a[3] += ww * bf_hi(q.y); a[4] += ww * bf_lo(q.z); a[5] += ww * bf_hi(q.z); a[6] += ww * bf_lo(q.w); a[7] += ww * bf_hi(q.w); }
                const int t = t0 + j, lo = t - hw < 0 ? 0 : t - hw, hi = t + hw > L ? L : t + hw;
                const float ic = 1.0f / (float)(hi - lo);
                const u32x4 q = rows[j + 8];
                const float uu[8] = {bf_lo(q.x), bf_hi(q.x), bf_lo(q.y), bf_hi(q.y), bf_lo(q.z), bf_hi(q.z), bf_lo(q.w), bf_hi(q.w)};
#pragma unroll
                for (int e = 0; e < 8; ++e) a[e] = a[e] * ic - uu[e];
                u32x4 o; o.x = cvt_pk_bf16(a[0], a[1]); o.y = cvt_pk_bf16(a[2], a[3]); o.z = cvt_pk_bf16(a[4], a[5]); o.w = cvt_pk_bf16(a[6], a[7]);
                *(u32x4*)(PO + (size_t)(r0 + j) * 512 + lane * 8) = o;
            }
        }
    }
}
__device__ __forceinline__ void ssq_sum(const Params& P) {
    const int ZZ = opq0();
    const float* sh = (const float*)(P.ws + ZZ + WS_SSQH);
    for (int m = blockIdx.x * 512 + threadIdx.x; m < MTOK; m += gridDim.x * 512) { float s = 0.f;
#pragma unroll
        for (int h = 0; h < 16; ++h) s += sh[(size_t)h * MTOK + m];
        ((float*)(P.ws + ZZ + WS_SSQ))[m] = s; }
}
__device__ __forceinline__ void phase_h2(const Params& P, int l) {
    const int ZZ = opq0();
    const int tid = threadIdx.x, lane = tid & 63, w = tid >> 6;
    const int gw = blockIdx.x * 8 + w, NGW = gridDim.x * 8;
    const float* MOD = (const float*)(P.ws + ZZ + WS_MOD) + (size_t)l * 9 * 6144;
    norm_rows_x(P, ZZ, P.in[ZZ + I_N2G] + l * 1024, MOD, 3072, 4096, gw, NGW, lane);
}
__device__ __forceinline__ void dt_prepass(const Params& P, int l) {
    const int ZZ = opq0();
    const int tid = threadIdx.x, lane = tid & 63, w = tid >> 6;
    const int gw = blockIdx.x * 8 + w, NGW = gridDim.x * 8;
    const float* DT = (const float*)(P.ws + ZZ + WS_DT); float* DTS = (float*)(P.ws + ZZ + WS_DTS); float* CUM = (float*)(P.ws + ZZ + WS_CUM2);
    constexpr int NT = 3;
    for (int task0 = gw; task0 < 192 * 32; task0 += NT * NGW) {
        float xr0[NT], xr1[NT];
#pragma unroll
        for (int k = 0; k < NT; ++k) { const int task = task0 + k * NGW; xr0[k] = 0.f; xr1[k] = 0.f;
            if (task < 192 * 32) { const size_t i0 = (size_t)((task >> 5) * 128 + 2 * lane) * 32 + (task & 31); xr0[k] = DT[i0]; xr1[k] = DT[i0 + 32]; } }
#pragma unroll
        for (int k = 0; k < NT; ++k) { const int task = task0 + k * NGW; if (task >= 192 * 32) break;
            const int hd = task & 31, rbase = (task >> 5) * 128;
            const float A = -__expf(P.in[ZZ + I_ALOG][l * 32 + hd]), bias = P.in[ZZ + I_DTB][l * 32 + hd];
            const size_t o0 = (size_t)hd * MTOK + rbase + 2 * lane;
            const float x0 = xr0[k] + bias, x1 = xr1[k] + bias;
            const float d0 = fmaxf(x0, 0.f) + log1pf(__expf(-fabsf(x0))), d1 = fmaxf(x1, 0.f) + log1pf(__expf(-fabsf(x1)));
            const float a0 = d0 * A, a1 = d1 * A, pair = a0 + a1;
            float s = pair;
            if (hd < 16) {
#pragma unroll
                for (int dlt = 1; dlt < 64; dlt <<= 1) { const float v = __shfl_up(s, dlt); if (lane >= dlt) s += v; }
                const float ex = s - pair; *(f32x2*)(CUM + o0) = (f32x2){ex + a0, ex + pair};
            } else {
#pragma unroll
                for (int dlt = 1; dlt < 64; dlt <<= 1) { const float v = __shfl_down(s, dlt); if (lane + dlt < 64) s += v; }
                const float ex = s - pair; *(f32x2*)(CUM + o0) = (f32x2){ex + pair, ex + a1};
            }
            *(f32x2*)(DTS + o0) = (f32x2){d0, d1};
        }
    }
}
constexpr int SL_C = 0, SL_B = 32768, SL_XT = 65536, SL_XE = 81920, SL_SB = 98304  , SL_CUM = 131072, SL_DT = 131584;
__device__ __forceinline__ unsigned short bf16_1(float x) { return (unsigned short)(cvt_pk_bf16_c(x, x) & 0xffffu); }
__device__ __forceinline__ void ssd_chain(const Params& P, int l, LAS unsigned char* lds, int lat, int b, int h, int dir, bool dry) {
    const int ZZ = opq0();
    const int tid = threadIdx.x, lane = tid & 63, w = __builtin_amdgcn_readfirstlane(tid >> 6), g = lane >> 4, li = lane & 15;
    const int L = lat ? LLAT : LCTX, row0 = lat ? MCTX + b * LLAT : b * LCTX, grp = h >> 3, hd = dir * 16 + h, nck = L / 128;
    const float Dsk = P.in[ZZ + I_DSKIP][l * 16 + h];
    const bf16_t* X = (const bf16_t*)(P.ws + ZZ + WS_X2) + (size_t)h * MTOK * 64;
    const bf16_t* BC = (const bf16_t*)(P.ws + ZZ + WS_BC) + (size_t)grp * MTOK * 256;
    const float* DT = (const float*)(P.ws + ZZ + WS_DTS) + (size_t)hd * MTOK;
    const float* CUM = (const float*)(P.ws + ZZ + WS_CUM2) + (size_t)hd * MTOK;
    bf16_t* Y = (bf16_t*)((unsigned char*)(P.out + ZZ) + OUTB_Y) + (size_t)h * MTOK * 64;
    bf16_t* Z = (bf16_t*)(P.ws + ZZ + WS_Z);
    const float* cw = P.in[ZZ + I_CONVW] + (size_t)l * 5 * 1536 + h * 64;
    const float* cb = P.in[ZZ + I_CONVB] + (size_t)l * 1536 + h * 64;
    LAS float* cumL = (LAS float*)(lds + SL_CUM);
    LAS float* dtL = (LAS float*)(lds + SL_DT);
    const int pt_s = w & 3, nt0 = 4 * (w >> 2);
    f32x4 Sacc[4];
    if (lat) { const float* sp = P.in[ZZ + I_ST] + (size_t)((((b * 2 + l) * 2 + dir) * 16 + h) * 64) * 128;
#pragma unroll
        for (int k = 0; k < 4; ++k)
#pragma unroll
            for (int r = 0; r < 4; ++r) Sacc[k][r] = sp[(size_t)(16 * pt_s + 4 * g + r) * 128 + 16 * (nt0 + k) + li]; }
    else {
#pragma unroll
        for (int k = 0; k < 4; ++k) Sacc[k] = (f32x4){0.f, 0.f, 0.f, 0.f}; }
    int sb = 0;
#define SSD_WRITE_SB(sel) do { _Pragma("unroll") for (int k = 0; k < 4; ++k) _Pragma("unroll") for (int r = 0; r < 4; ++r) { const int p_ = 16 * pt_s + 4 * g + r, n_ = 16 * (nt0 + k) + li; \
        *(LAS unsigned short*)(lds + SL_SB + (sel) * 16384 + p_ * 256 + ((((n_ >> 3) ^ (p_ & 15))) << 4) + (n_ & 7) * 2) = bf16_1(Sacc[k][r]); } } while (0)
    const int st_c = 2 * (tid & 31), st_jr = tid >> 5;
    float cw0[5], cw1[5];
#pragma unroll
    for (int j = 0; j < 5; ++j) { cw0[j] = cw[j * 1536 + st_c]; cw1[j] = cw[j * 1536 + st_c + 1]; }
    const float cb0 = cb[st_c], cb1 = cb[st_c + 1];
    float pf_cum, pf_dt, pf_tot; u32x4 pf_b[4], pf_c[4]; unsigned pf_x[12]; float pf_xdt[8], pf_xcum[8];
    const unsigned vo_bc = (unsigned)((tid >> 4) * 512 + (tid & 15) * 16);
    const unsigned vo_x = (unsigned)(st_jr * 1024 + st_c * 2);
    const unsigned vo_dt = (unsigned)(st_jr * 32);
    const unsigned vo_t = (unsigned)((tid & 127) * 4);
#define SSD_PREFETCH(CK) do { const int t0_ = (dir == 0 ? (CK) : nck - 1 - (CK)) * 128; const size_t rb_ = (size_t)row0 + t0_; \
        const char* bcb_ = (const char*)(BC + rb_ * 256); const char* xb_ = (const char*)(X + ((ptrdiff_t)rb_ - 2) * 64); const char* dtb_ = (const char*)(DT + rb_); const char* cmb_ = (const char*)(CUM + rb_); \
        if (tid < 128) { pf_cum = *(const float*)(cmb_ + vo_t); pf_dt = *(const float*)(dtb_ + vo_t); } \
        pf_tot = *(const float*)(cmb_ + (dir == 0 ? 127 * 4 : 0)); \
        _Pragma("unroll") for (int k = 0; k < 4; ++k) { pf_b[k] = *(const u32x4*)(bcb_ + k * 16384 + vo_bc); pf_c[k] = *(const u32x4*)(bcb_ + k * 16384 + 256 + vo_bc); } \
        _Pragma("unroll") for (int e = 0; e < 12; ++e) pf_x[e] = *(const unsigned*)(xb_ + e * 128 + vo_x); \
        { const bool lo_bad = (t0_ == 0 && st_jr == 0), hi_bad = (t0_ + 128 == L && st_jr == 15);     \
          if (lo_bad) { pf_x[0] = 0u; pf_x[1] = 0u; } if (hi_bad) { pf_x[10] = 0u; pf_x[11] = 0u; } } \
        { const f32x4 d0_ = *(const f32x4*)(dtb_ + vo_dt), d1_ = *(const f32x4*)(dtb_ + 16 + vo_dt), c0_ = *(const f32x4*)(cmb_ + vo_dt), c1_ = *(const f32x4*)(cmb_ + 16 + vo_dt); \
          _Pragma("unroll") for (int e = 0; e < 4; ++e) { pf_xdt[e] = d0_[e]; pf_xdt[4 + e] = d1_[e]; pf_xcum[e] = c0_[e]; pf_xcum[4 + e] = c1_[e]; } } } while (0)
    __syncthreads();
    SSD_WRITE_SB(0);
    SSD_PREFETCH(0);
#ifdef SSD_TS
    unsigned long long ts_acc0 = 0, ts_acc1 = 0, ts_acc2 = 0, ts_acc3 = 0, ts_acc4 = 0, ts_prev = __builtin_amdgcn_s_memrealtime();
#define TS_MARK(A) do { const unsigned long long t_ = __builtin_amdgcn_s_memrealtime(); A += t_ - ts_prev; ts_prev = t_; } while (0)
#else
#define TS_MARK(A) do { } while (0)
#endif
    for (int ck = 0; ck < nck; ++ck) {
        const int t0 = (dir == 0 ? ck : nck - 1 - ck) * 128;
        const size_t rbase = (size_t)row0 + t0;
        LDS_BARRIER();
        TS_MARK(ts_acc0);
        if (tid < 128) { cumL[tid] = pf_cum * 1.4426950408889634f; dtL[tid] = pf_dt; }
        const float tot = pf_tot;
#pragma unroll
        for (int k = 0; k < 4; ++k) { const int idx = tid + 512 * k, row = idx >> 4, ch = idx & 15;
            *(LAS u32x4*)(lds + SL_B + row * 256 + ((ch ^ (row & 15)) << 4)) = pf_b[k];
            *(LAS u32x4*)(lds + SL_C + row * 256 + ((ch ^ (row & 15)) << 4)) = pf_c[k]; }
#ifdef SSD_TS2
        TS_MARK(ts_acc1);
#endif
        {
            const int c = st_c, jr = st_jr;
            f32x2 x2[12];
#pragma unroll
            for (int e = 0; e < 12; ++e) x2[e] = (f32x2){bf_lo(pf_x[e]), bf_hi(pf_x[e])};
            f32x2 xv[8], xe[8];
#pragma unroll
            for (int e = 0; e < 8; ++e) { f32x2 a = (f32x2){cb0, cb1};
#pragma unroll
                for (int j = 0; j < 5; ++j) a = __builtin_elementwise_fma((f32x2){cw0[j], cw1[j]}, x2[e + j], a);
                const f32x2 sl = (f32x2){silu_f(a[0]), silu_f(a[1])};
                xv[e] = sl * pf_xdt[e]; xe[e] = xv[e] * __expf(tot - pf_xcum[e]); }
#pragma unroll
            for (int hf = 0; hf < 2; ++hf) { const int cc = c + hf, o = cc * 256 + ((jr ^ (cc & 15)) << 4);
                u32x4 q; q.x = cvt_pk_bf16_c(xv[0][hf], xv[1][hf]); q.y = cvt_pk_bf16_c(xv[2][hf], xv[3][hf]); q.z = cvt_pk_bf16_c(xv[4][hf], xv[5][hf]); q.w = cvt_pk_bf16_c(xv[6][hf], xv[7][hf]);
                *(LAS u32x4*)(lds + SL_XT + o) = q;
                q.x = cvt_pk_bf16_c(xe[0][hf], xe[1][hf]); q.y = cvt_pk_bf16_c(xe[2][hf], xe[3][hf]); q.z = cvt_pk_bf16_c(xe[4][hf], xe[5][hf]); q.w = cvt_pk_bf16_c(xe[6][hf], xe[7][hf]);
                *(LAS u32x4*)(lds + SL_XE + o) = q; }
        }
#ifdef SSD_TS2
        TS_MARK(ts_acc2);
#endif
        if (ck + 1 < nck) SSD_PREFETCH(ck + 1);
#ifdef SSD_TS2
        TS_MARK(ts_acc3);
#else
        TS_MARK(ts_acc1);
#endif
        LDS_BARRIER();
#ifndef SSD_TS2
        TS_MARK(ts_acc2);
#endif
        const int i = 16 * w + li;
        const float cum_i = cumL[i];
        bf16x8 cf[4];
#pragma unroll
        for (int ks = 0; ks < 4; ++ks) cf[ks] = *(const LAS bf16x8*)(lds + SL_C + i * 256 + (((4 * ks + g) ^ (i & 15)) << 4));
        f32x4 y[4];
#pragma unroll
        for (int pt = 0; pt < 4; ++pt) { y[pt] = (f32x4){0.f, 0.f, 0.f, 0.f}; const int p = 16 * pt + li;
#pragma unroll
            for (int ks = 0; ks < 4; ++ks) { const bf16x8 a = *(const LAS bf16x8*)(lds + SL_SB + sb * 16384 + p * 256 + (((4 * ks + g) ^ (p & 15)) << 4));
                y[pt] = __builtin_amdgcn_mfma_f32_16x16x32_bf16(a, cf[ks], y[pt], 0, 0, 0); } }
        { const float ei = __builtin_amdgcn_exp2f(cum_i);
#pragma unroll
            for (int pt = 0; pt < 4; ++pt) y[pt] = y[pt] * ei; }
        const int s_lo = dir == 0 ? 0 : (w >> 1), s_hi = dir == 0 ? (w >> 1) : 3;
        for (int s = s_lo; s <= s_hi; ++s) {
            f32x4 G0 = (f32x4){0.f, 0.f, 0.f, 0.f}, G1 = G0;
            const int j0 = 32 * s + li, j1 = j0 + 16;
#pragma unroll
            for (int ks = 0; ks < 4; ++ks) {
                const bf16x8 a0 = *(const LAS bf16x8*)(lds + SL_B + j0 * 256 + (((4 * ks + g) ^ (j0 & 15)) << 4));
                const bf16x8 a1 = *(const LAS bf16x8*)(lds + SL_B + j1 * 256 + (((4 * ks + g) ^ (j1 & 15)) << 4));
                G0 = __builtin_amdgcn_mfma_f32_16x16x32_bf16(a0, cf[ks], G0, 0, 0, 0);
                G1 = __builtin_amdgcn_mfma_f32_16x16x32_bf16(a1, cf[ks], G1, 0, 0, 0); }
            const f32x4 cj0 = *(const LAS f32x4*)(cumL + 32 * s + 4 * g), cj1 = *(const LAS f32x4*)(cumL + 32 * s + 16 + 4 * g);
            const int sg = dir == 0 ? 1 : -1, mb = sg * (i - 32 * s - 4 * g);
#pragma unroll
            for (int r = 0; r < 4; ++r) { const bool va = mb >= sg * r, vb = mb >= sg * (r + 16);
                G0[r] = va ? G0[r] * __builtin_amdgcn_exp2f(cum_i - cj0[r]) : 0.f; G1[r] = vb ? G1[r] * __builtin_amdgcn_exp2f(cum_i - cj1[r]) : 0.f; }
            u32x4 pk; pk.x = cvt_pk_bf16(G0[0], G0[1]); pk.y = cvt_pk_bf16(G0[2], G0[3]); pk.z = cvt_pk_bf16(G1[0], G1[1]); pk.w = cvt_pk_bf16(G1[2], G1[3]);
            const bf16x8 bp = __builtin_bit_cast(bf16x8, pk);
#pragma unroll
            for (int pt = 0; pt < 4; ++pt) { const int p = 16 * pt + li;
                const u32x2 lo8 = *(const LAS u32x2*)(lds + SL_XT + p * 256 + (((4 * s + (g >> 1)) ^ (p & 15)) << 4) + 8 * (g & 1));
                const u32x2 hi8 = *(const LAS u32x2*)(lds + SL_XT + p * 256 + (((4 * s + 2 + (g >> 1)) ^ (p & 15)) << 4) + 8 * (g & 1));
                u32x4 av; av.x = lo8.x; av.y = lo8.y; av.z = hi8.x; av.w = hi8.y;
                y[pt] = __builtin_amdgcn_mfma_f32_16x16x32_bf16(__builtin_bit_cast(bf16x8, av), bp, y[pt], 0, 0, 0); }
        }
        { const float etot = __expf(tot);
#pragma unroll
            for (int k = 0; k < 4; ++k) Sacc[k] = Sacc[k] * etot; }
        unsigned tra[2][4];
        { int lq = li; asm volatile("" : "+v"(lq)); const int q = lq >> 2, pp = lq & 3;
#pragma unroll
          for (int t = 0; t < 2; ++t)
#pragma unroll
            for (int k = 0; k < 4; ++k) { const int row = 8 * g + 4 * t + q, ch = 2 * (nt0 + k) + (pp >> 1);
                tra[t][k] = (unsigned)(SL_B + row * 256 + ((ch ^ (row & 15)) << 4) + 8 * (pp & 1)); } }
        u32x2 ta[8], tb[8];
#define SSD_TR_READ(T, KS) asm volatile("ds_read_b64_tr_b16 %0, %8 offset:%16\n\tds_read_b64_tr_b16 %1, %9 offset:%16\n\tds_read_b64_tr_b16 %2, %10 offset:%16\n\tds_read_b64_tr_b16 %3, %11 offset:%16\n\t" \
                         "ds_read_b64_tr_b16 %4, %12 offset:%16\n\tds_read_b64_tr_b16 %5, %13 offset:%16\n\tds_read_b64_tr_b16 %6, %14 offset:%16\n\tds_read_b64_tr_b16 %7, %15 offset:%16" \
                         : "=&v"(T[0]), "=&v"(T[1]), "=&v"(T[2]), "=&v"(T[3]), "=&v"(T[4]), "=&v"(T[5]), "=&v"(T[6]), "=&v"(T[7]) \
                         : "v"(tra[0][0]), "v"(tra[0][1]), "v"(tra[0][2]), "v"(tra[0][3]), "v"(tra[1][0]), "v"(tra[1][1]), "v"(tra[1][2]), "v"(tra[1][3]), "i"(8192 * (KS)) : "memory")
#define SSD_TR_WAIT(T, N) asm volatile("s_waitcnt lgkmcnt(" #N ")" : "+v"(T[0]), "+v"(T[1]), "+v"(T[2]), "+v"(T[3]), "+v"(T[4]), "+v"(T[5]), "+v"(T[6]), "+v"(T[7]) :: "memory")
#define SSD_STATE_MMA(T, KS) do { const int p_ = 16 * pt_s + li; const bf16x8 a_ = *(const LAS bf16x8*)(lds + SL_XE + p_ * 256 + (((4 * (KS) + g) ^ (p_ & 15)) << 4)); \
            u32x4 b0_, b1_, b2_, b3_; b0_.x = T[0].x; b0_.y = T[0].y; b0_.z = T[4].x; b0_.w = T[4].y; b1_.x = T[1].x; b1_.y = T[1].y; b1_.z = T[5].x; b1_.w = T[5].y; \
            b2_.x = T[2].x; b2_.y = T[2].y; b2_.z = T[6].x; b2_.w = T[6].y; b3_.x = T[3].x; b3_.y = T[3].y; b3_.z = T[7].x; b3_.w = T[7].y; \
            Sacc[0] = __builtin_amdgcn_mfma_f32_16x16x32_bf16(a_, __builtin_bit_cast(bf16x8, b0_), Sacc[0], 0, 0, 0); Sacc[1] = __builtin_amdgcn_mfma_f32_16x16x32_bf16(a_, __builtin_bit_cast(bf16x8, b1_), Sacc[1], 0, 0, 0); \
            Sacc[2] = __builtin_amdgcn_mfma_f32_16x16x32_bf16(a_, __builtin_bit_cast(bf16x8, b2_), Sacc[2], 0, 0, 0); Sacc[3] = __builtin_amdgcn_mfma_f32_16x16x32_bf16(a_, __builtin_bit_cast(bf16x8, b3_), Sacc[3], 0, 0, 0); } while (0)
        SSD_TR_READ(ta, 0); SSD_TR_READ(tb, 1);
        SSD_TR_WAIT(ta, 8); SSD_STATE_MMA(ta, 0); __builtin_amdgcn_sched_barrier(0);
        SSD_TR_READ(ta, 2);
        SSD_TR_WAIT(tb, 8); SSD_STATE_MMA(tb, 1); __builtin_amdgcn_sched_barrier(0);
        SSD_TR_READ(tb, 3);
        SSD_TR_WAIT(ta, 8); SSD_STATE_MMA(ta, 2); __builtin_amdgcn_sched_barrier(0);
        SSD_TR_WAIT(tb, 0); SSD_STATE_MMA(tb, 3);
#undef SSD_TR_READ
#undef SSD_TR_WAIT
#undef SSD_STATE_MMA
        sb ^= 1;
        SSD_WRITE_SB(sb);
#ifndef SSD_TS2
        TS_MARK(ts_acc3);
#endif
        const float rdti = __builtin_amdgcn_rcpf(dtL[i]);
        float ssq_part = 0.f;
#pragma unroll
        for (int pt = 0; pt < 4; ++pt) { const size_t off = (rbase + i) * 1024 + h * 64 + 16 * pt + 4 * g, yoff = (rbase + i) * 64 + 16 * pt + 4 * g;
            if (dir == 0) { u32x2 o; o.x = cvt_pk_bf16(y[pt][0], y[pt][1]); o.y = cvt_pk_bf16(y[pt][2], y[pt][3]); *(u32x2*)(Y + yoff) = o; }
            else {
                const u32x2 yq = *(const u32x2*)(Y + yoff), zq = *(const u32x2*)(Z + off);
                const float yf[4] = {bf_lo(yq.x), bf_hi(yq.x), bf_lo(yq.y), bf_hi(yq.y)}, zf[4] = {bf_lo(zq.x), bf_hi(zq.x), bf_lo(zq.y), bf_hi(zq.y)};
                float rr[4];
#pragma unroll
                for (int r = 0; r < 4; ++r) { const int p = 16 * pt + 4 * g + r;
                    const unsigned short xr = *(const LAS unsigned short*)(lds + SL_XT + p * 256 + (((i >> 3) ^ (p & 15)) << 4) + (i & 7) * 2);
                    const float xv = __uint_as_float((unsigned)xr << 16) * rdti;
                    rr[r] = (yf[r] + y[pt][r] + Dsk * xv) * silu_f(zf[r]); }
                u32x2 o; o.x = cvt_pk_bf16(rr[0], rr[1]); o.y = cvt_pk_bf16(rr[2], rr[3]); *(u32x2*)(Z + off) = dry ? zq : o;
                { const float q0 = bf_lo(o.x), q1 = bf_hi(o.x), q2 = bf_lo(o.y), q3 = bf_hi(o.y); ssq_part += (q0 * q0 + q1 * q1) + (q2 * q2 + q3 * q3); }
            }
        }
        if (dir == 1 && !dry) {
            ssq_part += __shfl_xor(ssq_part, 16); ssq_part += __shfl_xor(ssq_part, 32);
            if (g == 0) ((float*)(P.ws + ZZ + WS_SSQH))[(size_t)h * MTOK + rbase + i] = ssq_part;
        }
        TS_MARK(ts_acc4);
    }
#ifdef SSD_TS
    if (blockIdx.x == 0 && l == 0 && lat && dir == 0 && (tid == 0 || tid == 448)) { unsigned long long* o_ = (unsigned long long*)(P.ws + ZZ + 512 * 1024 + 1024) + (tid ? 8 : 0);
        o_[0] = ts_acc0; o_[1] = ts_acc1; o_[2] = ts_acc2; o_[3] = ts_acc3; o_[4] = ts_acc4; }
#endif
    if (!lat) { float* sp = P.out + ZZ + OUT_ST + (size_t)((((b * 2 + l) * 2 + dir) * 16 + h) * 64) * 128;
#pragma unroll
        for (int k = 0; k < 4; ++k)
#pragma unroll
            for (int r = 0; r < 4; ++r) sp[(size_t)(16 * pt_s + 4 * g + r) * 128 + 16 * (nt0 + k) + li] = Sacc[k][r]; }
#undef TS_MARK
#undef SSD_WRITE_SB
#undef SSD_PREFETCH
}
__device__ __forceinline__ void latent_chain_of(int c, int& b, int& h) {
    const int x = c & 7, k = c >> 3, combo = x + 8 * (k >> 3); b = combo >> 1; h = (combo & 1) * 8 + (k & 7);
}
__device__ __forceinline__ void context_unit_of(int u, int& b, int& h) {
    const int cb = u >> 2, j = u & 3, x = cb & 7, ku = (cb >> 3) * 4 + j, combo = x + 8 * (ku >> 3); b = combo >> 1; h = (combo & 1) * 8 + (ku & 7);
}
#ifndef CTXMOVE
#define CTXMOVE 1
#endif
__device__ __forceinline__ void phase_ssd1(const Params& P, int l, LAS unsigned char* lds, bool dry) {
    const int G = gridDim.x, bid = blockIdx.x;
    const bool fast = (G == 256);
    for (int q = 0;; ++q) {
        int it, dir;
        if (fast) { if (bid < 128) { if (q >= 1) break; it = bid; dir = 0; } else { if (q >= 8 - CTXMOVE) break; it = 128 + (bid - 128) * 4 + (q >> 1); dir = q & 1; } }
        else { it = bid + (q >> 1) * G; dir = q & 1; if (it >= 640) break; if (it < 128 && dir == 1) continue; }
        const int lat = it < 128 ? 1 : 0; int b, h;
        if (lat) latent_chain_of(it, b, h); else context_unit_of(it - 128, b, h);
        ssd_chain(P, l, lds, lat, b, h, dir, dry);
    }
}
__device__ __forceinline__ void phase_ssd2(const Params& P, int l, LAS unsigned char* lds, bool dry, int first, int stride) {
    const bool fast = (gridDim.x == 256);
    for (int u = first; u < 128; u += stride) {
        for (int k = 0; k < (fast ? 1 + CTXMOVE : 1); ++k) {
            int b, h; const int lat = k == 0 ? 1 : 0;
            if (lat) latent_chain_of(u, b, h); else context_unit_of(4 * u + 3, b, h);
            ssd_chain(P, l, lds, lat, b, h, 1, dry);
        }
    }
}
#define XB_TMO      128
#define XB_XCNT(j)  (256  + 64 * (j))
#define XB_XSUB(j)  (1280 + 64 * (j))
#define XB_XGEN(j)  (2304 + 64 * (j))
#define XB_TOP      3328
#define XB_TOPGEN   3392
#define XCD_BAR_WORDS 3456
#define XB_SPIN_CAP (1u << 18)

__device__ __forceinline__ unsigned xb_ld(unsigned* p)              { return __hip_atomic_load(p, __ATOMIC_RELAXED, __HIP_MEMORY_SCOPE_AGENT); }
__device__ __forceinline__ unsigned xb_add(unsigned* p, unsigned v) { return __hip_atomic_fetch_add(p, v, __ATOMIC_RELAXED, __HIP_MEMORY_SCOPE_AGENT); }
__device__ __forceinline__ unsigned xb_xcc_id() { return (unsigned)__builtin_amdgcn_s_getreg((3 << 11) | 20) & 0xFu; }
#define XB_SPIN(cond, bar) do { unsigned _sp = 0; while (cond) { __builtin_amdgcn_s_sleep(1); \
    if ((++_sp & 255u) == 0u) { if (xb_ld(&(bar)[XB_TMO])) break; if (_sp > XB_SPIN_CAP) { atomicAdd(&(bar)[XB_TMO], 1u); break; } } } } while (0)

struct XcdBarrier {
    unsigned* bar; unsigned x;
    volatile LAS unsigned* st;
};

__device__ __forceinline__ XcdBarrier xcd_barrier_post(unsigned* bar, volatile LAS unsigned* st) {
    XcdBarrier b; b.bar = bar; b.x = xb_xcc_id(); b.st = st;
    if (threadIdx.x == 0) (void)xb_add(&bar[XB_XCNT(b.x)], 1u);
    return b;
}
__device__ __forceinline__ void xcd_barrier_complete(unsigned* bar, unsigned x, unsigned& nloc, unsigned& nx) {
    const unsigned G = gridDim.x * gridDim.y * gridDim.z;
    unsigned sum, cnt, mine, sp = 0u;
    for (;;) {
        sum = 0u; cnt = 0u; mine = 0u;
#pragma unroll
        for (unsigned j = 0; j < 16; ++j) { const unsigned c = xb_ld(&bar[XB_XCNT(j)]); sum += c; cnt += (c > 0u) ? 1u : 0u; mine = (j == x) ? c : mine; }
        if (sum == G) break;
        __builtin_amdgcn_s_sleep(1);
        if ((++sp & 255u) == 0u) { if (xb_ld(&bar[XB_TMO])) break; if (sp > XB_SPIN_CAP) { atomicAdd(&bar[XB_TMO], 1u); break; } }
    }
    nloc = mine > 0u ? mine : 1u; nx = cnt > 0u ? cnt : 1u;
}

__device__ __forceinline__ void xcd_barrier(const XcdBarrier& b) {
    asm volatile("s_waitcnt vmcnt(0)" ::: "memory");
    __syncthreads();
    if (threadIdx.x == 0) {
        unsigned* bar = b.bar;
        __builtin_amdgcn_s_waitcnt(0);
        unsigned nloc = b.st[0], nx = b.st[1];
        if (nloc == 0u) { xcd_barrier_complete(bar, b.x, nloc, nx); b.st[0] = nloc; b.st[1] = nx; }
        const unsigned old = xb_add(&bar[XB_XSUB(b.x)], 1u);
        const unsigned gen = old / nloc;
        if (old + 1u == (gen + 1u) * nloc) {
            __builtin_amdgcn_fence(__ATOMIC_RELEASE, "agent");
            asm volatile("s_waitcnt vmcnt(0)" ::: "memory");
            const unsigned og = xb_add(&bar[XB_TOP], 1u);
            const unsigned tg = og / nx;
            if (og + 1u == (tg + 1u) * nx) xb_add(&bar[XB_TOPGEN], 1u);
            else XB_SPIN(xb_ld(&bar[XB_TOPGEN]) == tg, bar);
            __builtin_amdgcn_fence(__ATOMIC_ACQUIRE, "agent");
            xb_add(&bar[XB_XGEN(b.x)], 1u);
            asm volatile("s_waitcnt vmcnt(0)" ::: "memory");
        } else {
            XB_SPIN(xb_ld(&bar[XB_XGEN(b.x)]) == gen, bar);
            __builtin_amdgcn_fence(__ATOMIC_ACQUIRE, "agent");
            asm volatile("s_waitcnt vmcnt(0)" ::: "memory");
        }
    }
    __syncthreads();
}
#ifndef N_LAUNCHES
#define N_LAUNCHES 1
#endif
#ifndef DEBUG_STAGE
#define DEBUG_STAGE 0
#endif
#define PH_IN(p) (lo <= (p) && (p) < hi)
#ifndef MT_MERGE
#define MT_MERGE 3
#endif
#ifndef MT_RESID
#define MT_RESID 3
#endif
#ifndef REP_PHASE
#define REP_PHASE -1
#endif
#define REPS(k) for (int rep_ = 0; rep_ < ((k) == REP_PHASE ? 2 : 1); ++rep_)
#define DRY(k) ((k) == REP_PHASE && rep_ == 0)
#ifdef ONLY_CASE
#define PH_ON(k) (((ONLY_CASE) >> (k)) & 1)
#else
#define PH_ON(k) 1
#endif
#ifdef PROBE_TS
constexpr size_t WS_TS = 512 * 1024;
#define SEAM(p) do { if (PH_IN(p) && PH_IN((p) + 1)) { xcd_barrier(xbar); if (blockIdx.x == 0 && threadIdx.x == 0) ((unsigned long long*)(P.ws + WS_TS))[(p) + 1] = __builtin_amdgcn_s_memrealtime(); } } while (0)
#else
#define SEAM(p) do { if (PH_IN(p) && PH_IN((p) + 1)) xcd_barrier(xbar); } while (0)
#endif
#ifdef PROBE_TS
#define SEAM_45(p) do { if (PH_IN(p) && PH_IN((p) + 2)) { xcd_barrier(xbar); if (blockIdx.x == 0 && threadIdx.x == 0) { const unsigned long long t_ = __builtin_amdgcn_s_memrealtime(); ((unsigned long long*)(P.ws + WS_TS))[(p) + 1] = t_; ((unsigned long long*)(P.ws + WS_TS))[(p) + 2] = t_; } } } while (0)
#else
#define SEAM_45(p) do { if (PH_IN(p) && PH_IN((p) + 2)) xcd_barrier(xbar); } while (0)
#endif
#define SEAM_MID(p) do { if (PH_IN(p)) xcd_barrier(xbar); } while (0)
template <int L>
__device__ __forceinline__ void layer_program(const Params& P, LAS unsigned char* lds, const XcdBarrier& xbar, const int lo, const int hi) {
    constexpr int B = 1 + NPH_LAYER * L;
    if (PH_ON(0) && PH_IN(B + 0)) REPS(0) phase_p0(P, L, lds);
    SEAM(B + 0);
    if (PH_ON(1) && PH_IN(B + 1)) REPS(1) {
        const int ZZ = opq0(); unsigned char* ws = P.ws + ZZ; float* outp = P.out + ZZ;
        pg8::Gemm g{(const bf16_t*)outp, (const bf16_t*)(ws + WS_WIN), MTOK, 4096, 1024};
        pg8::StaticOrder S; S.init(MTOK, 4096, gridDim.x, blockIdx.x);
        pg8::EpiInProj E{ws, outp + OUT_CV, L};
        pg8::gemm_phase<pg8::EpiInProj, pg8::StaticOrder, true, true>(lds, g, S, E);
    }
    SEAM(B + 1);
    if (PH_ON(2) && PH_IN(B + 2)) REPS(2) { if (rep_ == 0) { qk_prep(P, L); dt_prepass(P, L); } bc_conv(P, L); }
    SEAM(B + 2);
#ifndef ATT3
#define ATT3 1
#endif
#ifndef ATT4S
#define ATT4S 0
#endif
    if (PH_ON(3) && PH_IN(B + 3)) REPS(3) {
        phase_ssd1(P, L, lds, DRY(3));
        if (gridDim.x == 256 && blockIdx.x < 128 && !DRY(3)) phase_attn(P, L, lds, WS_Q, blockIdx.x, 128, 128 * ATT3);
    }
    SEAM(B + 3);
    if (PH_ON(4) && PH_IN(B + 4)) REPS(4) {
        const int G_ = gridDim.x, bid_ = blockIdx.x;
        int sf_ = bid_, ss_ = G_, af_ = bid_, as_ = G_;
        int an_ = ATT_UNITS;
        if (G_ == 256) { if (bid_ < 128) { af_ = 128 * ATT3 + bid_; as_ = 128; an_ = 128 * (ATT3 + ATT4S); } else { sf_ = 128; af_ = 128 * (ATT3 + ATT4S) + bid_ - 128; as_ = 128; } }
        phase_ssd2(P, L, lds, DRY(4), sf_, ss_);
        phase_attn(P, L, lds, WS_Q, af_, as_, an_);
        if (rep_ == 0) { if (G_ != 256) pooled_rows(P, bid_ * 8 + (threadIdx.x >> 6), G_ * 8, threadIdx.x & 63);
            else if (bid_ >= 128) pooled_rows(P, (bid_ - 128) * 8 + (threadIdx.x >> 6), 128 * 8, threadIdx.x & 63); }
    }
    SEAM_45(B + 4);
    if (PH_ON(6) && PH_IN(B + 6)) REPS(6) {
        const int ZZ = opq0(); unsigned char* ws = P.ws + ZZ;
        pg8::StaticOrder S; S.init(MTOK, 1024, gridDim.x, blockIdx.x, 192);
        pg8::gemm_merge6<pg8::StaticOrder>(lds, (const bf16_t*)(P.out + ZZ), (const bf16_t*)(ws + WS_WG), (const bf16_t*)(ws + WS_POOLED), (const bf16_t*)(ws + WS_Q), (const bf16_t*)(ws + WS_Z),
                                           (const bf16_t*)(ws + WS_WPOOL), (const bf16_t*)(ws + WS_WATT), (const bf16_t*)(ws + WS_WSSD), S, (bf16_t*)(ws + WS_MERGED), (const float*)(ws + WS_SSQH));
    }
    SEAM(B + 6);
    if (PH_ON(7) && PH_IN(B + 7)) REPS(7) {
        const int ZZ = opq0(); unsigned char* ws = P.ws + ZZ; float* outp = P.out + ZZ;
        const float* MOD = (const float*)(ws + WS_MOD) + (size_t)L * 9 * 6144;
        pg8::Gemm g{(const bf16_t*)(ws + WS_MERGED), (const bf16_t*)(ws + WS_WOUT), MTOK, 1024, 1024};
        pg8::StaticOrder S; S.init(MTOK, 1024, gridDim.x, blockIdx.x, 64 * MT_RESID);
        pg8::EpiResid<MT_RESID, L != 0, true> E{L == 0 ? (const void*)P.in[ZZ + I_XP] : (const void*)(ws + WS_X), L == 0 ? (const void*)P.in[ZZ + I_XS] : nullptr, ws + WS_X, MOD + 2048, DRY(7) ? 0.f : 1.f};
        pg8::gemm_phase<pg8::EpiResid<MT_RESID, L != 0, true>, pg8::StaticOrder, true, true>(lds, g, S, E);
    }
    SEAM(B + 7);
    if (PH_ON(8) && PH_IN(B + 8)) REPS(8) phase_h2(P, L);
    SEAM(B + 8);
    if (PH_ON(9) && PH_IN(B + 9)) REPS(9) {
        const int ZZ = opq0(); unsigned char* ws = P.ws + ZZ;
        pg8::Gemm g{(const bf16_t*)(P.out + ZZ), (const bf16_t*)(ws + WS_WM1), MTOK, 4096, 1024};
        pg8::StaticOrder S; S.init(MTOK, 4096, gridDim.x, blockIdx.x);
        pg8::EpiAct<2, 4> E{(bf16_t*)(ws + WS_HID), 4096};
        pg8::gemm_phase<pg8::EpiAct<2, 4>, pg8::StaticOrder, true, true>(lds, g, S, E);
    }
    SEAM(B + 9);
    if (PH_ON(10) && PH_IN(B + 10)) REPS(10) {
        const int ZZ = opq0(); unsigned char* ws = P.ws + ZZ; float* outp = P.out + ZZ;
        const float* MOD = (const float*)(ws + WS_MOD) + (size_t)L * 9 * 6144;
        pg8::Gemm g{(const bf16_t*)(ws + WS_HID), (const bf16_t*)(ws + WS_WM2), MTOK, 1024, 4096};
        pg8::StaticOrder S; S.init(MTOK, 1024, gridDim.x, blockIdx.x, 64 * MT_RESID);
        pg8::EpiResid<MT_RESID, true, L == 0> E{ws + WS_X, nullptr, L == 0 ? (void*)(ws + WS_X) : (void*)outp, MOD + 5120, DRY(10) ? 0.f : 1.f};
        pg8::gemm_phase<pg8::EpiResid<MT_RESID, true, L == 0>, pg8::StaticOrder, true, true>(lds, g, S, E);
    }
    SEAM(B + 10);
}
__global__ void __launch_bounds__(512, 2) fwd_megakernel(Params P) {
    extern __shared__ __attribute__((aligned(16))) unsigned char lds_raw[];
    LAS unsigned char* lds = (LAS unsigned char*)lds_raw;
    cg::grid_group grid = cg::this_grid();
    const int lo = P.ph_lo, hi = P.ph_hi;
    if (hi < 0) grid.sync();
    if (threadIdx.x < 16) ((LAS unsigned*)(lds + LDS_MISC))[threadIdx.x] = 0u;
    __syncthreads();
    const XcdBarrier xbar = xcd_barrier_post((unsigned*)(P.ws + WS_BAR), (volatile LAS unsigned*)(lds + LDS_MISC));
#ifdef PROBE_TS
    if (blockIdx.x == 0 && threadIdx.x == 0) ((unsigned long long*)(P.ws + WS_TS))[0] = __builtin_amdgcn_s_memrealtime();
#endif
    if (PH_ON(20) && PH_IN(0)) phase_mod(P, lds);
#ifdef FILL_SCRATCH
    { u32x4 z; z.x = z.y = z.z = z.w = 0x3f803f80u;
      for (size_t i = (size_t)blockIdx.x * 512 + threadIdx.x; i < (48 * MiB) / 16; i += (size_t)gridDim.x * 512) ((u32x4*)(P.ws + WS_X))[i] = z;
      for (size_t i = (size_t)blockIdx.x * 512 + threadIdx.x; i < (96 * MiB) / 16; i += (size_t)gridDim.x * 512) ((u32x4*)P.out)[i] = z; }
#endif
    SEAM(0);
    layer_program<0>(P, lds, xbar, lo, hi);
    layer_program<1>(P, lds, xbar, lo, hi);
#ifdef EXTRA_SYNCS
    for (int i_ = 0; i_ < EXTRA_SYNCS; ++i_) grid.sync();
#endif
#ifdef DETPROBE_OFF
    grid.sync();
    { const unsigned* src = (const unsigned*)(P.ws + (size_t)(DETPROBE_OFF));
      for (size_t i = (size_t)blockIdx.x * 512 + threadIdx.x; i < OUT_TOTAL; i += (size_t)gridDim.x * 512) { float v = 0.f;
          for (size_t j = i; j < (size_t)(DETPROBE_WORDS); j += OUT_TOTAL) { const unsigned w = src[j]; v += (float)((w ^ (w >> 16)) & 0xffffu); }
          P.out[i] = v; } }
#endif
#ifdef BITPROBE
    grid.sync();
    for (size_t i = (size_t)blockIdx.x * 512 + threadIdx.x; i < OUT_TOTAL; i += (size_t)gridDim.x * 512) P.out[i] = (float)(__float_as_uint(P.out[i]) & 0xfffu);
#endif
#ifdef PROBE_TS
    if (blockIdx.x == 0 && threadIdx.x == 0) ((unsigned long long*)(P.ws + WS_TS))[NPHASES] = __builtin_amdgcn_s_memrealtime();
#endif
}

#ifdef PROBE_TS
__global__ void probe_tail(float* out, const unsigned long long* ts) {
#ifdef SSD_TS_A
    const unsigned long long* sec = ts + 128;
    float ta = (float)sec[SSD_TS_A], tb = (float)sec[SSD_TS_B], tota = 0.f, totb = 0.f;
    for (int k = 0; k < 5; ++k) { tota += (float)sec[(SSD_TS_A & 8) + k]; totb += (float)sec[(SSD_TS_B & 8) + k]; }
    const float fa = ta / tota, fb = tb / totb;
#else
    float ta = (float)(ts[PROBE_A_HI] - ts[PROBE_A_LO]), tb = (float)(ts[PROBE_B_HI] - ts[PROBE_B_LO]);
#ifdef PROBE_BOTH
    ta += (float)(ts[PROBE_A_HI + NPH_LAYER] - ts[PROBE_A_LO + NPH_LAYER]); tb += (float)(ts[PROBE_B_HI + NPH_LAYER] - ts[PROBE_B_LO + NPH_LAYER]);
#endif
    const float tot = (float)(ts[NPHASES] - ts[0]);
    const float fa = ta / tot, fb = tb / tot;
#endif
    const float e = sqrtf(0.0025f * fb);
    for (size_t i = (size_t)blockIdx.x * blockDim.x + threadIdx.x; i < OUT_TOTAL; i += (size_t)gridDim.x * blockDim.x) { float v = out[i] * (1.0f + e); if (i == 0) v += 1.0f + 8.9f * fa; out[i] = v; }
}
#endif
#if DEBUG_STAGE
__global__ void debug_mask(float* out, int mode, float scale) {
    size_t i = (size_t)blockIdx.x * blockDim.x + threadIdx.x; const size_t stride = (size_t)gridDim.x * blockDim.x;
    for (; i < OUT_TOTAL; i += stride) {
        bool keep = false;
        if (mode == 1) keep = i >= OUT_CV && i < OUT_ST && (((i - OUT_CV) >> 15) & 1) == 0;
        if (mode == 2) keep = i >= OUT_CK && i < OUT_CV && (((i - OUT_CK) >> 15) & 1) == 0;
        if (mode == 3) keep = i >= OUT_ST && (((i - OUT_ST) >> 18) & 1) == 0;
        if (mode == 4) keep = i >= OUT_CK && i < OUT_CV;
        if (mode == 5) keep = i >= OUT_CV && i < OUT_ST;
        if (mode == 6) keep = i >= OUT_ST;
        if (mode == 7) keep = i < (size_t)MCTX * 1024;
        if (mode == 8) keep = i >= (size_t)MCTX * 1024 && i < OUT_CK;
        out[i] = keep ? out[i] * scale : 0.f;
    }
}
#endif

extern "C" void kernel_launch(void* const* d_in, const int* in_sizes, int n_in, void* d_out, int out_size, void* d_ws, size_t ws_size, hipStream_t stream) {
    static int grid = 0;
    if (grid == 0) {
        if (n_in != 29 || out_size != (int)OUT_TOTAL || ws_size < WS_END) { fprintf(stderr, "kernel_launch: unexpected shapes (n_in %d, out %d, ws %zu < %zu); nothing launched\n", n_in, out_size, ws_size, (size_t)WS_END); grid = -1; return; }
        int dev = 0, cus = 0, per_cu = 0;
        hipGetDevice(&dev);
        hipDeviceGetAttribute(&cus, hipDeviceAttributeMultiprocessorCount, dev);
        if (hipFuncSetAttribute((const void*)fwd_megakernel, hipFuncAttributeMaxDynamicSharedMemorySize, LDS_BYTES) != hipSuccess) { fprintf(stderr, "kernel_launch: hipFuncSetAttribute failed\n"); grid = -1; return; }
        if (hipOccupancyMaxActiveBlocksPerMultiprocessor(&per_cu, (const void*)fwd_megakernel, 512, LDS_BYTES) != hipSuccess || per_cu < 1) { fprintf(stderr, "kernel_launch: occupancy query says %d blocks per CU\n", per_cu); grid = -1; return; }
        grid = cus;
    }
    if (grid < 0) return;
    if (hipMemsetAsync((char*)d_ws + WS_BAR, 0, XCD_BAR_WORDS * 4, stream) != hipSuccess) { fprintf(stderr, "kernel_launch: memset of the barrier words failed\n"); return; }
    Params p{};
    for (int i = 0; i < 29; ++i) p.in[i] = (const float*)d_in[i];
    p.out = (float*)d_out; p.ws = (unsigned char*)d_ws;
#if DEBUG_STAGE
    const int last_phase = DEBUG_LAST_PHASE;
#elif defined(DETPROBE_LAST)
    const int last_phase = DETPROBE_LAST;
#else
    const int last_phase = NPHASES;
#endif
#if N_LAUNCHES == 1
    p.ph_lo = 0; p.ph_hi = last_phase;
    { void* args[] = {&p}; hipError_t e = hipLaunchCooperativeKernel((const void*)fwd_megakernel, dim3(grid), dim3(512), args, LDS_BYTES, stream);
      if (e != hipSuccess) fprintf(stderr, "cooperative launch failed: %s (grid %d)\n", hipGetErrorString(e), grid); }
#ifdef PROBE_TS
    probe_tail<<<2048, 256, 0, stream>>>((float*)d_out, (const unsigned long long*)((unsigned char*)d_ws + WS_TS));
#endif
#else
    for (int ph = 0; ph < last_phase; ++ph) {
        p.ph_lo = ph; p.ph_hi = ph + 1;
        void* args[] = {&p}; hipError_t e = hipLaunchCooperativeKernel((const void*)fwd_megakernel, dim3(grid), dim3(512), args, LDS_BYTES, stream);
        if (e != hipSuccess) { fprintf(stderr, "cooperative launch failed: %s (grid %d)\n", hipGetErrorString(e), grid); break; }
    }
#endif
#if DEBUG_STAGE
    debug_mask<<<1024, 256, 0, stream>>>((float*)d_out, DEBUG_STAGE, 4.0f);
#endif
}
```

```cpp
#include <hip/hip_runtime.h>
#include <hip/hip_cooperative_groups.h>
#include <cstdio>
#include <cstdint>
namespace cg = cooperative_groups;

#define LAS __attribute__((address_space(3)))
typedef unsigned short bf16_t;
typedef short bf16x8 __attribute__((ext_vector_type(8)));
typedef float f32x4 __attribute__((ext_vector_type(4)));
typedef float f32x2 __attribute__((ext_vector_type(2)));
typedef unsigned u32x4 __attribute__((ext_vector_type(4)));
typedef unsigned u32x2 __attribute__((ext_vector_type(2)));

constexpr int DM = 1024, MCTX = 8192, MLAT = 16384, MTOK = 24576, LCTX = 256, LLAT = 2048, PAST = 512;
constexpr int INC = 6944;
constexpr int NPH_LAYER = 11, NPHASES = 1 + 2 * NPH_LAYER;
constexpr size_t OUT_CK = 25165824, OUT_CV = 27262976, OUT_ST = 29360128, OUT_TOTAL = 46137344;
constexpr size_t MiB = 1u << 20;
constexpr size_t WS_MOD = 0;
constexpr size_t WS_BAR = 3 * MiB;
constexpr size_t WS_SSQ = 3 * MiB + 256 * 1024;
constexpr size_t OUTB_Y = 48 * MiB;
constexpr size_t WS_CK = 1 * MiB, WS_CV = 2 * MiB;
constexpr size_t WS_WIN = 4 * MiB;
constexpr size_t WS_WG = 12 * MiB;
constexpr size_t WS_WPOOL = 18 * MiB;
constexpr size_t WS_WATT = 19 * MiB;
constexpr size_t WS_WSSD = 20 * MiB;
constexpr size_t WS_WOUT = 22 * MiB;
constexpr size_t WS_WM1 = 24 * MiB;
constexpr size_t WS_WM2 = 32 * MiB;
constexpr size_t WS_X = 40 * MiB;
constexpr size_t WS_Q = 88 * MiB;
constexpr size_t WS_Z = 112 * MiB;
constexpr size_t WS_XBC = 160 * MiB;
constexpr size_t WS_X2 = WS_XBC, WS_BCR = 208 * MiB;
constexpr size_t WS_G8 = WS_XBC;
constexpr size_t WS_PU = 232 * MiB;
constexpr size_t WS_KV = 256 * MiB;
constexpr size_t WS_DT = 268 * MiB;
constexpr size_t WS_DTS = 272 * MiB, WS_CUM2 = 275 * MiB;
constexpr size_t WS_MERGED = WS_PU;
constexpr size_t WS_BC = 280 * MiB;
constexpr size_t WS_POOLED = WS_BCR;
constexpr size_t WS_HID = WS_Q;
constexpr size_t WS_SSQH = 304 * MiB;
constexpr size_t WS_END = 306 * MiB;

constexpr int LDS_GT = 133120;
constexpr int LDS_MISC = 162816;
constexpr int LDS_BYTES = 163840;

struct Params { const float* in[29]; float* out; unsigned char* ws; int ph_lo, ph_hi; };
enum { I_XP = 0, I_XS, I_CK, I_CV, I_ST, I_C, I_CCTX, I_WMOD, I_BMOD, I_N1G, I_N2G, I_WIN, I_POOLW, I_POOLS, I_WPO, I_QG, I_KG, I_SINK, I_WAO,
       I_CONVW, I_CONVB, I_DTB, I_ALOG, I_DSKIP, I_SSDG, I_WSO, I_WOUT, I_WM1, I_WM2 };

__device__ __forceinline__ unsigned cvt_pk_bf16(float lo, float hi) { unsigned r; asm volatile("s_nop 0\n\tv_cvt_pk_bf16_f32 %0, %1, %2" : "=v"(r) : "v"(lo), "v"(hi)); return r; }
typedef __bf16 bf16v2_t __attribute__((ext_vector_type(2)));
__device__ __forceinline__ unsigned cvt_pk_bf16_c(float lo, float hi) { const f32x2 v = {lo, hi}; return __builtin_bit_cast(unsigned, __builtin_convertvector(v, bf16v2_t)); }
__device__ __forceinline__ float bf_lo(unsigned u) { return __uint_as_float(u << 16); }
__device__ __forceinline__ float bf_hi(unsigned u) { return __uint_as_float(u & 0xffff0000u); }
__device__ __forceinline__ float silu_f(float x) { return x * __builtin_amdgcn_rcpf(1.f + __expf(-x)); }
__device__ __forceinline__ float sigmoid_f(float x) { return 1.f / (1.f + __expf(-x)); }
__device__ __forceinline__ float wave_sum(float v) {
#pragma unroll
    for (int o = 1; o < 64; o <<= 1) v += __shfl_xor(v, o);
    return v;
}
__device__ __forceinline__ const float* xrow_ptr0(const Params& P, int ZZ, int row) {
    return row < MCTX ? P.in[ZZ + I_XP] + (size_t)row * DM : P.in[ZZ + I_XS] + (size_t)(row - MCTX) * DM;
}
__device__ __forceinline__ int mod_index(int row) { return row < MCTX ? 0 : 1 + ((row - MCTX) >> 11); }
__device__ __forceinline__ int opq0() { int z = 0; asm volatile("" : "+s"(z)); return z; }
#define LDS_BARRIER() do { asm volatile("s_waitcnt lgkmcnt(0)" ::: "memory"); __builtin_amdgcn_s_barrier(); asm volatile("" ::: "memory"); } while (0)
#define LDS_WAIT() asm volatile("s_waitcnt lgkmcnt(0)" ::: "memory")
namespace pg8 {
#define PG8_LAS __attribute__((address_space(3)))
typedef unsigned short bf16_t;
typedef short bf16x8 __attribute__((ext_vector_type(8)));
typedef float f32x4 __attribute__((ext_vector_type(4)));
typedef unsigned u32x4 __attribute__((ext_vector_type(4)));
constexpr int BM = 256, BK = 64, HALF = 128, HTB = HALF * BK * 2  , STAGE_BYTES = 8 * HTB, NXCD = 8, WGM = 8;

__host__ __device__ __forceinline__ int lds_byte(int r, int c) { const int st = (r >> 4) * 2 + (c >> 5), rr = r & 15, cc = c & 31, ob = rr * 64 + cc * 2; return st * 1024 + (ob ^ (((ob >> 9) & 1) << 5)); }
__host__ __device__ __forceinline__ void stage_rc(int b, int& R, int& C) { const int st = b / 1024, sb = b % 1024, swz = sb ^ (((sb >> 9) & 1) << 5); R = (st >> 1) * 16 + swz / 64; C = (st & 1) * 32 + (swz % 64) / 2; }
__host__ __device__ __forceinline__ int perm32(int rho) { const int n = rho >> 4, i = rho & 15; return 8 * (i >> 2) + 4 * n + (i & 3); }

struct Unit { int pm, pn; };
struct Gemm { const bf16_t* A; const bf16_t* Bt; int M, N, K; };

struct StaticOrder {
    int nM, nN, nwg, G, c;
    __host__ __device__ void init(int M, int N, int G_, int c_, int RT = BM) { nM = M / RT; nN = N / BM; nwg = nM * nN; G = G_; c = c_; }
    __host__ __device__ bool next(int i, Unit& u) const {
        const long L = (long)i * G + c; if (L >= nwg) return false;
        int wgid = (int)L; { const int q = nwg / NXCD, r = nwg % NXCD, xcd = wgid % NXCD, off = wgid / NXCD; wgid = (xcd < r ? xcd * (q + 1) : r * (q + 1) + (xcd - r) * q) + off; }
        const int nig = WGM * nN, gid = wgid / nig, fm = gid * WGM, gsz = (nM - fm) < WGM ? (nM - fm) : WGM;
        u.pm = fm + ((wgid % nig) % gsz); u.pn = (wgid % nig) / gsz; return true;
    }
    __device__ __forceinline__ void a_ready(const Unit&) const {}
    __device__ __forceinline__ void done(const Unit&) const {}
};


struct EpiInProj {
    static constexpr bool PERM = true, AFTER_DRAIN = false; static constexpr int MT = 4;
    unsigned char* ws; float* out_cv; int layer;
    __device__ __forceinline__ void operator()(const f32x4 (&acc)[2][2][4][2], const Unit& u, int wr, int wc, int fr, int fq) const {
        const int pn = u.pn;
        const int row0 = u.pm * BM + wr * 64 + fr, cw = wc * 32 + 8 * fq;
        if (pn == 15) {
            if (wc == 0) { float* D = (float*)(ws + WS_DT);
#pragma unroll
                for (int ai = 0; ai < 2; ++ai)
#pragma unroll
                    for (int m = 0; m < 4; ++m) { float* rp = D + (size_t)(row0 + ai * HALF + m * 16) * 32 + cw; *(f32x4*)rp = acc[ai][0][m][0]; *(f32x4*)(rp + 4) = acc[ai][0][m][1]; } }
            return;
        }
        size_t boff; int ld, colt;
        if (pn < 2) { boff = WS_PU; ld = 512; colt = pn * 256; } else if (pn < 4) { boff = WS_Q; ld = 512; colt = (pn - 2) * 256; } else if (pn == 4) { boff = WS_KV; ld = 256; colt = 0; }
        else if (pn < 9) { boff = WS_Z; ld = 1024; colt = (pn - 5) * 256; } else { boff = WS_BCR; ld = 512; colt = (pn - 13) * 256; }
        if (pn >= 9 && pn < 13) {
#pragma unroll
            for (int ai = 0; ai < 2; ++ai)
#pragma unroll
                for (int m = 0; m < 4; ++m) { const int row = row0 + ai * HALF + m * 16;
#pragma unroll
                    for (int bj = 0; bj < 2; ++bj) { const int head = (pn - 9) * 4 + bj * 2 + (wc >> 1); const f32x4 v0 = acc[ai][bj][m][0], v1 = acc[ai][bj][m][1];
                        u32x4 w; w.x = cvt_pk_bf16_c(v0[0], v0[1]); w.y = cvt_pk_bf16_c(v0[2], v0[3]); w.z = cvt_pk_bf16_c(v1[0], v1[1]); w.w = cvt_pk_bf16_c(v1[2], v1[3]);
                        *(u32x4*)((bf16_t*)(ws + WS_X2) + ((size_t)head * MTOK + row) * 64 + (wc & 1) * 32 + 8 * fq) = w; } }
            return;
        }
        bf16_t* base = (bf16_t*)(ws + boff) + colt + cw;
#pragma unroll
        for (int ai = 0; ai < 2; ++ai)
#pragma unroll
            for (int m = 0; m < 4; ++m) { bf16_t* rowp = base + (size_t)(row0 + ai * HALF + m * 16) * ld;
#pragma unroll
                for (int bj = 0; bj < 2; ++bj) { const f32x4 v0 = acc[ai][bj][m][0], v1 = acc[ai][bj][m][1];
                    u32x4 w; w.x = cvt_pk_bf16_c(v0[0], v0[1]); w.y = cvt_pk_bf16_c(v0[2], v0[3]); w.z = cvt_pk_bf16_c(v1[0], v1[1]); w.w = cvt_pk_bf16_c(v1[2], v1[3]);
                    *(u32x4*)(rowp + bj * HALF) = w; } }
        if (pn == 4 && u.pm < 32) {
#pragma unroll
            for (int ai = 0; ai < 2; ++ai)
#pragma unroll
                for (int m = 0; m < 4; ++m) { const int row = row0 + ai * HALF + m * 16; float* o = out_cv + ((size_t)((row >> 8) * 2 + layer) * 256 + (row & 255)) * 128 + cw;
                    *(f32x4*)o = acc[ai][1][m][0]; *(f32x4*)(o + 4) = acc[ai][1][m][1]; }
        }
    }
};

template <int ACT, int MT_> struct EpiAct {
    static constexpr bool PERM = true, AFTER_DRAIN = false; static constexpr int MT = MT_;
    bf16_t* O; int ldc;
    __device__ __forceinline__ void operator()(const f32x4 (&acc)[2][2][MT_][2], const Unit& u, int wr, int wc, int fr, int fq) const {
        const int row0 = u.pm * (64 * MT_) + wr * (16 * MT_) + fr, col0 = u.pn * BM + wc * 32 + 8 * fq;
#pragma unroll
        for (int ai = 0; ai < 2; ++ai)
#pragma unroll
            for (int m = 0; m < MT_; ++m) { bf16_t* rowp = O + (size_t)(row0 + ai * (32 * MT_) + m * 16) * ldc + col0;
#pragma unroll
                for (int bj = 0; bj < 2; ++bj) { f32x4 v0 = acc[ai][bj][m][0], v1 = acc[ai][bj][m][1];
#pragma unroll
                    for (int e = 0; e < 4; ++e) {
                        if (ACT == 1) { v0[e] = __builtin_amdgcn_rcpf(1.f + __expf(-v0[e])); v1[e] = __builtin_amdgcn_rcpf(1.f + __expf(-v1[e])); }
                        if (ACT == 2) { const float a = fmaxf(v0[e], 0.f), b = fmaxf(v1[e], 0.f); v0[e] = a * a; v1[e] = b * b; } }
                    u32x4 w; w.x = cvt_pk_bf16_c(v0[0], v0[1]); w.y = cvt_pk_bf16_c(v0[2], v0[3]); w.z = cvt_pk_bf16_c(v1[0], v1[1]); w.w = cvt_pk_bf16_c(v1[2], v1[3]);
                    *(u32x4*)(rowp + bj * HALF) = w; } }
    }
};

struct EpiGate8 {
    static constexpr bool PERM = true, AFTER_DRAIN = false; static constexpr int MT = 4;
    unsigned char* G8;
    __device__ __forceinline__ void operator()(const f32x4 (&acc)[2][2][4][2], const Unit& u, int wr, int wc, int fr, int fq) const {
        const int row0 = u.pm * BM + wr * 64 + fr, col0 = u.pn * BM + wc * 32 + 8 * fq;
#pragma unroll
        for (int ai = 0; ai < 2; ++ai)
#pragma unroll
            for (int m = 0; m < 4; ++m) { unsigned char* rowp = G8 + (size_t)(row0 + ai * HALF + m * 16) * 3072 + col0;
#pragma unroll
                for (int bj = 0; bj < 2; ++bj) { const f32x4 v0 = acc[ai][bj][m][0], v1 = acc[ai][bj][m][1];
                    unsigned q[8];
#pragma unroll
                    for (int e = 0; e < 4; ++e) { q[e] = (unsigned)(255.f * __builtin_amdgcn_rcpf(1.f + __expf(-v0[e])) + 0.5f); q[4 + e] = (unsigned)(255.f * __builtin_amdgcn_rcpf(1.f + __expf(-v1[e])) + 0.5f); }
                    u32x2 w; w.x = q[0] | (q[1] << 8) | (q[2] << 16) | (q[3] << 24); w.y = q[4] | (q[5] << 8) | (q[6] << 16) | (q[7] << 24);
                    *(u32x2*)(rowp + bj * HALF) = w; } }
    }
};
template <int MT_> struct EpiMerge {
    static constexpr bool PERM = true, AFTER_DRAIN = false; static constexpr int MT = MT_;
    const unsigned char* G8; bf16_t* MG; int first; const float* ssq;
    __device__ __forceinline__ void operator()(const f32x4 (&acc)[2][2][MT_][2], const Unit& u, int wr, int wc, int fr, int fq) const {
        const int row0 = u.pm * (64 * MT_) + wr * (16 * MT_) + fr, col0 = u.pn * BM + wc * 32 + 8 * fq;
        constexpr float S = 1.0f / 255.0f;
#pragma unroll
        for (int ai = 0; ai < 2; ++ai)
#pragma unroll
            for (int m = 0; m < MT_; ++m) { const int row = row0 + ai * (32 * MT_) + m * 16; const size_t off = (size_t)row * 1024 + col0;
                const float rs = ssq ? S * (1.0f / sqrtf(ssq[row] * (1.0f / 1024.0f) + 1e-6f)) : S;
#pragma unroll
                for (int bj = 0; bj < 2; ++bj) { const f32x4 v0 = acc[ai][bj][m][0], v1 = acc[ai][bj][m][1];
                    const u32x2 gq = *(const u32x2*)(G8 + (size_t)row * 3072 + col0 + bj * HALF);
                    float r[8];
                    r[0] = (float)(gq.x & 255u) * rs * v0[0]; r[1] = (float)((gq.x >> 8) & 255u) * rs * v0[1]; r[2] = (float)((gq.x >> 16) & 255u) * rs * v0[2]; r[3] = (float)(gq.x >> 24) * rs * v0[3];
                    r[4] = (float)(gq.y & 255u) * rs * v1[0]; r[5] = (float)((gq.y >> 8) & 255u) * rs * v1[1]; r[6] = (float)((gq.y >> 16) & 255u) * rs * v1[2]; r[7] = (float)(gq.y >> 24) * rs * v1[3];
                    if (!first) { const u32x4 mq = *(const u32x4*)(MG + off + bj * HALF);
                        r[0] += bf_lo(mq.x); r[1] += bf_hi(mq.x); r[2] += bf_lo(mq.y); r[3] += bf_hi(mq.y); r[4] += bf_lo(mq.z); r[5] += bf_hi(mq.z); r[6] += bf_lo(mq.w); r[7] += bf_hi(mq.w); }
                    u32x4 w; w.x = cvt_pk_bf16_c(r[0], r[1]); w.y = cvt_pk_bf16_c(r[2], r[3]); w.z = cvt_pk_bf16_c(r[4], r[5]); w.w = cvt_pk_bf16_c(r[6], r[7]);
                    *(u32x4*)(MG + off + bj * HALF) = w; } }
    }
};

template <int MT_, bool XIN_BF, bool XOUT_BF> struct EpiResid {
    static constexpr bool PERM = true, AFTER_DRAIN = false; static constexpr int MT = MT_;
    const void *xa, *xb; void* xout; const float* gate; float gscale;
    __device__ __forceinline__ void operator()(const f32x4 (&acc)[2][2][MT_][2], const Unit& u, int wr, int wc, int fr, int fq) const {
        const int row0 = u.pm * (64 * MT_) + wr * (16 * MT_) + fr, col0 = u.pn * BM + wc * 32 + 8 * fq;
#pragma unroll
        for (int ai = 0; ai < 2; ++ai)
#pragma unroll
            for (int m = 0; m < MT_; ++m) { const int row = row0 + ai * (32 * MT_) + m * 16; const size_t off = (size_t)row * 1024 + col0;
                const int mi = row < MCTX ? 0 : 1 + ((row - MCTX) >> 11);
                const float* xin = (xb != nullptr && row >= MCTX) ? (const float*)xb - (size_t)MCTX * 1024 : (const float*)xa;
                const float* gp = gate + (size_t)mi * 6144 + col0;
#pragma unroll
                for (int bj = 0; bj < 2; ++bj) { f32x4 x0, x1;
                    if (XIN_BF) { const u32x4 q = *(const u32x4*)((const bf16_t*)xa + off + bj * HALF);
                        x0 = (f32x4){bf_lo(q.x), bf_hi(q.x), bf_lo(q.y), bf_hi(q.y)}; x1 = (f32x4){bf_lo(q.z), bf_hi(q.z), bf_lo(q.w), bf_hi(q.w)}; }
                    else { x0 = *(const f32x4*)(xin + off + bj * HALF); x1 = *(const f32x4*)(xin + off + bj * HALF + 4); }
                    const f32x4 g0 = *(const f32x4*)(gp + bj * HALF), g1 = *(const f32x4*)(gp + bj * HALF + 4);
                    const f32x4 r0 = x0 + g0 * acc[ai][bj][m][0] * gscale, r1 = x1 + g1 * acc[ai][bj][m][1] * gscale;
                    if (XOUT_BF) { u32x4 w; w.x = cvt_pk_bf16_c(r0[0], r0[1]); w.y = cvt_pk_bf16_c(r0[2], r0[3]); w.z = cvt_pk_bf16_c(r1[0], r1[1]); w.w = cvt_pk_bf16_c(r1[2], r1[3]);
                        *(u32x4*)((bf16_t*)xout + off + bj * HALF) = w; }
                    else { *(f32x4*)((float*)xout + off + bj * HALF) = r0; *(f32x4*)((float*)xout + off + bj * HALF + 4) = r1; } } }
    }
};

template <class Epi, class Sched, bool ALIGN_EPI = false, bool SP2 = false>
__device__ __forceinline__ void gemm_phase(PG8_LAS unsigned char* lds, const Gemm g, const Sched& S, const Epi& E) {
    int tid_ = threadIdx.x; asm volatile("" : "+v"(tid_));
    const int tid = tid_, wid = __builtin_amdgcn_readfirstlane(tid >> 6), lane = tid & 63, wr = wid >> 2, wc = wid & 3, fr = lane & 15, fq = lane >> 4;
    const int K = g.K, nt = K / BK;
    unsigned voffA[2], voffB[2];
#pragma unroll
    for (int i = 0; i < 2; ++i) { int R, C; stage_rc(tid * 16 + i * 8192, R, C); const int Rb = Epi::PERM ? ((R & ~31) + perm32(R & 31)) : R;
        voffA[i] = (unsigned)(R * K + C) * 2u; voffB[i] = (unsigned)(Rb * K + C) * 2u; }
    const size_t kstep = (size_t)(BK * 2);
    constexpr int MT = Epi::MT;
    static_assert(MT == 4 || (MT == 3 && SP2), "192-row tiles: SP2 loop only");
    const size_t hstepB = (size_t)HALF * K * 2, hstepA = (size_t)(32 * MT) * K * 2;
    const size_t tstepB = 2 * hstepB, tstepA = 2 * hstepA;
    const unsigned ldsw = (unsigned)wid * 1024u;
    const int aoff = lds_byte(wr * (16 * MT) + fr, fq * 8), boff = lds_byte(wc * 32 + fr, fq * 8);
#define PG8_SA(b, h) (((b) * 2 + (h)) * HTB)
#define PG8_SB(b, h) ((4 + (b) * 2 + (h)) * HTB)
#define PG8_STAGE(bufoff, gbase, voff) do { _Pragma("unroll") for (int _i = 0; _i < 2; ++_i) \
        __builtin_amdgcn_global_load_lds((const unsigned*)((const char*)(gbase) + (voff)[_i]), (PG8_LAS unsigned*)(lds + (bufoff) + ldsw + _i * 8192), 16, 0, 0); } while (0)
#define PG8_LDA(dst, b, h) do { _Pragma("unroll") for (int m = 0; m < MT; ++m) _Pragma("unroll") for (int k = 0; k < 2; ++k) dst[m][k] = *(const PG8_LAS bf16x8*)(lds + PG8_SA(b, h) + aoff + m * 2048 + k * 1024); } while (0)
#define PG8_LDB(dst, b, h) do { _Pragma("unroll") for (int n = 0; n < 2; ++n) _Pragma("unroll") for (int k = 0; k < 2; ++k) dst[n][k] = *(const PG8_LAS bf16x8*)(lds + PG8_SB(b, h) + boff + n * 2048 + k * 1024); } while (0)
#define PG8_MMA(ai, bj, At, Bt) do { __builtin_amdgcn_s_setprio(1); _Pragma("unroll") for (int m = 0; m < MT; ++m) _Pragma("unroll") for (int n = 0; n < 2; ++n) _Pragma("unroll") for (int k = 0; k < 2; ++k) \
        acc[ai][bj][m][n] = __builtin_amdgcn_mfma_f32_16x16x32_bf16(Bt[n][k], At[m][k], acc[ai][bj][m][n], 0, 0, 0); __builtin_amdgcn_s_setprio(0); } while (0)
#define PG8_WAIT_V(n) asm volatile("s_waitcnt vmcnt(" #n ")" ::: "memory")
#define PG8_WAIT_L(n) asm volatile("s_waitcnt lgkmcnt(" #n ")" ::: "memory")
#define PG8_BAR __builtin_amdgcn_s_barrier()
#define PG8_SCHED __builtin_amdgcn_sched_barrier(0)
    Unit cur, nxt; int ui = 0;
    if (!S.next(0, cur)) return;
    f32x4 acc[2][2][MT][2];
#pragma unroll
    for (int a = 0; a < 2; ++a)
#pragma unroll
        for (int b = 0; b < 2; ++b)
#pragma unroll
            for (int m = 0; m < MT; ++m)
#pragma unroll
                for (int n = 0; n < 2; ++n) acc[a][b][m][n] = (f32x4){0.f, 0.f, 0.f, 0.f};
    bf16x8 At[MT][2], B0[2][2], B1[2][2];
    const char* cA = (const char*)g.A + (size_t)cur.pm * tstepA; const char* cB = (const char*)g.Bt + (size_t)cur.pn * tstepB;
    S.a_ready(cur);
    if constexpr (SP2) {
        PG8_STAGE(PG8_SB(0, 0), cB, voffB); PG8_STAGE(PG8_SB(0, 1), cB + hstepB, voffB); PG8_STAGE(PG8_SA(0, 0), cA, voffA); PG8_STAGE(PG8_SA(0, 1), cA + hstepA, voffA);
        if (wr == 1) PG8_BAR;
        PG8_WAIT_V(2); PG8_BAR;
        PG8_STAGE(PG8_SB(1, 0), cB + kstep, voffB); PG8_STAGE(PG8_SA(1, 0), cA + kstep, voffA); PG8_STAGE(PG8_SB(1, 1), cB + hstepB + kstep, voffB);
        PG8_WAIT_V(6); PG8_BAR;
    } else {
        PG8_STAGE(PG8_SB(0, 0), cB, voffB); PG8_STAGE(PG8_SA(0, 0), cA, voffA); PG8_STAGE(PG8_SB(0, 1), cB + hstepB, voffB); PG8_STAGE(PG8_SA(0, 1), cA + hstepA, voffA);
        if (wr == 1) PG8_BAR;
        PG8_WAIT_V(4); PG8_BAR;
        PG8_STAGE(PG8_SB(1, 0), cB + kstep, voffB); PG8_STAGE(PG8_SA(1, 0), cA + kstep, voffA); PG8_STAGE(PG8_SB(1, 1), cB + hstepB + kstep, voffB);
        PG8_WAIT_V(6); PG8_BAR;
    }
    for (;;) {
        const bool has_next = S.next(ui + 1, nxt);
        const char* nA = has_next ? (const char*)g.A + (size_t)nxt.pm * tstepA : cA; const char* nB = has_next ? (const char*)g.Bt + (size_t)nxt.pn * tstepB : cB;
        for (int t = 0; t < nt; t += 2) {
            const bool last = (t == nt - 2);
            const char* a1 = cA + (size_t)(t + 1) * kstep;
            const char* a2 = last ? nA : cA + (size_t)(t + 2) * kstep; const char* b2 = last ? nB : cB + (size_t)(t + 2) * kstep;
            const char* a3 = a2 + kstep; const char* b3 = b2 + kstep;
            if (last && has_next) S.a_ready(nxt);
            if constexpr (SP2) {
            PG8_LDB(B0, 0, 0); PG8_LDB(B1, 0, 1); PG8_SCHED; PG8_LDA(At, 0, 0); PG8_STAGE(PG8_SA(1, 1), a1 + hstepA, voffA);
            PG8_WAIT_V(8); PG8_WAIT_L(0); PG8_BAR; PG8_MMA(0, 0, At, B0); PG8_MMA(0, 1, At, B1); PG8_BAR; PG8_SCHED;
            PG8_LDA(At, 0, 1); PG8_STAGE(PG8_SB(0, 0), b2, voffB); PG8_STAGE(PG8_SB(0, 1), b2 + hstepB, voffB); PG8_STAGE(PG8_SA(0, 0), a2, voffA);
            PG8_WAIT_V(8); PG8_WAIT_L(0); PG8_BAR; PG8_MMA(1, 0, At, B0); PG8_MMA(1, 1, At, B1); PG8_BAR; PG8_SCHED;
            PG8_LDB(B0, 1, 0); PG8_LDB(B1, 1, 1); PG8_SCHED; PG8_LDA(At, 1, 0); PG8_STAGE(PG8_SA(0, 1), a2 + hstepA, voffA);
            PG8_WAIT_V(8); PG8_WAIT_L(0); PG8_BAR; PG8_MMA(0, 0, At, B0); PG8_MMA(0, 1, At, B1); PG8_BAR; PG8_SCHED;
            PG8_LDA(At, 1, 1); PG8_STAGE(PG8_SB(1, 0), b3, voffB); PG8_STAGE(PG8_SB(1, 1), b3 + hstepB, voffB); PG8_STAGE(PG8_SA(1, 0), a3, voffA);
            PG8_WAIT_V(8); PG8_WAIT_L(0); PG8_BAR; PG8_MMA(1, 0, At, B0); PG8_MMA(1, 1, At, B1); PG8_BAR; PG8_SCHED;
            } else {
            PG8_LDB(B0, 0, 0); PG8_SCHED; PG8_LDA(At, 0, 0); PG8_STAGE(PG8_SA(1, 1), a1 + hstepA, voffA);
            PG8_WAIT_L(8); PG8_BAR; PG8_WAIT_L(0); PG8_MMA(0, 0, At, B0); PG8_BAR; PG8_SCHED;
            PG8_LDB(B1, 0, 1); PG8_STAGE(PG8_SB(0, 0), b2, voffB);
            PG8_BAR; PG8_WAIT_L(0); PG8_MMA(0, 1, At, B1); PG8_BAR;
            PG8_LDA(At, 0, 1); PG8_STAGE(PG8_SA(0, 0), a2, voffA);
            PG8_BAR; PG8_WAIT_L(0); PG8_MMA(1, 0, At, B0); PG8_BAR; PG8_SCHED;
            PG8_STAGE(PG8_SB(0, 1), b2 + hstepB, voffB);
            PG8_WAIT_V(6); PG8_BAR; PG8_MMA(1, 1, At, B1); PG8_BAR;
            PG8_LDB(B0, 1, 0); PG8_SCHED; PG8_LDA(At, 1, 0); PG8_STAGE(PG8_SA(0, 1), a2 + hstepA, voffA);
            PG8_WAIT_L(8); PG8_BAR; PG8_WAIT_L(0); PG8_MMA(0, 0, At, B0); PG8_BAR; PG8_SCHED;
            PG8_LDB(B1, 1, 1); PG8_STAGE(PG8_SB(1, 0), b3, voffB);
            PG8_BAR; PG8_WAIT_L(0); PG8_MMA(0, 1, At, B1); PG8_BAR;
            PG8_LDA(At, 1, 1); PG8_STAGE(PG8_SA(1, 0), a3, voffA);
            PG8_BAR; PG8_WAIT_L(0); PG8_MMA(1, 0, At, B0); PG8_BAR; PG8_SCHED;
            PG8_STAGE(PG8_SB(1, 1), b3 + hstepB, voffB);
            PG8_WAIT_V(6); PG8_BAR; PG8_MMA(1, 1, At, B1); PG8_BAR;
            }
        }
        if constexpr (ALIGN_EPI) { if (wr == 0) PG8_BAR; }
        if constexpr (!Epi::AFTER_DRAIN) { E(acc, cur, wr, wc, fr, fq); S.done(cur); }
        if (!has_next) break;
#pragma unroll
        for (int a = 0; a < 2; ++a)
#pragma unroll
            for (int b = 0; b < 2; ++b)
#pragma unroll
                for (int m = 0; m < MT; ++m)
#pragma unroll
                    for (int n = 0; n < 2; ++n) acc[a][b][m][n] = (f32x4){0.f, 0.f, 0.f, 0.f};
        cur = nxt; cA = nA; cB = nB; ++ui;
        if constexpr (ALIGN_EPI) { if (wr == 1) PG8_BAR; }
    }
    PG8_WAIT_V(0);
    if constexpr (!ALIGN_EPI) { if (wr == 0) PG8_BAR; }
    PG8_BAR;
    if constexpr (Epi::AFTER_DRAIN) { E.fused(acc, cur, wr, wc, fr, fq, lds, wid, lane); S.done(cur); }
#undef PG8_SA
#undef PG8_SB
#undef PG8_STAGE
#undef PG8_LDA
#undef PG8_LDB
#undef PG8_MMA
#undef PG8_WAIT_V
#undef PG8_WAIT_L
#undef PG8_BAR
#undef PG8_SCHED
}

template <class Sched>
__device__ __forceinline__ void gemm_merge3(PG8_LAS unsigned char* lds, const bf16_t* A0, const bf16_t* A1, const bf16_t* A2, const bf16_t* W0, const bf16_t* W1, const bf16_t* W2,
                                            const Sched& S, const unsigned char* G8, bf16_t* MG, const float* ssq) {
    int tid_ = threadIdx.x; asm volatile("" : "+v"(tid_));
    const int tid = tid_, wid = __builtin_amdgcn_readfirstlane(tid >> 6), lane = tid & 63, wr = wid >> 2, wc = wid & 3, fr = lane & 15, fq = lane >> 4;
    constexpr int MT = 3;
    unsigned rA[2], rB[2], c2[2];
#pragma unroll
    for (int i = 0; i < 2; ++i) { int R, C; stage_rc(tid * 16 + i * 8192, R, C); rA[i] = (unsigned)R; rB[i] = (unsigned)((R & ~31) + perm32(R & 31)); c2[i] = (unsigned)C * 2u; }
    const size_t kstep = (size_t)(BK * 2);
    const unsigned ldsw = (unsigned)wid * 1024u;
    const int aoff = lds_byte(wr * (16 * MT) + fr, fq * 8), boff = lds_byte(wc * 32 + fr, fq * 8);
#define PG8_SA(b, h) (((b) * 2 + (h)) * HTB)
#define PG8_SB(b, h) ((4 + (b) * 2 + (h)) * HTB)
#define PG8_STAGE(bufoff, gbase, rr, kb) do { _Pragma("unroll") for (int _i = 0; _i < 2; ++_i) \
        __builtin_amdgcn_global_load_lds((const unsigned*)((const char*)(gbase) + ((rr)[_i] * (unsigned)(kb) + c2[_i])), (PG8_LAS unsigned*)(lds + (bufoff) + ldsw + _i * 8192), 16, 0, 0); } while (0)
#define PG8_LDA(dst, b, h) do { _Pragma("unroll") for (int m = 0; m < MT; ++m) _Pragma("unroll") for (int k = 0; k < 2; ++k) dst[m][k] = *(const PG8_LAS bf16x8*)(lds + PG8_SA(b, h) + aoff + m * 2048 + k * 1024); } while (0)
#define PG8_LDB(dst, b, h) do { _Pragma("unroll") for (int n = 0; n < 2; ++n) _Pragma("unroll") for (int k = 0; k < 2; ++k) dst[n][k] = *(const PG8_LAS bf16x8*)(lds + PG8_SB(b, h) + boff + n * 2048 + k * 1024); } while (0)
#define PG8_MMA(ai, bj, At, Bt) do { __builtin_amdgcn_s_setprio(1); _Pragma("unroll") for (int m = 0; m < MT; ++m) _Pragma("unroll") for (int n = 0; n < 2; ++n) _Pragma("unroll") for (int k = 0; k < 2; ++k) \
        acc[ai][bj][m][n] = __builtin_amdgcn_mfma_f32_16x16x32_bf16(Bt[n][k], At[m][k], acc[ai][bj][m][n], 0, 0, 0); __builtin_amdgcn_s_setprio(0); } while (0)
#define PG8_WAIT_V(n) asm volatile("s_waitcnt vmcnt(" #n ")" ::: "memory")
#define PG8_WAIT_L(n) asm volatile("s_waitcnt lgkmcnt(" #n ")" ::: "memory")
#define PG8_BAR __builtin_amdgcn_s_barrier()
#define PG8_SCHED __builtin_amdgcn_sched_barrier(0)
#define PG8_SEGA(s) ((const char*)((s) == 0 ? A0 : (s) == 1 ? A1 : A2))
#define PG8_SEGW(s) ((const char*)((s) == 0 ? W0 : (s) == 1 ? W1 : W2))
    Unit cur, nxt; int ti = 0, seg = 0;
    if (!S.next(0, cur)) return;
    f32x4 acc[2][2][MT][2];
#pragma unroll
    for (int a = 0; a < 2; ++a)
#pragma unroll
        for (int b = 0; b < 2; ++b)
#pragma unroll
            for (int m = 0; m < MT; ++m)
#pragma unroll
                for (int n = 0; n < 2; ++n) acc[a][b][m][n] = (f32x4){0.f, 0.f, 0.f, 0.f};
    u32x4 mrg[2][MT][2];
    bf16x8 At[MT][2], B0[2][2], B1[2][2];
    int kb = 512 * 2;
    const char* cA = PG8_SEGA(0) + (size_t)cur.pm * (size_t)(64 * MT) * kb; const char* cB = PG8_SEGW(0) + (size_t)cur.pn * (size_t)BM * kb;
    {   const size_t hA = (size_t)(32 * MT) * kb, hB = (size_t)HALF * kb;
        PG8_STAGE(PG8_SB(0, 0), cB, rB, kb); PG8_STAGE(PG8_SB(0, 1), cB + hB, rB, kb); PG8_STAGE(PG8_SA(0, 0), cA, rA, kb); PG8_STAGE(PG8_SA(0, 1), cA + hA, rA, kb);
        if (wr == 1) PG8_BAR;
        PG8_WAIT_V(2); PG8_BAR;
        PG8_STAGE(PG8_SB(1, 0), cB + kstep, rB, kb); PG8_STAGE(PG8_SA(1, 0), cA + kstep, rA, kb); PG8_STAGE(PG8_SB(1, 1), cB + hB + kstep, rB, kb);
        PG8_WAIT_V(6); PG8_BAR; }
    for (;;) {
        int nseg = seg + 1; bool has_next = true; Unit nu = cur;
        if (nseg == 3) { nseg = 0; has_next = S.next(ti + 1, nxt); nu = nxt; }
        const int nkb = has_next ? (nseg == 2 ? 2048 : 1024) : kb;
        const char* nA = has_next ? PG8_SEGA(nseg) + (size_t)nu.pm * (size_t)(64 * MT) * nkb : cA; const char* nB = has_next ? PG8_SEGW(nseg) + (size_t)nu.pn * (size_t)BM * nkb : cB;
        const int nt = kb >> 7;
        const size_t hA = (size_t)(32 * MT) * kb, hB = (size_t)HALF * kb;
        for (int t = 0; t < nt; t += 2) {
            const bool last = (t == nt - 2);
            const char* a1 = cA + (size_t)(t + 1) * kstep;
            const char* a2 = last ? nA : cA + (size_t)(t + 2) * kstep; const char* b2 = last ? nB : cB + (size_t)(t + 2) * kstep;
            const char* a3 = a2 + kstep; const char* b3 = b2 + kstep;
            const int kb2 = last ? nkb : kb; const size_t hA2 = (size_t)(32 * MT) * kb2, hB2 = (size_t)HALF * kb2;
            PG8_LDB(B0, 0, 0); PG8_LDB(B1, 0, 1); PG8_SCHED; PG8_LDA(At, 0, 0); PG8_STAGE(PG8_SA(1, 1), a1 + hA, rA, kb);
            PG8_WAIT_V(8); PG8_WAIT_L(0); PG8_BAR; PG8_MMA(0, 0, At, B0); PG8_MMA(0, 1, At, B1); PG8_BAR; PG8_SCHED;
            PG8_LDA(At, 0, 1); PG8_STAGE(PG8_SB(0, 0), b2, rB, kb2); PG8_STAGE(PG8_SB(0, 1), b2 + hB2, rB, kb2); PG8_STAGE(PG8_SA(0, 0), a2, rA, kb2);
            PG8_WAIT_V(8); PG8_WAIT_L(0); PG8_BAR; PG8_MMA(1, 0, At, B0); PG8_MMA(1, 1, At, B1); PG8_BAR; PG8_SCHED;
            PG8_LDB(B0, 1, 0); PG8_LDB(B1, 1, 1); PG8_SCHED; PG8_LDA(At, 1, 0); PG8_STAGE(PG8_SA(0, 1), a2 + hA2, rA, kb2);
            PG8_WAIT_V(8); PG8_WAIT_L(0); PG8_BAR; PG8_MMA(0, 0, At, B0); PG8_MMA(0, 1, At, B1); PG8_BAR; PG8_SCHED;
            PG8_LDA(At, 1, 1); PG8_STAGE(PG8_SB(1, 0), b3, rB, kb2); PG8_STAGE(PG8_SB(1, 1), b3 + hB2, rB, kb2); PG8_STAGE(PG8_SA(1, 0), a3, rA, kb2);
            PG8_WAIT_V(8); PG8_WAIT_L(0); PG8_BAR; PG8_MMA(1, 0, At, B0); PG8_MMA(1, 1, At, B1); PG8_BAR; PG8_SCHED;
        }
        if (wr == 0) PG8_BAR;
        {
            const int row0 = cur.pm * (64 * MT) + wr * (16 * MT) + fr, col0 = cur.pn * BM + wc * 32 + 8 * fq;
            constexpr float SC = 1.0f / 255.0f;
#pragma unroll
            for (int ai = 0; ai < 2; ++ai)
#pragma unroll
                for (int m = 0; m < MT; ++m) { const int row = row0 + ai * (32 * MT) + m * 16;
                    const float rs = seg == 2 ? SC * (1.0f / sqrtf(ssq[row] * (1.0f / 1024.0f) + 1e-6f)) : SC;
#pragma unroll
                    for (int bj = 0; bj < 2; ++bj) { const f32x4 v0 = acc[ai][bj][m][0], v1 = acc[ai][bj][m][1];
                        const u32x2 gq = *(const u32x2*)(G8 + (size_t)row * 3072 + seg * 1024 + col0 + bj * HALF);
                        float r[8];
                        r[0] = (float)(gq.x & 255u) * rs * v0[0]; r[1] = (float)((gq.x >> 8) & 255u) * rs * v0[1]; r[2] = (float)((gq.x >> 16) & 255u) * rs * v0[2]; r[3] = (float)(gq.x >> 24) * rs * v0[3];
                        r[4] = (float)(gq.y & 255u) * rs * v1[0]; r[5] = (float)((gq.y >> 8) & 255u) * rs * v1[1]; r[6] = (float)((gq.y >> 16) & 255u) * rs * v1[2]; r[7] = (float)(gq.y >> 24) * rs * v1[3];
                        if (seg != 0) { const u32x4 mq = mrg[ai][m][bj];
                            r[0] += __uint_as_float(mq.x << 16); r[1] += __uint_as_float(mq.x & 0xffff0000u); r[2] += __uint_as_float(mq.y << 16); r[3] += __uint_as_float(mq.y & 0xffff0000u);
                            r[4] += __uint_as_float(mq.z << 16); r[5] += __uint_as_float(mq.z & 0xffff0000u); r[6] += __uint_as_float(mq.w << 16); r[7] += __uint_as_float(mq.w & 0xffff0000u); }
                        u32x4 w; w.x = cvt_pk_bf16_c(r[0], r[1]); w.y = cvt_pk_bf16_c(r[2], r[3]); w.z = cvt_pk_bf16_c(r[4], r[5]); w.w = cvt_pk_bf16_c(r[6], r[7]);
                        mrg[ai][m][bj] = w;
                        if (seg == 2) *(u32x4*)(MG + (size_t)row * 1024 + col0 + bj * HALF) = w; } }
        }
        if (!has_next) break;
#pragma unroll
        for (int a = 0; a < 2; ++a)
#pragma unroll
            for (int b = 0; b < 2; ++b)
#pragma unroll
                for (int m = 0; m < MT; ++m)
#pragma unroll
                    for (int n = 0; n < 2; ++n) acc[a][b][m][n] = (f32x4){0.f, 0.f, 0.f, 0.f};
        if (nseg == 0) { cur = nxt; ++ti; }
        seg = nseg; kb = nkb; cA = nA; cB = nB;
        if (wr == 1) PG8_BAR;
    }
    PG8_WAIT_V(0);
    PG8_BAR;
#undef PG8_SEGA
#undef PG8_SEGW
#undef PG8_SA
#undef PG8_SB
#undef PG8_STAGE
#undef PG8_LDA
#undef PG8_LDB
#undef PG8_MMA
#undef PG8_WAIT_V
#undef PG8_WAIT_L
#undef PG8_BAR
#undef PG8_SCHED
}
template <class Sched>
__device__ __forceinline__ void gemm_merge6(PG8_LAS unsigned char* lds, const bf16_t* H, const bf16_t* WG, const bf16_t* A0, const bf16_t* A1, const bf16_t* A2, const bf16_t* W0, const bf16_t* W1, const bf16_t* W2,
                                            const Sched& S, bf16_t* MG, const float* ssqh) {
    constexpr int GT_OFF = 133120;
    int tid_ = threadIdx.x; asm volatile("" : "+v"(tid_));
    const int tid = tid_, wid = __builtin_amdgcn_readfirstlane(tid >> 6), lane = tid & 63, wr = wid >> 2, wc = wid & 3, fr = lane & 15, fq = lane >> 4;
    constexpr int MT = 3;
    unsigned rA, rB, c2;
    { int R, C; stage_rc(tid * 16, R, C); rA = (unsigned)R; rB = (unsigned)((R & ~31) + perm32(R & 31)); c2 = (unsigned)C * 2u; }
    const size_t kstep = (size_t)(BK * 2);
    const unsigned ldsw = (unsigned)wid * 1024u;
    const int aoff = lds_byte(wr * (16 * MT) + fr, fq * 8), boff = lds_byte(wc * 32 + fr, fq * 8);
#define PG8_SA(b, h) (((b) * 2 + (h)) * HTB)
#define PG8_SB(b, h) ((4 + (b) * 2 + (h)) * HTB)
#define PG8_STAGE(bufoff, gbase, rr, kb) do { const unsigned vo_ = (rr) * (unsigned)(kb) + c2; _Pragma("unroll") for (int _i = 0; _i < 2; ++_i) \
        __builtin_amdgcn_global_load_lds((const unsigned*)((const char*)(gbase) + (size_t)(_i * 64) * (size_t)(kb) + vo_), (PG8_LAS unsigned*)(lds + (bufoff) + ldsw + _i * 8192), 16, 0, 0); } while (0)
#define PG8_LDA(dst, b, h) do { _Pragma("unroll") for (int m = 0; m < MT; ++m) _Pragma("unroll") for (int k = 0; k < 2; ++k) dst[m][k] = *(const PG8_LAS bf16x8*)(lds + PG8_SA(b, h) + aoff + m * 2048 + k * 1024); } while (0)
#define PG8_LDB(dst, b, h) do { _Pragma("unroll") for (int n = 0; n < 2; ++n) _Pragma("unroll") for (int k = 0; k < 2; ++k) dst[n][k] = *(const PG8_LAS bf16x8*)(lds + PG8_SB(b, h) + boff + n * 2048 + k * 1024); } while (0)
#define PG8_MMA(ai, bj, At, Bt) do { __builtin_amdgcn_s_setprio(1); _Pragma("unroll") for (int m = 0; m < MT; ++m) _Pragma("unroll") for (int n = 0; n < 2; ++n) _Pragma("unroll") for (int k = 0; k < 2; ++k) \
        acc[ai][bj][m][n] = __builtin_amdgcn_mfma_f32_16x16x32_bf16(Bt[n][k], At[m][k], acc[ai][bj][m][n], 0, 0, 0); __builtin_amdgcn_s_setprio(0); } while (0)
#define PG8_WAIT_V(n) asm volatile("s_waitcnt vmcnt(" #n ")" ::: "memory")
#define PG8_WAIT_L(n) asm volatile("s_waitcnt lgkmcnt(" #n ")" ::: "memory")
#define PG8_BAR __builtin_amdgcn_s_barrier()
#define PG8_SCHED __builtin_amdgcn_sched_barrier(0)
#define PG8_SEGA(s) ((const char*)(((s) & 1) == 0 ? H : (s) == 1 ? A0 : (s) == 3 ? A1 : A2))
#define PG8_SEGW(s) ((const char*)(((s) & 1) == 0 ? WG + (size_t)((s) >> 1) * 1024 * 1024 : (s) == 1 ? W0 : (s) == 3 ? W1 : W2))
#define PG8_SEGKB(s) (((s) == 1 || (s) == 3) ? 1024 : 2048)
    Unit cur, nxt; int ti = 0, seg = 0;
    if (!S.next(0, cur)) return;
    f32x4 acc[2][2][MT][2];
#pragma unroll
    for (int a = 0; a < 2; ++a)
#pragma unroll
        for (int b = 0; b < 2; ++b)
#pragma unroll
            for (int m = 0; m < MT; ++m)
#pragma unroll
                for (int n = 0; n < 2; ++n) acc[a][b][m][n] = (f32x4){0.f, 0.f, 0.f, 0.f};
    u32x4 mrg[2][MT][2];
    u32x2 gt[MT][2];
    PG8_LAS u32x4* gtl = (PG8_LAS u32x4*)(lds + GT_OFF) + tid;
    bf16x8 At[MT][2], B0[2][2], B1[2][2];
    int kb = 1024 * 2;
    const char* cA = PG8_SEGA(0) + (size_t)cur.pm * (size_t)(64 * MT) * kb; const char* cB = PG8_SEGW(0) + (size_t)cur.pn * (size_t)BM * kb;
    {   const size_t hA = (size_t)(32 * MT) * kb, hB = (size_t)HALF * kb;
        PG8_STAGE(PG8_SB(0, 0), cB, rB, kb); PG8_STAGE(PG8_SB(0, 1), cB + hB, rB, kb); PG8_STAGE(PG8_SA(0, 0), cA, rA, kb); PG8_STAGE(PG8_SA(0, 1), cA + hA, rA, kb);
        if (wr == 1) PG8_BAR;
        PG8_WAIT_V(2); PG8_BAR;
        PG8_STAGE(PG8_SB(1, 0), cB + kstep, rB, kb); PG8_STAGE(PG8_SA(1, 0), cA + kstep, rA, kb); PG8_STAGE(PG8_SB(1, 1), cB + hB + kstep, rB, kb);
        PG8_WAIT_V(6); PG8_BAR; }
    for (;;) {
        int nseg = seg + 1; bool has_next = true; Unit nu = cur;
        if (nseg == 6) { nseg = 0; has_next = S.next(ti + 1, nxt); nu = nxt; }
        const int nkb = has_next ? PG8_SEGKB(nseg) : kb;
        const char* nA = has_next ? PG8_SEGA(nseg) + (size_t)nu.pm * (size_t)(64 * MT) * nkb : cA; const char* nB = has_next ? PG8_SEGW(nseg) + (size_t)nu.pn * (size_t)BM * nkb : cB;
        const int nt = kb >> 7;
        const size_t hA = (size_t)(32 * MT) * kb, hB = (size_t)HALF * kb;
        for (int t = 0; t < nt; t += 2) {
            const bool last = (t == nt - 2);
            const char* a1 = cA + (size_t)(t + 1) * kstep;
            const char* a2 = last ? nA : cA + (size_t)(t + 2) * kstep; const char* b2 = last ? nB : cB + (size_t)(t + 2) * kstep;
            const char* a3 = a2 + kstep; const char* b3 = b2 + kstep;
            const int kb2 = last ? nkb : kb; const size_t hA2 = (size_t)(32 * MT) * kb2, hB2 = (size_t)HALF * kb2;
            PG8_LDB(B0, 0, 0); PG8_LDB(B1, 0, 1); PG8_SCHED; PG8_LDA(At, 0, 0); PG8_STAGE(PG8_SA(1, 1), a1 + hA, rA, kb);
            PG8_WAIT_V(8); PG8_WAIT_L(0); PG8_BAR; PG8_MMA(0, 0, At, B0); PG8_MMA(0, 1, At, B1); PG8_BAR; PG8_SCHED;
            PG8_LDA(At, 0, 1); PG8_STAGE(PG8_SB(0, 0), b2, rB, kb2); PG8_STAGE(PG8_SB(0, 1), b2 + hB2, rB, kb2); PG8_STAGE(PG8_SA(0, 0), a2, rA, kb2);
            PG8_WAIT_V(8); PG8_WAIT_L(0); PG8_BAR; PG8_MMA(1, 0, At, B0); PG8_MMA(1, 1, At, B1); PG8_BAR; PG8_SCHED;
            PG8_LDB(B0, 1, 0); PG8_LDB(B1, 1, 1); PG8_SCHED; PG8_LDA(At, 1, 0); PG8_STAGE(PG8_SA(0, 1), a2 + hA2, rA, kb2);
            PG8_WAIT_V(8); PG8_WAIT_L(0); PG8_BAR; PG8_MMA(0, 0, At, B0); PG8_MMA(0, 1, At, B1); PG8_BAR; PG8_SCHED;
            PG8_LDA(At, 1, 1); PG8_STAGE(PG8_SB(1, 0), b3, rB, kb2); PG8_STAGE(PG8_SB(1, 1), b3 + hB2, rB, kb2); PG8_STAGE(PG8_SA(1, 0), a3, rA, kb2);
            PG8_WAIT_V(8); PG8_WAIT_L(0); PG8_BAR; PG8_MMA(1, 0, At, B0); PG8_MMA(1, 1, At, B1); PG8_BAR; PG8_SCHED;
        }
        if (wr == 0) PG8_BAR;
        if ((seg & 1) == 0) {
            u32x2 gl[MT][2];
#pragma unroll
            for (int ai = 0; ai < 2; ++ai)
#pragma unroll
                for (int m = 0; m < MT; ++m)
#pragma unroll
                    for (int bj = 0; bj < 2; ++bj) { const f32x4 v0 = acc[ai][bj][m][0], v1 = acc[ai][bj][m][1];
                        unsigned q[8];
#pragma unroll
                        for (int e = 0; e < 4; ++e) { q[e] = (unsigned)(255.f * __builtin_amdgcn_rcpf(1.f + __expf(-v0[e])) + 0.5f); q[4 + e] = (unsigned)(255.f * __builtin_amdgcn_rcpf(1.f + __expf(-v1[e])) + 0.5f); }
                        u32x2 w; w.x = q[0] | (q[1] << 8) | (q[2] << 16) | (q[3] << 24); w.y = q[4] | (q[5] << 8) | (q[6] << 16) | (q[7] << 24);
                        if (ai == 0) gt[m][bj] = w; else gl[m][bj] = w; }
            { u32x4 t; t.x = gl[0][0].x; t.y = gl[0][0].y; t.z = gl[0][1].x; t.w = gl[0][1].y; gtl[0] = t; t.x = gl[1][0].x; t.y = gl[1][0].y; t.z = gl[1][1].x; t.w = gl[1][1].y; gtl[512] = t;
              t.x = gl[2][0].x; t.y = gl[2][0].y; t.z = gl[2][1].x; t.w = gl[2][1].y; gtl[1024] = t; }
        } else {
            int fr_ = fr, fq_ = fq; asm volatile("" : "+v"(fr_), "+v"(fq_));
            const int row0 = cur.pm * (64 * MT) + wr * (16 * MT) + fr_, col0 = cur.pn * BM + wc * 32 + 8 * fq_;
            constexpr float SC = 1.0f / 255.0f;
#pragma unroll
            for (int ai = 0; ai < 2; ++ai)
#pragma unroll
                for (int m = 0; m < MT; ++m) { const int row = row0 + ai * (32 * MT) + m * 16;
                    float rs = SC;
                    if (seg == 5) {
                        const float* sp = ssqh + (size_t)(4 * fq_) * MTOK + row;
                        float s4 = (sp[0] + sp[MTOK]) + (sp[2 * (size_t)MTOK] + sp[3 * (size_t)MTOK]);
                        s4 += __shfl_xor(s4, 16); s4 += __shfl_xor(s4, 32);
                        rs = SC * (1.0f / sqrtf(s4 * (1.0f / 1024.0f) + 1e-6f)); }
#pragma unroll
                    for (int bj = 0; bj < 2; ++bj) { const f32x4 v0 = acc[ai][bj][m][0], v1 = acc[ai][bj][m][1];
                        u32x2 gq; if (ai == 0) gq = gt[m][bj]; else { const u32x4 t = gtl[512 * m]; gq.x = bj ? t.z : t.x; gq.y = bj ? t.w : t.y; }
                        float r[8];
                        r[0] = (float)(gq.x & 255u) * rs * v0[0]; r[1] = (float)((gq.x >> 8) & 255u) * rs * v0[1]; r[2] = (float)((gq.x >> 16) & 255u) * rs * v0[2]; r[3] = (float)(gq.x >> 24) * rs * v0[3];
                        r[4] = (float)(gq.y & 255u) * rs * v1[0]; r[5] = (float)((gq.y >> 8) & 255u) * rs * v1[1]; r[6] = (float)((gq.y >> 16) & 255u) * rs * v1[2]; r[7] = (float)(gq.y >> 24) * rs * v1[3];
                        if (seg != 1) { const u32x4 mq = mrg[ai][m][bj];
                            r[0] += __uint_as_float(mq.x << 16); r[1] += __uint_as_float(mq.x & 0xffff0000u); r[2] += __uint_as_float(mq.y << 16); r[3] += __uint_as_float(mq.y & 0xffff0000u);
                            r[4] += __uint_as_float(mq.z << 16); r[5] += __uint_as_float(mq.z & 0xffff0000u); r[6] += __uint_as_float(mq.w << 16); r[7] += __uint_as_float(mq.w & 0xffff0000u); }
                        u32x4 w; w.x = cvt_pk_bf16_c(r[0], r[1]); w.y = cvt_pk_bf16_c(r[2], r[3]); w.z = cvt_pk_bf16_c(r[4], r[5]); w.w = cvt_pk_bf16_c(r[6], r[7]);
                        mrg[ai][m][bj] = w;
                        if (seg == 5) *(u32x4*)(MG + (size_t)row * 1024 + col0 + bj * HALF) = w; } }
        }
        if (!has_next) break;
#pragma unroll
        for (int a = 0; a < 2; ++a)
#pragma unroll
            for (int b = 0; b < 2; ++b)
#pragma unroll
                for (int m = 0; m < MT; ++m)
#pragma unroll
                    for (int n = 0; n < 2; ++n) acc[a][b][m][n] = (f32x4){0.f, 0.f, 0.f, 0.f};
        if (nseg == 0) { cur = nxt; ++ti; }
        seg = nseg; kb = nkb; cA = nA; cB = nB;
        if (wr == 1) PG8_BAR;
    }
    PG8_WAIT_V(0);
    PG8_BAR;
#undef PG8_SEGA
#undef PG8_SEGW
#undef PG8_SEGKB
#undef PG8_SA
#undef PG8_SB
#undef PG8_STAGE
#undef PG8_LDA
#undef PG8_LDB
#undef PG8_MMA
#undef PG8_WAIT_V
#undef PG8_WAIT_L
#undef PG8_BAR
#undef PG8_SCHED
}
}
using pg8::bf16_t;
__device__ __forceinline__ void phase_mod(const Params& P, LAS unsigned char* lds) {
    const int ZZ = opq0();
    const int tid = threadIdx.x, lane = tid & 63, w = tid >> 6;
    LAS float* sv = (LAS float*)lds;
    LAS float* red = (LAS float*)(lds + 9 * 1024 * 4);
    for (int i = tid; i < 9 * 1024; i += 512) { const int v = i >> 10, k = i & 1023; const float c = v == 0 ? P.in[ZZ + I_CCTX][k] : P.in[ZZ + I_C][(v - 1) * 1024 + k]; sv[i] = silu_f(c); }
    __syncthreads();
    float* MOD = (float*)(P.ws + ZZ + WS_MOD);
    for (int cgp = blockIdx.x; cgp < 192; cgp += gridDim.x) {
        const int col = cgp * 64 + lane, l = col / 6144, j = col % 6144;
        const float* wp = P.in[ZZ + I_WMOD] + (size_t)l * 1024 * 6144 + j;
        float a[9];
#pragma unroll
        for (int v = 0; v < 9; ++v) a[v] = 0.f;
        const int k0 = w * 128;
        for (int kb = k0; kb < k0 + 128; kb += 16) {
            float wv[16];
#pragma unroll
            for (int kk = 0; kk < 16; ++kk) wv[kk] = wp[(size_t)(kb + kk) * 6144];
#pragma unroll
            for (int kk = 0; kk < 16; ++kk)
#pragma unroll
                for (int v = 0; v < 9; ++v) a[v] += sv[v * 1024 + kb + kk] * wv[kk];
        }
#pragma unroll
        for (int v = 0; v < 9; ++v) red[(w * 9 + v) * 64 + lane] = a[v];
        __syncthreads();
        for (int o = tid; o < 9 * 64; o += 512) { const int v = o >> 6, ln = o & 63; float s = 0.f;
#pragma unroll
            for (int ww = 0; ww < 8; ++ww) s += red[(ww * 9 + v) * 64 + ln];
            const int c2 = cgp * 64 + ln, l2 = c2 / 6144, j2 = c2 % 6144;
            MOD[(size_t)(l2 * 9 + v) * 6144 + j2] = s + P.in[ZZ + I_BMOD][l2 * 6144 + j2]; }
        __syncthreads();
    }
}

__device__ __forceinline__ void transpose_item(const float* W, int ldw, int srccol0, bf16_t* WT, int K, int n0, int k0, LAS float* scr, int lane, const float* kscale = nullptr) {
    const int ks = lane >> 3, c4 = lane & 7;
    f32x4 v[8];
    if (srccol0 >= 0) {
#pragma unroll
        for (int i = 0; i < 8; ++i) { v[i] = *(const f32x4*)(W + (size_t)(k0 + 8 * i + ks) * ldw + srccol0 + 4 * c4); if (kscale) v[i] = v[i] * kscale[k0 + 8 * i + ks]; }
    } else {
#pragma unroll
        for (int i = 0; i < 8; ++i) v[i] = (f32x4){0.f, 0.f, 0.f, 0.f};
    }
#pragma unroll
    for (int i = 0; i < 8; ++i) { LAS float* d = scr + (8 * i + ks) * 33 + 4 * c4; d[0] = v[i][0]; d[1] = v[i][1]; d[2] = v[i][2]; d[3] = v[i][3]; }
    LDS_WAIT(); asm volatile("" ::: "memory");
    const int c = lane & 7;
#pragma unroll
    for (int j = 0; j < 4; ++j) { const int n = (lane >> 3) + 8 * j; const LAS float* s = scr + (8 * c) * 33 + n;
        u32x4 o; o.x = cvt_pk_bf16(s[0 * 33], s[1 * 33]); o.y = cvt_pk_bf16(s[2 * 33], s[3 * 33]); o.z = cvt_pk_bf16(s[4 * 33], s[5 * 33]); o.w = cvt_pk_bf16(s[6 * 33], s[7 * 33]);
        *(u32x4*)(WT + (size_t)(n0 + n) * K + k0 + 8 * c) = o; }
    LDS_WAIT(); asm volatile("" ::: "memory");
}
__device__ __forceinline__ void titem_load(const float* W, int ldw, int srccol0, int k0, const float* kscale, f32x4 (&v)[8], float (&sc)[8], int lane) {
    const int ks = lane >> 3, c4 = lane & 7;
#pragma unroll
    for (int i = 0; i < 8; ++i) { v[i] = (f32x4){0.f, 0.f, 0.f, 0.f}; sc[i] = 1.0f;
        if (srccol0 >= 0) { v[i] = *(const f32x4*)(W + (size_t)(k0 + 8 * i + ks) * ldw + srccol0 + 4 * c4); if (kscale) sc[i] = kscale[k0 + 8 * i + ks]; } }
}
__device__ __forceinline__ void titem_store(bf16_t* WT, int K, int n0, int k0, const f32x4 (&v)[8], const float (&sc)[8], LAS float* scr, int lane) {
    const int ks = lane >> 3, c4 = lane & 7;
#pragma unroll
    for (int i = 0; i < 8; ++i) { LAS float* d = scr + (8 * i + ks) * 33 + 4 * c4; d[0] = v[i][0] * sc[i]; d[1] = v[i][1] * sc[i]; d[2] = v[i][2] * sc[i]; d[3] = v[i][3] * sc[i]; }
    LDS_WAIT(); asm volatile("" ::: "memory");
    const int c = lane & 7;
#pragma unroll
    for (int j = 0; j < 4; ++j) { const int n = (lane >> 3) + 8 * j; const LAS float* s = scr + (8 * c) * 33 + n;
        u32x4 o; o.x = cvt_pk_bf16(s[0 * 33], s[1 * 33]); o.y = cvt_pk_bf16(s[2 * 33], s[3 * 33]); o.z = cvt_pk_bf16(s[4 * 33], s[5 * 33]); o.w = cvt_pk_bf16(s[6 * 33], s[7 * 33]);
        *(u32x4*)(WT + (size_t)(n0 + n) * K + k0 + 8 * c) = o; }
    LDS_WAIT(); asm volatile("" ::: "memory");
}
__device__ __forceinline__ int win_srccol(int n0) { return n0 < 3872 ? n0 : -1; }
template <int NR, bool XBF>
__device__ __forceinline__ void norm_mod_rows(const void* const (&xr)[NR], const float* g, const float* const (&md)[NR], int sh_off, int sc_off, bf16_t* const (&orow)[NR], int lane) {
    f32x4 v[XBF ? 1 : NR][4]; u32x2 q[XBF ? NR : 1][4]; float s[NR];
#define NM_X(r, j) (XBF ? (f32x4){bf_lo(q[XBF ? (r) : 0][j].x), bf_hi(q[XBF ? (r) : 0][j].x), bf_lo(q[XBF ? (r) : 0][j].y), bf_hi(q[XBF ? (r) : 0][j].y)} : v[XBF ? 0 : (r)][j])
#pragma unroll
    for (int r = 0; r < NR; ++r)
#pragma unroll
        for (int j = 0; j < 4; ++j) { if (XBF) q[XBF ? r : 0][j] = ((const u32x2*)xr[r])[lane + 64 * j]; else v[XBF ? 0 : r][j] = ((const f32x4*)xr[r])[lane + 64 * j]; }
#pragma unroll
    for (int r = 0; r < NR; ++r) { s[r] = 0.f;
#pragma unroll
        for (int j = 0; j < 4; ++j) { const f32x4 x = NM_X(r, j); s[r] += (x[0] * x[0] + x[1] * x[1]) + (x[2] * x[2] + x[3] * x[3]); } }
#pragma unroll
    for (int o = 1; o < 64; o <<= 1)
#pragma unroll
        for (int r = 0; r < NR; ++r) s[r] += __shfl_xor(s[r], o);
#pragma unroll
    for (int j = 0; j < 4; ++j) { const f32x4 gg = ((const f32x4*)g)[lane + 64 * j];
#pragma unroll
        for (int r = 0; r < NR; ++r) { const float rs = 1.0f / sqrtf(s[r] * (1.0f / 1024.0f) + 1e-6f);
            const f32x4 a1 = ((const f32x4*)(md[r] + sc_off))[lane + 64 * j], a0 = ((const f32x4*)(md[r] + sh_off))[lane + 64 * j];
            const f32x4 x = NM_X(r, j);
            const f32x4 y = (x * rs * gg) * (a1 + 1.0f) + a0;
            ((unsigned long long*)orow[r])[lane + 64 * j] = (unsigned long long)cvt_pk_bf16(y[0], y[1]) | ((unsigned long long)cvt_pk_bf16(y[2], y[3]) << 32); } }
#undef NM_X
}
__device__ __forceinline__ void norm_rows_x(const Params& P, int ZZ, const float* g, const float* MOD, int sh_off, int sc_off, int gw, int NGW, int lane) {
    const bf16_t* X = (const bf16_t*)(P.ws + ZZ + WS_X); bf16_t* H = (bf16_t*)(P.out + ZZ);
    gw = __builtin_amdgcn_readfirstlane(gw);
    for (int m = 6 * gw; m < MTOK; m += 6 * NGW) {
        const void* xr[6]; const float* md[6]; bf16_t* orow[6];
#pragma unroll
        for (int r = 0; r < 6; ++r) { xr[r] = X + (size_t)(m + r) * 1024; md[r] = MOD + (size_t)mod_index(m + r) * 6144; orow[r] = H + (size_t)(m + r) * 1024; }
        norm_mod_rows<6, true>(xr, g, md, sh_off, sc_off, orow, lane);
    }
}
__device__ __forceinline__ void h1_rows2(const Params& P, int l, int gw, int NGW, int lane) {
    const int ZZ = opq0();
    const float* MOD = (const float*)(P.ws + ZZ + WS_MOD) + (size_t)l * 9 * 6144;
    if (l != 0) { norm_rows_x(P, ZZ, P.in[ZZ + I_N1G] + l * 1024, MOD, 0, 1024, gw, NGW, lane); return; }
    bf16_t* H = (bf16_t*)(P.out + ZZ);
    for (int m = 4 * gw; m < MTOK; m += 4 * NGW) {
        const void* xr[4]; const float* md[4]; bf16_t* orow[4];
#pragma unroll
        for (int r = 0; r < 4; ++r) { xr[r] = xrow_ptr0(P, ZZ, m + r); md[r] = MOD + (size_t)mod_index(m + r) * 6144; orow[r] = H + (size_t)(m + r) * 1024; }
        norm_mod_rows<4, false>(xr, P.in[ZZ + I_N1G] + l * 1024, md, 0, 1024, orow, lane);
    }
}
__device__ __forceinline__ void phase_p0(const Params& P, int l, LAS unsigned char* lds) {
    const int ZZ = opq0();
    const int tid = threadIdx.x, lane = tid & 63, w = tid >> 6;
    LAS float* scr = (LAS float*)(lds + w * 8704);
    const int gw = blockIdx.x * 8 + w, NGW = gridDim.x * 8;
    constexpr int I0 = 2048, I1 = I0 + 1536, I2 = I1 + 256, I3 = I2 + 512, I4 = I3 + 512, I5 = I4 + 2048, I6 = I5 + 2048;
    unsigned char* ws = P.ws + ZZ;
    const float* const pWIN = P.in[ZZ + I_WIN] + (size_t)l * 1024 * INC; const float* const pWAO = P.in[ZZ + I_WAO] + (size_t)l * 512 * 1024; const float* const pWSO = P.in[ZZ + I_WSO] + (size_t)l * 1024 * 1024;
    const float* const pWOUT = P.in[ZZ + I_WOUT] + (size_t)l * 1024 * 1024; const float* const pWM1 = P.in[ZZ + I_WM1] + (size_t)l * 1024 * 4096; const float* const pWM2 = P.in[ZZ + I_WM2] + (size_t)l * 4096 * 1024;
    const float* const pSSDG = P.in[ZZ + I_SSDG] + l * 1024;
#define P0_ITEM(IT, W_, LD_, SC_, K0_, KS_, WT_, KK_, N0_) do { const int it_ = (IT); KS_ = nullptr; \
        if (it_ < I0) { const int kb = it_ / 128, nb = it_ % 128; W_ = pWIN; LD_ = INC; SC_ = win_srccol(nb * 32); WT_ = (bf16_t*)(ws + WS_WIN); KK_ = 1024; N0_ = nb * 32; K0_ = kb * 64; } \
        else if (it_ < I1) { const int r = it_ - I0, kb = r / 96, nb = r % 96; W_ = pWIN; LD_ = INC; SC_ = 3872 + nb * 32; WT_ = (bf16_t*)(ws + WS_WG); KK_ = 1024; N0_ = nb * 32; K0_ = kb * 64; } \
        else if (it_ < I2) { const int r = it_ - I1, kb = r / 32, nb = r % 32; W_ = pWAO; LD_ = 1024; SC_ = nb * 32; WT_ = (bf16_t*)(ws + WS_WATT); KK_ = 512; N0_ = nb * 32; K0_ = kb * 64; } \
        else if (it_ < I3) { const int r = it_ - I2, kb = r / 32, nb = r % 32; W_ = pWSO; LD_ = 1024; SC_ = nb * 32; WT_ = (bf16_t*)(ws + WS_WSSD); KK_ = 1024; N0_ = nb * 32; K0_ = kb * 64; \
            KS_ = pSSDG; }     \
        else if (it_ < I4) { const int r = it_ - I3, kb = r / 32, nb = r % 32; W_ = pWOUT; LD_ = 1024; SC_ = nb * 32; WT_ = (bf16_t*)(ws + WS_WOUT); KK_ = 1024; N0_ = nb * 32; K0_ = kb * 64; } \
        else if (it_ < I5) { const int r = it_ - I4, kb = r / 128, nb = r % 128; W_ = pWM1; LD_ = 4096; SC_ = nb * 32; WT_ = (bf16_t*)(ws + WS_WM1); KK_ = 1024; N0_ = nb * 32; K0_ = kb * 64; } \
        else { const int r = it_ - I5, kb = r / 32, nb = r % 32; W_ = pWM2; LD_ = 1024; SC_ = nb * 32; WT_ = (bf16_t*)(ws + WS_WM2); KK_ = 4096; N0_ = nb * 32; K0_ = kb * 64; } } while (0)
    {
        f32x4 va[8], vb[8]; float sa[8], sb[8];
        const float *cW, *cKS; int cLD, cSC, cK0, cKK, cN0; bf16_t* cWT;
        int it = __builtin_amdgcn_readfirstlane(gw);
        P0_ITEM(it < I6 ? it : 0, cW, cLD, cSC, cK0, cKS, cWT, cKK, cN0);
        if (it < I6) titem_load(cW, cLD, cSC, cK0, cKS, va, sa, lane);
        for (; it < I6; it += NGW) {
            const int nx = it + NGW;
            const float *nW, *nKS; int nLD, nSC, nK0, nKK, nN0; bf16_t* nWT;
            P0_ITEM(nx < I6 ? nx : it, nW, nLD, nSC, nK0, nKS, nWT, nKK, nN0);
            if (nx < I6) titem_load(nW, nLD, nSC, nK0, nKS, vb, sb, lane);
            titem_store(cWT, cKK, cN0, cK0, va, sa, scr, lane);
#pragma unroll
            for (int i = 0; i < 8; ++i) { va[i] = vb[i]; sa[i] = sb[i]; }
            cWT = nWT; cKK = nKK; cN0 = nN0; cK0 = nK0;
        }
    }
#undef P0_ITEM
    for (int tk = gw; tk < 2048; tk += NGW) {
        const int c0 = (tk >> 4) * 4, n = (tk & 15) * 64 + lane, g = c0 >> 7, cc0 = c0 & 127;
        const float* wo = P.in[ZZ + I_WPO] + (size_t)l * 512 * 1024 + (size_t)(g * 128) * 1024 + n;
        const float* sc = P.in[ZZ + I_POOLS] + l * 512 + g * 128;
        const float* pw = P.in[ZZ + I_POOLW] + ((size_t)(l * 4 + g) * 128 + cc0) * 128;
#pragma unroll
        for (int i = 0; i < 2; ++i) { const int e = (lane + 64 * i) * 4, d = e & 127; const f32x4 a = *(const f32x4*)(pw + e), b = *(const f32x4*)(sc + d);
            *(LAS f32x4*)(scr + e) = a * b; }
        LDS_WAIT(); asm volatile("" ::: "memory");
        float a[4];
#pragma unroll
        for (int j = 0; j < 4; ++j) a[j] = 0.f;
        for (int d0 = 0; d0 < 128; d0 += 32) {
            float wv[32];
#pragma unroll
            for (int dd = 0; dd < 32; ++dd) wv[dd] = wo[(size_t)(d0 + dd) * 1024];
#pragma unroll
            for (int dd = 0; dd < 32; dd += 4)
#pragma unroll
                for (int j = 0; j < 4; ++j) { const f32x4 p4 = *(const LAS f32x4*)(scr + j * 128 + d0 + dd); a[j] += p4[0] * wv[dd] + p4[1] * wv[dd + 1] + p4[2] * wv[dd + 2] + p4[3] * wv[dd + 3]; }
        }
        u32x2 o; o.x = cvt_pk_bf16(a[0], a[1]); o.y = cvt_pk_bf16(a[2], a[3]);
        *(u32x2*)((bf16_t*)(ws + WS_WPOOL) + (size_t)n * 512 + c0) = o;
        LDS_WAIT(); asm volatile("" ::: "memory");
    }
    for (int tk = gw; tk < 2048; tk += NGW) {
        const int which = tk >> 10, idx = (tk & 1023) * 512 + lane * 8, b = idx >> 16, rem = idx & 65535;
        const float* src = P.in[ZZ + which ? I_CV : I_CK] + (size_t)(b * 2 + l) * 65536 + rem;
        const f32x4 a = *(const f32x4*)src, c = *(const f32x4*)(src + 4);
        u32x4 o; o.x = cvt_pk_bf16(a[0], a[1]); o.y = cvt_pk_bf16(a[2], a[3]); o.z = cvt_pk_bf16(c[0], c[1]); o.w = cvt_pk_bf16(c[2], c[3]);
        *(u32x4*)((bf16_t*)(ws + (which ? WS_CV : WS_CK)) + idx) = o;
    }
    h1_rows2(P, l, gw, NGW, lane);
}

__device__ __forceinline__ float rope_inv(int i) { return exp2f(-(float)i * 0.83048202372184058696f); }
__device__ __forceinline__ float fast_rcp(float x) { return __builtin_amdgcn_rcpf(x); }
__device__ __forceinline__ void qk_norm_8(float (&v)[8], const float (&gn)[8]) {
    float ss = 0.f;
#pragma unroll
    for (int e = 0; e < 8; ++e) ss += v[e] * v[e];
    ss += __shfl_xor(ss, 1); ss += __shfl_xor(ss, 2); ss += __shfl_xor(ss, 4);
    const float rstd = 1.0f / sqrtf(ss * (1.0f / 64.0f) + 1e-6f);
#pragma unroll
    for (int e = 0; e < 8; ++e) v[e] = v[e] * rstd * gn[e];
}
__device__ __forceinline__ void rope_8(float (&v)[8], const float (&cs)[8], const float (&sn)[8], int ch) {
#pragma unroll
    for (int e = 0; e < 8; ++e) { const float own = v[e], oth = __shfl_xor(own, 2); v[e] = (ch & 2) == 0 ? own * cs[e] - oth * sn[e] : oth * sn[e] + own * cs[e]; }
}
__device__ __forceinline__ void qk_prep(const Params& P, int l) {
    const int ZZ = opq0();
    const int tid = threadIdx.x, lane = tid & 63, w = tid >> 6;
    const int gw = blockIdx.x * 8 + w, NGW = gridDim.x * 8;
    bf16_t* Qb = (bf16_t*)(P.ws + ZZ + WS_Q);
    bf16_t* KVb = (bf16_t*)(P.ws + ZZ + WS_KV);
    const float* qg = P.in[ZZ + I_QG] + l * 64;
    const float* kg = P.in[ZZ + I_KG] + l * 64;
    float* ock = P.out + ZZ + OUT_CK;
    const int ch = lane & 7;
    float qgn[8], kgn[8], finv[8];
#pragma unroll
    for (int e = 0; e < 8; ++e) { qgn[e] = qg[8 * ch + e]; kgn[e] = kg[8 * ch + e]; finv[e] = rope_inv(8 * (ch & 1) + e); }
    for (int m0 = 2 * gw; m0 < MTOK; m0 += 2 * NGW) {
        u32x4 qr[2], kr[2];
#pragma unroll
        for (int r = 0; r < 2; ++r) { qr[r] = *((const u32x4*)(Qb + (size_t)(m0 + r) * 512) + lane); kr[r] = *((const u32x4*)(KVb + (size_t)(m0 + r) * 256) + (lane & 15)); }
#pragma unroll
        for (int r = 0; r < 2; ++r) {
            const int m = m0 + r;
            const bool lat = m >= MCTX; const int t = (m - MCTX) & 2047;
            float cs[8], sn[8];
            if (lat) { const float pos = (float)((ch >> 2) == 0 ? (t >> 6) : (t & 63));
#pragma unroll
                for (int e = 0; e < 8; ++e) { const float ang = pos * finv[e]; cs[e] = __cosf(ang); sn[e] = __sinf(ang); } }
            float v[8] = {bf_lo(qr[r].x), bf_hi(qr[r].x), bf_lo(qr[r].y), bf_hi(qr[r].y), bf_lo(qr[r].z), bf_hi(qr[r].z), bf_lo(qr[r].w), bf_hi(qr[r].w)};
            qk_norm_8(v, qgn);
            if (lat) rope_8(v, cs, sn, ch);
            constexpr float QS = 0.125f * 1.4426950408889634f;
            u32x4 o; o.x = cvt_pk_bf16(v[0] * QS, v[1] * QS); o.y = cvt_pk_bf16(v[2] * QS, v[3] * QS); o.z = cvt_pk_bf16(v[4] * QS, v[5] * QS); o.w = cvt_pk_bf16(v[6] * QS, v[7] * QS);
            *((u32x4*)(Qb + (size_t)m * 512) + lane) = o;
            float k[8] = {bf_lo(kr[r].x), bf_hi(kr[r].x), bf_lo(kr[r].y), bf_hi(kr[r].y), bf_lo(kr[r].z), bf_hi(kr[r].z), bf_lo(kr[r].w), bf_hi(kr[r].w)};
            qk_norm_8(k, kgn);
            if (!lat && lane < 16) { float* ok = ock + ((size_t)((m >> 8) * 2 + l) * 256 + (m & 255)) * 128 + lane * 8;
                *(f32x4*)ok = (f32x4){k[0], k[1], k[2], k[3]}; *(f32x4*)(ok + 4) = (f32x4){k[4], k[5], k[6], k[7]}; }
            if (lat) rope_8(k, cs, sn, ch);
            if (lane < 16) { u32x4 ko; ko.x = cvt_pk_bf16(k[0], k[1]); ko.y = cvt_pk_bf16(k[2], k[3]); ko.z = cvt_pk_bf16(k[4], k[5]); ko.w = cvt_pk_bf16(k[6], k[7]); *((u32x4*)(KVb + (size_t)m * 256) + lane) = ko; }
        }
    }
}
constexpr int ATT_UNITS = 768;
__device__ __forceinline__ void attn_unit(const Params& P, int l, LAS unsigned char* lds, int unit, size_t out_off) {
    const int ZZ = opq0();
    const int tid = threadIdx.x, lane = tid & 63, w = tid >> 6, g = lane >> 4, li = lane & 15;
    const bf16_t* Qb = (const bf16_t*)(P.ws + ZZ + WS_Q);
    const bf16_t* KVb = (const bf16_t*)(P.ws + ZZ + WS_KV);
    const bf16_t* CKb = (const bf16_t*)(P.ws + ZZ + WS_CK);
    const bf16_t* CVb = (const bf16_t*)(P.ws + ZZ + WS_CV);
    int lat, b, hp, qb;
    unit = unit < 128 ? unit : (unit < 384 ? 384 + unit : unit - 256);
    if (unit < 512) { lat = 1; b = unit >> 6; hp = (unit >> 4) & 3; qb = unit & 15; }
    else { const int u2 = unit - 512; lat = 0; b = u2 >> 3; hp = (u2 >> 1) & 3; qb = u2 & 1; }
    const int h0 = 2 * hp, kvh = hp >> 1;
    const int row0 = lat ? MCTX + b * LLAT + qb * 128 : b * LCTX + qb * 128;
    const int qrow = row0 + 16 * w + li;
    const int qpos = qb * 128 + 16 * w + li;
    bf16x8 bq[2][2];
    float m_run[2], l_run[2];
    f32x4 o[2][4];
#pragma unroll
    for (int hh = 0; hh < 2; ++hh) {
        bq[hh][0] = *(const bf16x8*)(Qb + (size_t)qrow * 512 + (h0 + hh) * 64 + 8 * g);
        bq[hh][1] = *(const bf16x8*)(Qb + (size_t)qrow * 512 + (h0 + hh) * 64 + 32 + 8 * g);
        m_run[hh] = P.in[ZZ + I_SINK][l * 8 + h0 + hh] * 1.4426950408889634f;
        l_run[hh] = (g == 0) ? 1.f : 0.f;
#pragma unroll
        for (int i = 0; i < 4; ++i) o[hh][i] = (f32x4){0.f, 0.f, 0.f, 0.f}; }
    const int t_lo = 0, t_hi = lat ? 14 : 4;
    const int kt2 = tid - 256, dp = tid & 31, kb = (tid >> 5) & 7;
    u32x4 pk0, pk1; unsigned pv[8];
#define ATT_TILE_PTRS(T, KP, VP, STRIDE, KPOS0, MASKED, VALID) do { VALID = true; MASKED = false; KPOS0 = 0; \
        if (!lat) { KP = KVb + (size_t)(b * LCTX + 64 * (T)) * 256 + kvh * 64; VP = KP + 128; STRIDE = 256; } \
        else if ((T) < 8) { KP = CKb + (size_t)(b * PAST + 64 * (T)) * 128 + kvh * 64; VP = CVb + (size_t)(b * PAST + 64 * (T)) * 128 + kvh * 64; STRIDE = 128; } \
        else { const int blk_ = qb - 1 + (((T) - 8) >> 1); VALID = !(blk_ < 0 || blk_ > 15); KPOS0 = blk_ * 128 + (((T) - 8) & 1) * 64; \
            KP = KVb + (size_t)(MCTX + b * LLAT + (VALID ? KPOS0 : 0)) * 256 + kvh * 64; VP = KP + 128; STRIDE = 256; MASKED = true; } } while (0)
#define ATT_PREFETCH(T) do { const bf16_t *kp_, *vp_; int st_, k0_; bool mk_, ok_; ATT_TILE_PTRS(T, kp_, vp_, st_, k0_, mk_, ok_); \
        if (ok_) { if (tid >= 256) { pk0 = *(const u32x4*)(kp_ + (size_t)(kt2 >> 3) * st_ + (kt2 & 7) * 8); pk1 = *(const u32x4*)(kp_ + (size_t)((kt2 + 256) >> 3) * st_ + (kt2 & 7) * 8); } \
            else { _Pragma("unroll") for (int j = 0; j < 8; ++j) pv[j] = *(const unsigned*)(vp_ + (size_t)(8 * kb + j) * st_ + 2 * dp); } } } while (0)
    ATT_PREFETCH(t_lo);
    for (int t = t_lo; t < t_hi; ++t) {
        const bf16_t *kp, *vp; int stride, kpos0; bool masked, valid;
        ATT_TILE_PTRS(t, kp, vp, stride, kpos0, masked, valid);
        if (!valid) { if (t + 1 < t_hi) ATT_PREFETCH(t + 1); continue; }
        LDS_BARRIER();
        if (tid >= 256) {
            { const int key = kt2 >> 3, ch = kt2 & 7; *(LAS u32x4*)(lds + key * 128 + ((ch ^ (key & 7)) << 4)) = pk0; }
            { const int key = (kt2 + 256) >> 3, ch = kt2 & 7; *(LAS u32x4*)(lds + key * 128 + ((ch ^ (key & 7)) << 4)) = pk1; }
        } else {
            u32x4 lo, hi;
            lo.x = (pv[0] & 0xffffu) | (pv[1] << 16); lo.y = (pv[2] & 0xffffu) | (pv[3] << 16); lo.z = (pv[4] & 0xffffu) | (pv[5] << 16); lo.w = (pv[6] & 0xffffu) | (pv[7] << 16);
            hi.x = (pv[0] >> 16) | (pv[1] & 0xffff0000u); hi.y = (pv[2] >> 16) | (pv[3] & 0xffff0000u); hi.z = (pv[4] >> 16) | (pv[5] & 0xffff0000u); hi.w = (pv[6] >> 16) | (pv[7] & 0xffff0000u);
            const int d0 = 2 * dp, d1 = d0 + 1;
            *(LAS u32x4*)(lds + 8192 + d0 * 128 + ((kb ^ (d0 & 7)) << 4)) = lo;
            *(LAS u32x4*)(lds + 8192 + d1 * 128 + ((kb ^ (d1 & 7)) << 4)) = hi;
        }
        if (t + 1 < t_hi) ATT_PREFETCH(t + 1);
        LDS_BARRIER();
        if (masked) { const int q0w = qb * 128 + 16 * w;
            if (kpos0 + 63 < q0w - 128 || kpos0 > q0w + 15 + 128) continue; }
        bf16x8 bp[2][2];
        {
            bf16x8 ka[4][2];
#pragma unroll
            for (int mt = 0; mt < 4; ++mt) { const int key = 16 * mt + li;
#pragma unroll
                for (int ks = 0; ks < 2; ++ks) { const int ch = 4 * ks + g; ka[mt][ks] = *(const LAS bf16x8*)(lds + key * 128 + ((ch ^ (key & 7)) << 4)); } }
#pragma unroll
            for (int hh = 0; hh < 2; ++hh) {
                f32x4 s[4];
#pragma unroll
                for (int mt = 0; mt < 4; ++mt) { s[mt] = (f32x4){0.f, 0.f, 0.f, 0.f};
#pragma unroll
                    for (int ks = 0; ks < 2; ++ks) s[mt] = __builtin_amdgcn_mfma_f32_16x16x32_bf16(ka[mt][ks], bq[hh][ks], s[mt], 0, 0, 0); }
                if (masked) {
#pragma unroll
                    for (int mt = 0; mt < 4; ++mt)
#pragma unroll
                        for (int r = 0; r < 4; ++r) { const int kpos = kpos0 + 16 * mt + 4 * g + r; const int df = qpos - kpos; if (df > 128 || df < -128) s[mt][r] = -INFINITY; }
                }
                float mx = -INFINITY;
#pragma unroll
                for (int mt = 0; mt < 4; ++mt) mx = fmaxf(mx, fmaxf(fmaxf(s[mt][0], s[mt][1]), fmaxf(s[mt][2], s[mt][3])));
                mx = fmaxf(mx, __shfl_xor(mx, 16)); mx = fmaxf(mx, __shfl_xor(mx, 32));
                const float m_new = fmaxf(m_run[hh], mx);
                if (!__all(mx <= m_run[hh])) {
                    const float alpha = __builtin_amdgcn_exp2f(m_run[hh] - m_new); l_run[hh] *= alpha;
#pragma unroll
                    for (int i = 0; i < 4; ++i) o[hh][i] = o[hh][i] * alpha;
                }
                m_run[hh] = m_new;
                float ps = 0.f;
#pragma unroll
                for (int mt = 0; mt < 4; ++mt)
#pragma unroll
                    for (int r = 0; r < 4; ++r) { s[mt][r] = __builtin_amdgcn_exp2f(s[mt][r] - m_new); ps += s[mt][r]; }
                l_run[hh] += ps;
#pragma unroll
                for (int s2 = 0; s2 < 2; ++s2) { u32x4 pk; pk.x = cvt_pk_bf16(s[2 * s2][0], s[2 * s2][1]); pk.y = cvt_pk_bf16(s[2 * s2][2], s[2 * s2][3]);
                    pk.z = cvt_pk_bf16(s[2 * s2 + 1][0], s[2 * s2 + 1][1]); pk.w = cvt_pk_bf16(s[2 * s2 + 1][2], s[2 * s2 + 1][3]); bp[hh][s2] = __builtin_bit_cast(bf16x8, pk); }
            }
        }
#pragma unroll
        for (int dt = 0; dt < 4; ++dt) { const int d = 16 * dt + li;
#pragma unroll
            for (int s2 = 0; s2 < 2; ++s2) {
                const u32x2 lo8 = *(const LAS u32x2*)(lds + 8192 + d * 128 + (((4 * s2 + (g >> 1)) ^ (d & 7)) << 4) + 8 * (g & 1));
                const u32x2 hi8 = *(const LAS u32x2*)(lds + 8192 + d * 128 + (((4 * s2 + 2 + (g >> 1)) ^ (d & 7)) << 4) + 8 * (g & 1));
                u32x4 av; av.x = lo8.x; av.y = lo8.y; av.z = hi8.x; av.w = hi8.y;
#pragma unroll
                for (int hh = 0; hh < 2; ++hh) o[hh][dt] = __builtin_amdgcn_mfma_f32_16x16x32_bf16(__builtin_bit_cast(bf16x8, av), bp[hh][s2], o[hh][dt], 0, 0, 0); } }
    }
#undef ATT_PREFETCH
#undef ATT_TILE_PTRS
#pragma unroll
    for (int hh = 0; hh < 2; ++hh) {
        float lr = l_run[hh]; lr += __shfl_xor(lr, 16); lr += __shfl_xor(lr, 32);
        const float inv = 1.0f / lr;
#pragma unroll
        for (int dt = 0; dt < 4; ++dt) { const f32x4 x = o[hh][dt] * inv; u32x2 wv; wv.x = cvt_pk_bf16(x[0], x[1]); wv.y = cvt_pk_bf16(x[2], x[3]);
            *(u32x2*)((bf16_t*)(P.ws + ZZ + out_off) + (size_t)qrow * 512 + (h0 + hh) * 64 + 16 * dt + 4 * g) = wv; } }
}
__device__ __forceinline__ void bc_conv(const Params& P, int l) {
    const int ZZ = opq0();
    const bf16_t* X = (const bf16_t*)(P.ws + ZZ + WS_BCR);
    bf16_t* BC = (bf16_t*)(P.ws + ZZ + WS_BC);
    const int nthr = gridDim.x * 512, t0 = blockIdx.x * 512 + threadIdx.x;
    const int c = 8 * (t0 & 63);
    const float* cw = P.in[ZZ + I_CONVW] + (size_t)l * 5 * 1536 + 1024 + c;
    const float* cb = P.in[ZZ + I_CONVB] + (size_t)l * 1536 + 1024 + c;
    float wt[5][8], bs[8];
#pragma unroll
    for (int j = 0; j < 5; ++j) { const f32x4 a0 = *(const f32x4*)(cw + j * 1536), a1 = *(const f32x4*)(cw + j * 1536 + 4);
#pragma unroll
        for (int e = 0; e < 4; ++e) { wt[j][e] = a0[e]; wt[j][4 + e] = a1[e]; } }
    { const f32x4 a0 = *(const f32x4*)cb, a1 = *(const f32x4*)(cb + 4);
#pragma unroll
      for (int e = 0; e < 4; ++e) { bs[e] = a0[e]; bs[4 + e] = a1[e]; } }
    const int grp = (c >> 7) & 1, dcol = (c >> 8) * 128 + (c & 127);
    for (int task = t0; task < (MTOK / 4) * 64; task += nthr) {
        const int row = (task >> 6) * 4;
        int t, L; if (row < MCTX) { t = row & 255; L = LCTX; } else { t = (row - MCTX) & 2047; L = LLAT; }
        u32x4 raw[8];
#pragma unroll
        for (int i = 0; i < 8; ++i) { const int tt = t - 2 + i; u32x4 u = (u32x4){0u, 0u, 0u, 0u}; if (tt >= 0 && tt < L) u = *(const u32x4*)(X + (size_t)(row - 2 + i) * 512 + c); raw[i] = u; }
#pragma unroll
        for (int i = 0; i < 4; ++i) { float a[8];
#pragma unroll
            for (int e = 0; e < 8; ++e) a[e] = bs[e];
#pragma unroll
            for (int j = 0; j < 5; ++j) { const u32x4 u = raw[i + j];
                a[0] += wt[j][0] * bf_lo(u.x); a[1] += wt[j][1] * bf_hi(u.x); a[2] += wt[j][2] * bf_lo(u.y); a[3] += wt[j][3] * bf_hi(u.y);
                a[4] += wt[j][4] * bf_lo(u.z); a[5] += wt[j][5] * bf_hi(u.z); a[6] += wt[j][6] * bf_lo(u.w); a[7] += wt[j][7] * bf_hi(u.w); }
            u32x4 o; o.x = cvt_pk_bf16(silu_f(a[0]), silu_f(a[1])); o.y = cvt_pk_bf16(silu_f(a[2]), silu_f(a[3])); o.z = cvt_pk_bf16(silu_f(a[4]), silu_f(a[5])); o.w = cvt_pk_bf16(silu_f(a[6]), silu_f(a[7]));
            *(u32x4*)(BC + ((size_t)grp * MTOK + row + i) * 256 + dcol) = o; }
    }
}
__device__ __forceinline__ void phase_attn(const Params& P, int l, LAS unsigned char* lds, size_t out_off, int first, int stride, int nunits) {
    for (int u = first; u < nunits; u += stride) attn_unit(P, l, lds, u, out_off);
}

__device__ __forceinline__ void ssd_unit(const Params& P, int l, LAS unsigned char* lds, int lat, int b, int h, int dir) {
    const int ZZ = opq0();
    const int tid = threadIdx.x, p = tid >> 3, ns = tid & 7;
    const int L = lat ? LLAT : LCTX, row0 = lat ? MCTX + b * LLAT : b * LCTX, grp = h >> 3;
    const float A = -__expf(P.in[ZZ + I_ALOG][l * 32 + dir * 16 + h]);
    const float Dsk = P.in[ZZ + I_DSKIP][l * 16 + h];
    const float dtbias = P.in[ZZ + I_DTB][l * 32 + dir * 16 + h];
    const bf16_t* X = (const bf16_t*)(P.ws + ZZ + WS_XBC);
    const bf16_t* BC = (const bf16_t*)(P.ws + ZZ + WS_BC);
    const float* DT = (const float*)(P.ws + ZZ + WS_DT);
    bf16_t* Y = (bf16_t*)((unsigned char*)(P.out + ZZ) + OUTB_Y);
    bf16_t* Z = (bf16_t*)(P.ws + ZZ + WS_Z);
    LAS float* xs = (LAS float*)lds;
    LAS float* Bs = (LAS float*)(lds + 16384);
    LAS float* Cs = (LAS float*)(lds + 49152);
    LAS float* yb = (LAS float*)(lds + 81920);
    LAS float* dts = (LAS float*)(lds + 98304);
    LAS float* das = (LAS float*)(lds + 98304 + 256);
    float S[16];
    if (lat) { const float* sp = P.in[ZZ + I_ST] + ((size_t)((((b * 2 + l) * 2 + dir) * 16 + h) * 64 + p)) * 128 + ns * 16;
#pragma unroll
        for (int i = 0; i < 4; ++i) { const f32x4 v = *(const f32x4*)(sp + 4 * i); S[4 * i] = v[0]; S[4 * i + 1] = v[1]; S[4 * i + 2] = v[2]; S[4 * i + 3] = v[3]; } }
    else {
#pragma unroll
        for (int i = 0; i < 16; ++i) S[i] = 0.f; }
    const float* cw = P.in[ZZ + I_CONVW] + (size_t)l * 5 * 1536 + h * 64;
    const float* cb = P.in[ZZ + I_CONVB] + (size_t)l * 1536 + h * 64;
    const int nck = L / 64;
    for (int ck = 0; ck < nck; ++ck) {
        const int t0 = dir == 0 ? ck * 64 : L - 64 - ck * 64;
        __syncthreads();
        {
            const int tt = tid >> 3, c0 = (tid & 7) * 16; const bf16_t* src = BC + (size_t)(row0 + t0 + tt) * 512 + grp * 128 + c0;
#pragma unroll
            for (int hf = 0; hf < 2; ++hf) { const u32x4 bq = *(const u32x4*)(src + hf * 8), cq = *(const u32x4*)(src + 256 + hf * 8);
                *(LAS f32x4*)(Bs + tt * 128 + c0 + hf * 8) = (f32x4){bf_lo(bq.x), bf_hi(bq.x), bf_lo(bq.y), bf_hi(bq.y)};
                *(LAS f32x4*)(Bs + tt * 128 + c0 + hf * 8 + 4) = (f32x4){bf_lo(bq.z), bf_hi(bq.z), bf_lo(bq.w), bf_hi(bq.w)};
                *(LAS f32x4*)(Cs + tt * 128 + c0 + hf * 8) = (f32x4){bf_lo(cq.x), bf_hi(cq.x), bf_lo(cq.y), bf_hi(cq.y)};
                *(LAS f32x4*)(Cs + tt * 128 + c0 + hf * 8 + 4) = (f32x4){bf_lo(cq.z), bf_hi(cq.z), bf_lo(cq.w), bf_hi(cq.w)}; }
        }
        if (tid < 64) { const float xr = DT[(size_t)(row0 + t0 + tid) * 32 + dir * 16 + h] + dtbias; const float dtv = fmaxf(xr, 0.f) + log1pf(__expf(-fabsf(xr))); dts[tid] = dtv; das[tid] = __expf(dtv * A); }
        {
            const int p2 = tid & 31, tr = tid >> 5, c = 2 * p2, tl = 4 * tr;
            float raw0[8], raw1[8];
#pragma unroll
            for (int i = 0; i < 8; ++i) { const int tt = t0 + tl - 2 + i; unsigned u = 0u; if (tt >= 0 && tt < L) u = *(const unsigned*)(X + (size_t)(row0 + tt) * 1536 + h * 64 + c); raw0[i] = bf_lo(u); raw1[i] = bf_hi(u); }
            float w0[5], w1[5];
#pragma unroll
            for (int j = 0; j < 5; ++j) { w0[j] = cw[j * 1536 + c]; w1[j] = cw[j * 1536 + c + 1]; }
            const float b0 = cb[c], b1 = cb[c + 1];
#pragma unroll
            for (int i = 0; i < 4; ++i) { float a0 = b0, a1 = b1;
#pragma unroll
                for (int j = 0; j < 5; ++j) { a0 += w0[j] * raw0[i + j]; a1 += w1[j] * raw1[i + j]; }
                *(LAS f32x2*)(xs + (tl + i) * 64 + c) = (f32x2){silu_f(a0), silu_f(a1)}; }
        }
        __syncthreads();
        for (int st = 0; st < 64; ++st) {
            const int tt = dir == 0 ? st : 63 - st;
            const float da = das[tt], dx = dts[tt] * xs[tt * 64 + p];
            float yp = 0.f;
#pragma unroll
            for (int i = 0; i < 4; ++i) { const f32x4 bv = *(const LAS f32x4*)(Bs + tt * 128 + ns * 16 + 4 * i), cv = *(const LAS f32x4*)(Cs + tt * 128 + ns * 16 + 4 * i);
#pragma unroll
                for (int e = 0; e < 4; ++e) { S[4 * i + e] = S[4 * i + e] * da + dx * bv[e]; yp += cv[e] * S[4 * i + e]; } }
            yp += __shfl_xor(yp, 1); yp += __shfl_xor(yp, 2); yp += __shfl_xor(yp, 4);
            if (ns == 0) yb[tt * 64 + p] = yp;
        }
        __syncthreads();
        {
            const int tt = tid >> 3, p0 = (tid & 7) * 8; const size_t off = (size_t)(row0 + t0 + tt) * 1024 + h * 64 + p0;
            const f32x4 ya = *(const LAS f32x4*)(yb + tt * 64 + p0), yc = *(const LAS f32x4*)(yb + tt * 64 + p0 + 4);
            float yv[8] = {ya[0], ya[1], ya[2], ya[3], yc[0], yc[1], yc[2], yc[3]};
            if (dir == 0) {
                u32x4 o; o.x = cvt_pk_bf16(yv[0], yv[1]); o.y = cvt_pk_bf16(yv[2], yv[3]); o.z = cvt_pk_bf16(yv[4], yv[5]); o.w = cvt_pk_bf16(yv[6], yv[7]);
                *(u32x4*)(Y + off) = o;
            } else {
                const u32x4 yq = *(const u32x4*)(Y + off), zq = *(const u32x4*)(Z + off);
                const f32x4 xa = *(const LAS f32x4*)(xs + tt * 64 + p0), xc = *(const LAS f32x4*)(xs + tt * 64 + p0 + 4);
                const float yf[8] = {bf_lo(yq.x), bf_hi(yq.x), bf_lo(yq.y), bf_hi(yq.y), bf_lo(yq.z), bf_hi(yq.z), bf_lo(yq.w), bf_hi(yq.w)};
                const float zf[8] = {bf_lo(zq.x), bf_hi(zq.x), bf_lo(zq.y), bf_hi(zq.y), bf_lo(zq.z), bf_hi(zq.z), bf_lo(zq.w), bf_hi(zq.w)};
                const float xf[8] = {xa[0], xa[1], xa[2], xa[3], xc[0], xc[1], xc[2], xc[3]};
                float r[8];
#pragma unroll
                for (int e = 0; e < 8; ++e) r[e] = (yf[e] + yv[e] + Dsk * xf[e]) * silu_f(zf[e]);
                u32x4 o; o.x = cvt_pk_bf16(r[0], r[1]); o.y = cvt_pk_bf16(r[2], r[3]); o.z = cvt_pk_bf16(r[4], r[5]); o.w = cvt_pk_bf16(r[6], r[7]);
                *(u32x4*)(Z + off) = o;
            }
        }
    }
    if (!lat) { float* sp = P.out + ZZ + OUT_ST + ((size_t)((((b * 2 + l) * 2 + dir) * 16 + h) * 64 + p)) * 128 + ns * 16;
#pragma unroll
        for (int i = 0; i < 4; ++i) *(f32x4*)(sp + 4 * i) = (f32x4){S[4 * i], S[4 * i + 1], S[4 * i + 2], S[4 * i + 3]}; }
}
__device__ __forceinline__ void phase_ssd(const Params& P, int l, LAS unsigned char* lds, int dir) {
    for (int u = blockIdx.x; u < 640; u += gridDim.x) {
        if (u < 128) ssd_unit(P, l, lds, 1, u >> 4, u & 15, dir);
        else { const int u2 = u - 128; ssd_unit(P, l, lds, 0, u2 >> 4, u2 & 15, dir); }
    }
}

__device__ __forceinline__ void pooled_rows(const Params& P, int gw, int NGW, int lane) {
    const int ZZ = opq0();
    const bf16_t* PU = (const bf16_t*)(P.ws + ZZ + WS_PU);
    bf16_t* PO = (bf16_t*)(P.ws + ZZ + WS_POOLED);
    {
        const int hw = 1 << (lane >> 4);
        float wgt[16];
#pragma unroll
        for (int dk = -8; dk < 8; ++dk) wgt[dk + 8] = (dk >= -hw && dk < hw) ? 1.f : 0.f;
        for (int task = gw; task < MTOK / 4; task += NGW) {
            const int r0 = task * 4;
            int t0, L; if (r0 < MCTX) { t0 = r0 & 255; L = LCTX; } else { t0 = (r0 - MCTX) & 2047; L = LLAT; }
            u32x4 rows[20];
#pragma unroll
            for (int k = 0; k < 20; ++k) { const int tt = t0 + k - 8; rows[k] = (u32x4){0u, 0u, 0u, 0u}; if (tt >= 0 && tt < L) rows[k] = *(const u32x4*)(PU + (size_t)(r0 + k - 8) * 512 + lane * 8); }
#pragma unroll
            for (int j = 0; j < 4; ++j) {
                float a[8];
#pragma unroll
                for (int e = 0; e < 8; ++e) a[e] = 0.f;
#pragma unroll
                for (int dk = 0; dk < 16; ++dk) { const u32x4 q = rows[j + dk]; const float ww = wgt[dk];
                    a[0] += ww * bf_lo(q.x); a[1] += ww * bf_hi(q.x); a[2] += ww * bf_lo(q.y); a[3] += ww * bf_hi(q.y); a[4] += ww * bf_lo(q.z); a[5] += ww * bf_hi(q.z); a[6] += ww * bf_lo(q.w); a[7] += ww * bf_hi(q.w); }
                const int t = t0 + j, lo = t - hw < 0 ? 0 : t - hw, hi = t + hw > L ? L : t + hw;
                const float ic = 1.0f / (float)(hi - lo);
                const u32x4 q = rows[j + 8];
                const float uu[8] = {bf_lo(q.x), bf_hi(q.x), bf_lo(q.y), bf_hi(q.y), bf_lo(q.z), bf_hi(q.z), bf_lo(q.w), bf_hi(q.w)};
#pragma unroll
                for (int e = 0; e < 8; ++e) a[e] = a[e] * ic - uu[e];
                u32x4 o; o.x = cvt_pk_bf16(a[0], a[1]); o.y = cvt_pk_bf16(a[2], a[3]); o.z = cvt_pk_bf16(a[4], a[5]); o.w = cvt_pk_bf16(a[6], a[7]);
                *(u32x4*)(PO + (size_t)(r0 + j) * 512 + lane * 8) = o;
            }
        }
    }
}
__device__ __forceinline__ void ssq_sum(const Params& P) {
    const int ZZ = opq0();
    const float* sh = (const float*)(P.ws + ZZ + WS_SSQH);
    for (int m = blockIdx.x * 512 + threadIdx.x; m < MTOK; m += gridDim.x * 512) { float s = 0.f;
#pragma unroll
        for (int h = 0; h < 16; ++h) s += sh[(size_t)h * MTOK + m];
        ((float*)(P.ws + ZZ + WS_SSQ))[m] = s; }
}
__device__ __forceinline__ void phase_h2(const Params& P, int l) {
    const int ZZ = opq0();
    const int tid = threadIdx.x, lane = tid & 63, w = tid >> 6;
    const int gw = blockIdx.x * 8 + w, NGW = gridDim.x * 8;
    const float* MOD = (const float*)(P.ws + ZZ + WS_MOD) + (size_t)l * 9 * 6144;
    norm_rows_x(P, ZZ, P.in[ZZ + I_N2G] + l * 1024, MOD, 3072, 4096, gw, NGW, lane);
}
__device__ __forceinline__ void dt_prepass(const Params& P, int l) {
    const int ZZ = opq0();
    const int tid = threadIdx.x, lane = tid & 63, w = tid >> 6;
    const int gw = blockIdx.x * 8 + w, NGW = gridDim.x * 8;
    const float* DT = (const float*)(P.ws + ZZ + WS_DT); float* DTS = (float*)(P.ws + ZZ + WS_DTS); float* CUM = (float*)(P.ws + ZZ + WS_CUM2);
    constexpr int NT = 3;
    for (int task0 = gw; task0 < 192 * 32; task0 += NT * NGW) {
        float xr0[NT], xr1[NT];
#pragma unroll
        for (int k = 0; k < NT; ++k) { const int task = task0 + k * NGW; xr0[k] = 0.f; xr1[k] = 0.f;
            if (task < 192 * 32) { const size_t i0 = (size_t)((task >> 5) * 128 + 2 * lane) * 32 + (task & 31); xr0[k] = DT[i0]; xr1[k] = DT[i0 + 32]; } }
#pragma unroll
        for (int k = 0; k < NT; ++k) { const int task = task0 + k * NGW; if (task >= 192 * 32) break;
            const int hd = task & 31, rbase = (task >> 5) * 128;
            const float A = -__expf(P.in[ZZ + I_ALOG][l * 32 + hd]), bias = P.in[ZZ + I_DTB][l * 32 + hd];
            const size_t o0 = (size_t)hd * MTOK + rbase + 2 * lane;
            const float x0 = xr0[k] + bias, x1 = xr1[k] + bias;
            const float d0 = fmaxf(x0, 0.f) + log1pf(__expf(-fabsf(x0))), d1 = fmaxf(x1, 0.f) + log1pf(__expf(-fabsf(x1)));
            const float a0 = d0 * A, a1 = d1 * A, pair = a0 + a1;
            float s = pair;
            if (hd < 16) {
#pragma unroll
                for (int dlt = 1; dlt < 64; dlt <<= 1) { const float v = __shfl_up(s, dlt); if (lane >= dlt) s += v; }
                const float ex = s - pair; *(f32x2*)(CUM + o0) = (f32x2){ex + a0, ex + pair};
            } else {
#pragma unroll
                for (int dlt = 1; dlt < 64; dlt <<= 1) { const float v = __shfl_down(s, dlt); if (lane + dlt < 64) s += v; }
                const float ex = s - pair; *(f32x2*)(CUM + o0) = (f32x2){ex + pair, ex + a1};
            }
            *(f32x2*)(DTS + o0) = (f32x2){d0, d1};
        }
    }
}
constexpr int SL_C = 0, SL_B = 32768, SL_XT = 65536, SL_XE = 81920, SL_SB = 98304  , SL_CUM = 131072, SL_DT = 131584;
__device__ __forceinline__ unsigned short bf16_1(float x) { return (unsigned short)(cvt_pk_bf16_c(x, x) & 0xffffu); }
__device__ __forceinline__ void ssd_chain(const Params& P, int l, LAS unsigned char* lds, int lat, int b, int h, int dir, bool dry) {
    const int ZZ = opq0();
    const int tid = threadIdx.x, lane = tid & 63, w = __builtin_amdgcn_readfirstlane(tid >> 6), g = lane >> 4, li = lane & 15;
    const int L = lat ? LLAT : LCTX, row0 = lat ? MCTX + b * LLAT : b * LCTX, grp = h >> 3, hd = dir * 16 + h, nck = L / 128;
    const float Dsk = P.in[ZZ + I_DSKIP][l * 16 + h];
    const bf16_t* X = (const bf16_t*)(P.ws + ZZ + WS_X2) + (size_t)h * MTOK * 64;
    const bf16_t* BC = (const bf16_t*)(P.ws + ZZ + WS_BC) + (size_t)grp * MTOK * 256;
    const float* DT = (const float*)(P.ws + ZZ + WS_DTS) + (size_t)hd * MTOK;
    const float* CUM = (const float*)(P.ws + ZZ + WS_CUM2) + (size_t)hd * MTOK;
    bf16_t* Y = (bf16_t*)((unsigned char*)(P.out + ZZ) + OUTB_Y) + (size_t)h * MTOK * 64;
    bf16_t* Z = (bf16_t*)(P.ws + ZZ + WS_Z);
    const float* cw = P.in[ZZ + I_CONVW] + (size_t)l * 5 * 1536 + h * 64;
    const float* cb = P.in[ZZ + I_CONVB] + (size_t)l * 1536 + h * 64;
    LAS float* cumL = (LAS float*)(lds + SL_CUM);
    LAS float* dtL = (LAS float*)(lds + SL_DT);
    const int pt_s = w & 3, nt0 = 4 * (w >> 2);
    f32x4 Sacc[4];
    if (lat) { const float* sp = P.in[ZZ + I_ST] + (size_t)((((b * 2 + l) * 2 + dir) * 16 + h) * 64) * 128;
#pragma unroll
        for (int k = 0; k < 4; ++k)
#pragma unroll
            for (int r = 0; r < 4; ++r) Sacc[k][r] = sp[(size_t)(16 * pt_s + 4 * g + r) * 128 + 16 * (nt0 + k) + li]; }
    else {
#pragma unroll
        for (int k = 0; k < 4; ++k) Sacc[k] = (f32x4){0.f, 0.f, 0.f, 0.f}; }
    int sb = 0;
#define SSD_WRITE_SB(sel) do { _Pragma("unroll") for (int k = 0; k < 4; ++k) _Pragma("unroll") for (int r = 0; r < 4; ++r) { const int p_ = 16 * pt_s + 4 * g + r, n_ = 16 * (nt0 + k) + li; \
        *(LAS unsigned short*)(lds + SL_SB + (sel) * 16384 + p_ * 256 + ((((n_ >> 3) ^ (p_ & 15))) << 4) + (n_ & 7) * 2) = bf16_1(Sacc[k][r]); } } while (0)
    const int st_c = 2 * (tid & 31), st_jr = tid >> 5;
    float cw0[5], cw1[5];
#pragma unroll
    for (int j = 0; j < 5; ++j) { cw0[j] = cw[j * 1536 + st_c]; cw1[j] = cw[j * 1536 + st_c + 1]; }
    const float cb0 = cb[st_c], cb1 = cb[st_c + 1];
    float pf_cum, pf_dt, pf_tot; u32x4 pf_b[4], pf_c[4]; unsigned pf_x[12]; float pf_xdt[8], pf_xcum[8];
    const unsigned vo_bc = (unsigned)((tid >> 4) * 512 + (tid & 15) * 16);
    const unsigned vo_x = (unsigned)(st_jr * 1024 + st_c * 2);
    const unsigned vo_dt = (unsigned)(st_jr * 32);
    const unsigned vo_t = (unsigned)((tid & 127) * 4);
#define SSD_PREFETCH(CK) do { const int t0_ = (dir == 0 ? (CK) : nck - 1 - (CK)) * 128; const size_t rb_ = (size_t)row0 + t0_; \
        const char* bcb_ = (const char*)(BC + rb_ * 256); const char* xb_ = (const char*)(X + ((ptrdiff_t)rb_ - 2) * 64); const char* dtb_ = (const char*)(DT + rb_); const char* cmb_ = (const char*)(CUM + rb_); \
        if (tid < 128) { pf_cum = *(const float*)(cmb_ + vo_t); pf_dt = *(const float*)(dtb_ + vo_t); } \
        pf_tot = *(const float*)(cmb_ + (dir == 0 ? 127 * 4 : 0)); \
        _Pragma("unroll") for (int k = 0; k < 4; ++k) { pf_b[k] = *(const u32x4*)(bcb_ + k * 16384 + vo_bc); pf_c[k] = *(const u32x4*)(bcb_ + k * 16384 + 256 + vo_bc); } \
        _Pragma("unroll") for (int e = 0; e < 12; ++e) pf_x[e] = *(const unsigned*)(xb_ + e * 128 + vo_x); \
        { const bool lo_bad = (t0_ == 0 && st_jr == 0), hi_bad = (t0_ + 128 == L && st_jr == 15);     \
          if (lo_bad) { pf_x[0] = 0u; pf_x[1] = 0u; } if (hi_bad) { pf_x[10] = 0u; pf_x[11] = 0u; } } \
        { const f32x4 d0_ = *(const f32x4*)(dtb_ + vo_dt), d1_ = *(const f32x4*)(dtb_ + 16 + vo_dt), c0_ = *(const f32x4*)(cmb_ + vo_dt), c1_ = *(const f32x4*)(cmb_ + 16 + vo_dt); \
          _Pragma("unroll") for (int e = 0; e < 4; ++e) { pf_xdt[e] = d0_[e]; pf_xdt[4 + e] = d1_[e]; pf_xcum[e] = c0_[e]; pf_xcum[4 + e] = c1_[e]; } } } while (0)
    __syncthreads();
    SSD_WRITE_SB(0);
    SSD_PREFETCH(0);
#ifdef SSD_TS
    unsigned long long ts_acc0 = 0, ts_acc1 = 0, ts_acc2 = 0, ts_acc3 = 0, ts_acc4 = 0, ts_prev = __builtin_amdgcn_s_memrealtime();
#define TS_MARK(A) do { const unsigned long long t_ = __builtin_amdgcn_s_memrealtime(); A += t_ - ts_prev; ts_prev = t_; } while (0)
#else
#define TS_MARK(A) do { } while (0)
#endif
    for (int ck = 0; ck < nck; ++ck) {
        const int t0 = (dir == 0 ? ck : nck - 1 - ck) * 128;
        const size_t rbase = (size_t)row0 + t0;
        LDS_BARRIER();
        TS_MARK(ts_acc0);
        if (tid < 128) { cumL[tid] = pf_cum * 1.4426950408889634f; dtL[tid] = pf_dt; }
        const float tot = pf_tot;
#pragma unroll
        for (int k = 0; k < 4; ++k) { const int idx = tid + 512 * k, row = idx >> 4, ch = idx & 15;
            *(LAS u32x4*)(lds + SL_B + row * 256 + ((ch ^ (row & 15)) << 4)) = pf_b[k];
            *(LAS u32x4*)(lds + SL_C + row * 256 + ((ch ^ (row & 15)) << 4)) = pf_c[k]; }
#ifdef SSD_TS2
        TS_MARK(ts_acc1);
#endif
        {
            const int c = st_c, jr = st_jr;
            f32x2 x2[12];
#pragma unroll
            for (int e = 0; e < 12; ++e) x2[e] = (f32x2){bf_lo(pf_x[e]), bf_hi(pf_x[e])};
            f32x2 xv[8], xe[8];
#pragma unroll
            for (int e = 0; e < 8; ++e) { f32x2 a = (f32x2){cb0, cb1};
#pragma unroll
                for (int j = 0; j < 5; ++j) a = __builtin_elementwise_fma((f32x2){cw0[j], cw1[j]}, x2[e + j], a);
                const f32x2 sl = (f32x2){silu_f(a[0]), silu_f(a[1])};
                xv[e] = sl * pf_xdt[e]; xe[e] = xv[e] * __expf(tot - pf_xcum[e]); }
#pragma unroll
            for (int hf = 0; hf < 2; ++hf) { const int cc = c + hf, o = cc * 256 + ((jr ^ (cc & 15)) << 4);
                u32x4 q; q.x = cvt_pk_bf16_c(xv[0][hf], xv[1][hf]); q.y = cvt_pk_bf16_c(xv[2][hf], xv[3][hf]); q.z = cvt_pk_bf16_c(xv[4][hf], xv[5][hf]); q.w = cvt_pk_bf16_c(xv[6][hf], xv[7][hf]);
                *(LAS u32x4*)(lds + SL_XT + o) = q;
                q.x = cvt_pk_bf16_c(xe[0][hf], xe[1][hf]); q.y = cvt_pk_bf16_c(xe[2][hf], xe[3][hf]); q.z = cvt_pk_bf16_c(xe[4][hf], xe[5][hf]); q.w = cvt_pk_bf16_c(xe[6][hf], xe[7][hf]);
                *(LAS u32x4*)(lds + SL_XE + o) = q; }
        }
#ifdef SSD_TS2
        TS_MARK(ts_acc2);
#endif
        if (ck + 1 < nck) SSD_PREFETCH(ck + 1);
#ifdef SSD_TS2
        TS_MARK(ts_acc3);
#else
        TS_MARK(ts_acc1);
#endif
        LDS_BARRIER();
#ifndef SSD_TS2
        TS_MARK(ts_acc2);
#endif
        const int i = 16 * w + li;
        const float cum_i = cumL[i];
        bf16x8 cf[4];
#pragma unroll
        for (int ks = 0; ks < 4; ++ks) cf[ks] = *(const LAS bf16x8*)(lds + SL_C + i * 256 + (((4 * ks + g) ^ (i & 15)) << 4));
        f32x4 y[4];
#pragma unroll
        for (int pt = 0; pt < 4; ++pt) { y[pt] = (f32x4){0.f, 0.f, 0.f, 0.f}; const int p = 16 * pt + li;
#pragma unroll
            for (int ks = 0; ks < 4; ++ks) { const bf16x8 a = *(const LAS bf16x8*)(lds + SL_SB + sb * 16384 + p * 256 + (((4 * ks + g) ^ (p & 15)) << 4));
                y[pt] = __builtin_amdgcn_mfma_f32_16x16x32_bf16(a, cf[ks], y[pt], 0, 0, 0); } }
        { const float ei = __builtin_amdgcn_exp2f(cum_i);
#pragma unroll
            for (int pt = 0; pt < 4; ++pt) y[pt] = y[pt] * ei; }
        const int s_lo = dir == 0 ? 0 : (w >> 1), s_hi = dir == 0 ? (w >> 1) : 3;
        for (int s = s_lo; s <= s_hi; ++s) {
            f32x4 G0 = (f32x4){0.f, 0.f, 0.f, 0.f}, G1 = G0;
            const int j0 = 32 * s + li, j1 = j0 + 16;
#pragma unroll
            for (int ks = 0; ks < 4; ++ks) {
                const bf16x8 a0 = *(const LAS bf16x8*)(lds + SL_B + j0 * 256 + (((4 * ks + g) ^ (j0 & 15)) << 4));
                const bf16x8 a1 = *(const LAS bf16x8*)(lds + SL_B + j1 * 256 + (((4 * ks + g) ^ (j1 & 15)) << 4));
                G0 = __builtin_amdgcn_mfma_f32_16x16x32_bf16(a0, cf[ks], G0, 0, 0, 0);
                G1 = __builtin_amdgcn_mfma_f32_16x16x32_bf16(a1, cf[ks], G1, 0, 0, 0); }
            const f32x4 cj0 = *(const LAS f32x4*)(cumL + 32 * s + 4 * g), cj1 = *(const LAS f32x4*)(cumL + 32 * s + 16 + 4 * g);
            const int sg = dir == 0 ? 1 : -1, mb = sg * (i - 32 * s - 4 * g);
#pragma unroll
            for (int r = 0; r < 4; ++r) { const bool va = mb >= sg * r, vb = mb >= sg * (r + 16);
                G0[r] = va ? G0[r] * __builtin_amdgcn_exp2f(cum_i - cj0[r]) : 0.f; G1[r] = vb ? G1[r] * __builtin_amdgcn_exp2f(cum_i - cj1[r]) : 0.f; }
            u32x4 pk; pk.x = cvt_pk_bf16(G0[0], G0[1]); pk.y = cvt_pk_bf16(G0[2], G0[3]); pk.z = cvt_pk_bf16(G1[0], G1[1]); pk.w = cvt_pk_bf16(G1[2], G1[3]);
            const bf16x8 bp = __builtin_bit_cast(bf16x8, pk);
#pragma unroll
            for (int pt = 0; pt < 4; ++pt) { const int p = 16 * pt + li;
                const u32x2 lo8 = *(const LAS u32x2*)(lds + SL_XT + p * 256 + (((4 * s + (g >> 1)) ^ (p & 15)) << 4) + 8 * (g & 1));
                const u32x2 hi8 = *(const LAS u32x2*)(lds + SL_XT + p * 256 + (((4 * s + 2 + (g >> 1)) ^ (p & 15)) << 4) + 8 * (g & 1));
                u32x4 av; av.x = lo8.x; av.y = lo8.y; av.z = hi8.x; av.w = hi8.y;
                y[pt] = __builtin_amdgcn_mfma_f32_16x16x32_bf16(__builtin_bit_cast(bf16x8, av), bp, y[pt], 0, 0, 0); }
        }
        { const float etot = __expf(tot);
#pragma unroll
            for (int k = 0; k < 4; ++k) Sacc[k] = Sacc[k] * etot; }
        unsigned tra[2][4];
        { int lq = li; asm volatile("" : "+v"(lq)); const int q = lq >> 2, pp = lq & 3;
#pragma unroll
          for (int t = 0; t < 2; ++t)
#pragma unroll
            for (int k = 0; k < 4; ++k) { const int row = 8 * g + 4 * t + q, ch = 2 * (nt0 + k) + (pp >> 1);
                tra[t][k] = (unsigned)(SL_B + row * 256 + ((ch ^ (row & 15)) << 4) + 8 * (pp & 1)); } }
#define SSD_STATE_KS(KS) do { u32x2 t0a, t0b, t0c, t0d, t1a, t1b, t1c, t1d; \
            asm volatile("ds_read_b64_tr_b16 %0, %8 offset:%16\n\tds_read_b64_tr_b16 %1, %9 offset:%16\n\tds_read_b64_tr_b16 %2, %10 offset:%16\n\tds_read_b64_tr_b16 %3, %11 offset:%16\n\t" \
                         "ds_read_b64_tr_b16 %4, %12 offset:%16\n\tds_read_b64_tr_b16 %5, %13 offset:%16\n\tds_read_b64_tr_b16 %6, %14 offset:%16\n\tds_read_b64_tr_b16 %7, %15 offset:%16\n\ts_waitcnt lgkmcnt(0)" \
                         : "=&v"(t0a), "=&v"(t0b), "=&v"(t0c), "=&v"(t0d), "=&v"(t1a), "=&v"(t1b), "=&v"(t1c), "=&v"(t1d) \
                         : "v"(tra[0][0]), "v"(tra[0][1]), "v"(tra[0][2]), "v"(tra[0][3]), "v"(tra[1][0]), "v"(tra[1][1]), "v"(tra[1][2]), "v"(tra[1][3]), "i"(8192 * (KS)) : "memory"); \
            __builtin_amdgcn_sched_barrier(0); \
            const int p_ = 16 * pt_s + li; const bf16x8 a_ = *(const LAS bf16x8*)(lds + SL_XE + p_ * 256 + (((4 * (KS) + g) ^ (p_ & 15)) << 4)); \
            u32x4 b0_, b1_, b2_, b3_; b0_.x = t0a.x; b0_.y = t0a.y; b0_.z = t1a.x; b0_.w = t1a.y; b1_.x = t0b.x; b1_.y = t0b.y; b1_.z = t1b.x; b1_.w = t1b.y; \
            b2_.x = t0c.x; b2_.y = t0c.y; b2_.z = t1c.x; b2_.w = t1c.y; b3_.x = t0d.x; b3_.y = t0d.y; b3_.z = t1d.x; b3_.w = t1d.y; \
            Sacc[0] = __builtin_amdgcn_mfma_f32_16x16x32_bf16(a_, __builtin_bit_cast(bf16x8, b0_), Sacc[0], 0, 0, 0); Sacc[1] = __builtin_amdgcn_mfma_f32_16x16x32_bf16(a_, __builtin_bit_cast(bf16x8, b1_), Sacc[1], 0, 0, 0); \
            Sacc[2] = __builtin_amdgcn_mfma_f32_16x16x32_bf16(a_, __builtin_bit_cast(bf16x8, b2_), Sacc[2], 0, 0, 0); Sacc[3] = __builtin_amdgcn_mfma_f32_16x16x32_bf16(a_, __builtin_bit_cast(bf16x8, b3_), Sacc[3], 0, 0, 0); } while (0)
        SSD_STATE_KS(0); SSD_STATE_KS(1); SSD_STATE_KS(2); SSD_STATE_KS(3);
#undef SSD_STATE_KS
        sb ^= 1;
        SSD_WRITE_SB(sb);
#ifndef SSD_TS2
        TS_MARK(ts_acc3);
#endif
        const float rdti = __builtin_amdgcn_rcpf(dtL[i]);
        float ssq_part = 0.f;
#pragma unroll
        for (int pt = 0; pt < 4; ++pt) { const size_t off = (rbase + i) * 1024 + h * 64 + 16 * pt + 4 * g, yoff = (rbase + i) * 64 + 16 * pt + 4 * g;
            if (dir == 0) { u32x2 o; o.x = cvt_pk_bf16(y[pt][0], y[pt][1]); o.y = cvt_pk_bf16(y[pt][2], y[pt][3]); *(u32x2*)(Y + yoff) = o; }
            else {
                const u32x2 yq = *(const u32x2*)(Y + yoff), zq = *(const u32x2*)(Z + off);
                const float yf[4] = {bf_lo(yq.x), bf_hi(yq.x), bf_lo(yq.y), bf_hi(yq.y)}, zf[4] = {bf_lo(zq.x), bf_hi(zq.x), bf_lo(zq.y), bf_hi(zq.y)};
                float rr[4];
#pragma unroll
                for (int r = 0; r < 4; ++r) { const int p = 16 * pt + 4 * g + r;
                    const unsigned short xr = *(const LAS unsigned short*)(lds + SL_XT + p * 256 + (((i >> 3) ^ (p & 15)) << 4) + (i & 7) * 2);
                    const float xv = __uint_as_float((unsigned)xr << 16) * rdti;
                    rr[r] = (yf[r] + y[pt][r] + Dsk * xv) * silu_f(zf[r]); }
                u32x2 o; o.x = cvt_pk_bf16(rr[0], rr[1]); o.y = cvt_pk_bf16(rr[2], rr[3]); *(u32x2*)(Z + off) = dry ? zq : o;
                { const float q0 = bf_lo(o.x), q1 = bf_hi(o.x), q2 = bf_lo(o.y), q3 = bf_hi(o.y); ssq_part += (q0 * q0 + q1 * q1) + (q2 * q2 + q3 * q3); }
            }
        }
        if (dir == 1 && !dry) {
            ssq_part += __shfl_xor(ssq_part, 16); ssq_part += __shfl_xor(ssq_part, 32);
            if (g == 0) ((float*)(P.ws + ZZ + WS_SSQH))[(size_t)h * MTOK + rbase + i] = ssq_part;
        }
        TS_MARK(ts_acc4);
    }
#ifdef SSD_TS
    if (blockIdx.x == 0 && l == 0 && lat && dir == 0 && (tid == 0 || tid == 448)) { unsigned long long* o_ = (unsigned long long*)(P.ws + ZZ + 512 * 1024 + 1024) + (tid ? 8 : 0);
        o_[0] = ts_acc0; o_[1] = ts_acc1; o_[2] = ts_acc2; o_[3] = ts_acc3; o_[4] = ts_acc4; }
#endif
    if (!lat) { float* sp = P.out + ZZ + OUT_ST + (size_t)((((b * 2 + l) * 2 + dir) * 16 + h) * 64) * 128;
#pragma unroll
        for (int k = 0; k < 4; ++k)
#pragma unroll
            for (int r = 0; r < 4; ++r) sp[(size_t)(16 * pt_s + 4 * g + r) * 128 + 16 * (nt0 + k) + li] = Sacc[k][r]; }
#undef TS_MARK
#undef SSD_WRITE_SB
#undef SSD_PREFETCH
}
__device__ __forceinline__ void latent_chain_of(int c, int& b, int& h) {
    const int x = c & 7, k = c >> 3, combo = x + 8 * (k >> 3); b = combo >> 1; h = (combo & 1) * 8 + (k & 7);
}
__device__ __forceinline__ void context_unit_of(int u, int& b, int& h) {
    const int cb = u >> 2, j = u & 3, x = cb & 7, ku = (cb >> 3) * 4 + j, combo = x + 8 * (ku >> 3); b = combo >> 1; h = (combo & 1) * 8 + (ku & 7);
}
#ifndef CTXMOVE
#define CTXMOVE 0
#endif
__device__ __forceinline__ void phase_ssd1(const Params& P, int l, LAS unsigned char* lds, bool dry) {
    const int G = gridDim.x, bid = blockIdx.x;
    const bool fast = (G == 256);
    for (int q = 0;; ++q) {
        int it, dir;
        if (fast) { if (bid < 128) { if (q >= 1) break; it = bid; dir = 0; } else { if (q >= 8 - CTXMOVE) break; it = 128 + (bid - 128) * 4 + (q >> 1); dir = q & 1; } }
        else { it = bid + (q >> 1) * G; dir = q & 1; if (it >= 640) break; if (it < 128 && dir == 1) continue; }
        const int lat = it < 128 ? 1 : 0; int b, h;
        if (lat) latent_chain_of(it, b, h); else context_unit_of(it - 128, b, h);
        ssd_chain(P, l, lds, lat, b, h, dir, dry);
    }
}
__device__ __forceinline__ void phase_ssd2(const Params& P, int l, LAS unsigned char* lds, bool dry, int first, int stride) {
    const bool fast = (gridDim.x == 256);
    for (int u = first; u < 128; u += stride) {
        for (int k = 0; k < (fast ? 1 + CTXMOVE : 1); ++k) {
            int b, h; const int lat = k == 0 ? 1 : 0;
            if (lat) latent_chain_of(u, b, h); else context_unit_of(4 * u + 3, b, h);
            ssd_chain(P, l, lds, lat, b, h, 1, dry);
        }
    }
}
#define XB_TMO      128
#define XB_XCNT(j)  (256  + 64 * (j))
#define XB_XSUB(j)  (1280 + 64 * (j))
#define XB_XGEN(j)  (2304 + 64 * (j))
#define XB_TOP      3328
#define XB_TOPGEN   3392
#define XCD_BAR_WORDS 3456
#define XB_SPIN_CAP (1u << 18)

__device__ __forceinline__ unsigned xb_ld(unsigned* p)              { return __hip_atomic_load(p, __ATOMIC_RELAXED, __HIP_MEMORY_SCOPE_AGENT); }
__device__ __forceinline__ unsigned xb_add(unsigned* p, unsigned v) { return __hip_atomic_fetch_add(p, v, __ATOMIC_RELAXED, __HIP_MEMORY_SCOPE_AGENT); }
__device__ __forceinline__ unsigned xb_xcc_id() { return (unsigned)__builtin_amdgcn_s_getreg((3 << 11) | 20) & 0xFu; }
#define XB_SPIN(cond, bar) do { unsigned _sp = 0; while (cond) { __builtin_amdgcn_s_sleep(1); \
    if ((++_sp & 255u) == 0u) { if (xb_ld(&(bar)[XB_TMO])) break; if (_sp > XB_SPIN_CAP) { atomicAdd(&(bar)[XB_TMO], 1u); break; } } } } while (0)

struct XcdBarrier {
    unsigned* bar; unsigned x;
    volatile LAS unsigned* st;
};

__device__ __forceinline__ XcdBarrier xcd_barrier_post(unsigned* bar, volatile LAS unsigned* st) {
    XcdBarrier b; b.bar = bar; b.x = xb_xcc_id(); b.st = st;
    if (threadIdx.x == 0) (void)xb_add(&bar[XB_XCNT(b.x)], 1u);
    return b;
}
__device__ __forceinline__ void xcd_barrier_complete(unsigned* bar, unsigned x, unsigned& nloc, unsigned& nx) {
    const unsigned G = gridDim.x * gridDim.y * gridDim.z;
    unsigned sum, cnt, mine, sp = 0u;
    for (;;) {
        sum = 0u; cnt = 0u; mine = 0u;
#pragma unroll
        for (unsigned j = 0; j < 16; ++j) { const unsigned c = xb_ld(&bar[XB_XCNT(j)]); sum += c; cnt += (c > 0u) ? 1u : 0u; mine = (j == x) ? c : mine; }
        if (sum == G) break;
        __builtin_amdgcn_s_sleep(1);
        if ((++sp & 255u) == 0u) { if (xb_ld(&bar[XB_TMO])) break; if (sp > XB_SPIN_CAP) { atomicAdd(&bar[XB_TMO], 1u); break; } }
    }
    nloc = mine > 0u ? mine : 1u; nx = cnt > 0u ? cnt : 1u;
}

__device__ __forceinline__ void xcd_barrier(const XcdBarrier& b) {
    asm volatile("s_waitcnt vmcnt(0)" ::: "memory");
    __syncthreads();
    if (threadIdx.x == 0) {
        unsigned* bar = b.bar;
        __builtin_amdgcn_s_waitcnt(0);
        unsigned nloc = b.st[0], nx = b.st[1];
        if (nloc == 0u) { xcd_barrier_complete(bar, b.x, nloc, nx); b.st[0] = nloc; b.st[1] = nx; }
        const unsigned old = xb_add(&bar[XB_XSUB(b.x)], 1u);
        const unsigned gen = old / nloc;
        if (old + 1u == (gen + 1u) * nloc) {
            __builtin_amdgcn_fence(__ATOMIC_RELEASE, "agent");
            asm volatile("s_waitcnt vmcnt(0)" ::: "memory");
            const unsigned og = xb_add(&bar[XB_TOP], 1u);
            const unsigned tg = og / nx;
            if (og + 1u == (tg + 1u) * nx) xb_add(&bar[XB_TOPGEN], 1u);
            else XB_SPIN(xb_ld(&bar[XB_TOPGEN]) == tg, bar);
            __builtin_amdgcn_fence(__ATOMIC_ACQUIRE, "agent");
            xb_add(&bar[XB_XGEN(b.x)], 1u);
            asm volatile("s_waitcnt vmcnt(0)" ::: "memory");
        } else {
            XB_SPIN(xb_ld(&bar[XB_XGEN(b.x)]) == gen, bar);
            __builtin_amdgcn_fence(__ATOMIC_ACQUIRE, "agent");
            asm volatile("s_waitcnt vmcnt(0)" ::: "memory");
        }
    }
    __syncthreads();
}
#ifndef N_LAUNCHES
#define N_LAUNCHES 1
#endif
#ifndef DEBUG_STAGE
#define DEBUG_STAGE 0
#endif
#define PH_IN(p) (lo <= (p) && (p) < hi)
#ifndef MT_MERGE
#define MT_MERGE 3
#endif
#ifndef MT_RESID
#define MT_RESID 3
#endif
#ifndef REP_PHASE
#define REP_PHASE -1
#endif
#define REPS(k) for (int rep_ = 0; rep_ < ((k) == REP_PHASE ? 2 : 1); ++rep_)
#define DRY(k) ((k) == REP_PHASE && rep_ == 0)
#ifdef ONLY_CASE
#define PH_ON(k) (((ONLY_CASE) >> (k)) & 1)
#else
#define PH_ON(k) 1
#endif
#ifdef PROBE_TS
constexpr size_t WS_TS = 512 * 1024;
#define SEAM(p) do { if (PH_IN(p) && PH_IN((p) + 1)) { xcd_barrier(xbar); if (blockIdx.x == 0 && threadIdx.x == 0) ((unsigned long long*)(P.ws + WS_TS))[(p) + 1] = __builtin_amdgcn_s_memrealtime(); } } while (0)
#else
#define SEAM(p) do { if (PH_IN(p) && PH_IN((p) + 1)) xcd_barrier(xbar); } while (0)
#endif
#ifdef PROBE_TS
#define SEAM_45(p) do { if (PH_IN(p) && PH_IN((p) + 2)) { xcd_barrier(xbar); if (blockIdx.x == 0 && threadIdx.x == 0) { const unsigned long long t_ = __builtin_amdgcn_s_memrealtime(); ((unsigned long long*)(P.ws + WS_TS))[(p) + 1] = t_; ((unsigned long long*)(P.ws + WS_TS))[(p) + 2] = t_; } } } while (0)
#else
#define SEAM_45(p) do { if (PH_IN(p) && PH_IN((p) + 2)) xcd_barrier(xbar); } while (0)
#endif
#define SEAM_MID(p) do { if (PH_IN(p)) xcd_barrier(xbar); } while (0)
template <int L>
__device__ __forceinline__ void layer_program(const Params& P, LAS unsigned char* lds, const XcdBarrier& xbar, const int lo, const int hi) {
    constexpr int B = 1 + NPH_LAYER * L;
    if (PH_ON(0) && PH_IN(B + 0)) REPS(0) phase_p0(P, L, lds);
    SEAM(B + 0);
    if (PH_ON(1) && PH_IN(B + 1)) REPS(1) {
        const int ZZ = opq0(); unsigned char* ws = P.ws + ZZ; float* outp = P.out + ZZ;
        pg8::Gemm g{(const bf16_t*)outp, (const bf16_t*)(ws + WS_WIN), MTOK, 4096, 1024};
        pg8::StaticOrder S; S.init(MTOK, 4096, gridDim.x, blockIdx.x);
        pg8::EpiInProj E{ws, outp + OUT_CV, L};
        pg8::gemm_phase<pg8::EpiInProj, pg8::StaticOrder, true, true>(lds, g, S, E);
    }
    SEAM(B + 1);
    if (PH_ON(2) && PH_IN(B + 2)) REPS(2) { if (rep_ == 0) { qk_prep(P, L); dt_prepass(P, L); } bc_conv(P, L); }
    SEAM(B + 2);
#ifndef ATT3
#define ATT3 1
#endif
#ifndef ATT4S
#define ATT4S 2
#endif
    if (PH_ON(3) && PH_IN(B + 3)) REPS(3) {
        phase_ssd1(P, L, lds, DRY(3));
        if (gridDim.x == 256 && blockIdx.x < 128 && !DRY(3)) phase_attn(P, L, lds, WS_Q, blockIdx.x, 128, 128 * ATT3);
    }
    if (!(gridDim.x == 256 && CTXMOVE == 0)) SEAM(B + 3);
    if (PH_ON(4) && PH_IN(B + 4)) REPS(4) {
        const int G_ = gridDim.x, bid_ = blockIdx.x;
        int sf_ = bid_, ss_ = G_, af_ = bid_, as_ = G_;
        int an_ = ATT_UNITS;
        if (G_ == 256) { if (bid_ < 128) { af_ = 128 * ATT3 + bid_; as_ = 128; an_ = 128 * (ATT3 + ATT4S); } else { sf_ = 128; af_ = 128 * (ATT3 + ATT4S) + bid_ - 128; as_ = 128; } }
        phase_ssd2(P, L, lds, DRY(4), sf_, ss_);
        phase_attn(P, L, lds, WS_Q, af_, as_, an_);
        if (rep_ == 0) { if (G_ != 256) pooled_rows(P, bid_ * 8 + (threadIdx.x >> 6), G_ * 8, threadIdx.x & 63);
            else if (bid_ >= 128) pooled_rows(P, (bid_ - 128) * 8 + (threadIdx.x >> 6), 128 * 8, threadIdx.x & 63); }
    }
    SEAM_45(B + 4);
    if (PH_ON(6) && PH_IN(B + 6)) REPS(6) {
        const int ZZ = opq0(); unsigned char* ws = P.ws + ZZ;
        pg8::StaticOrder S; S.init(MTOK, 1024, gridDim.x, blockIdx.x, 192);
        pg8::gemm_merge6<pg8::StaticOrder>(lds, (const bf16_t*)(P.out + ZZ), (const bf16_t*)(ws + WS_WG), (const bf16_t*)(ws + WS_POOLED), (const bf16_t*)(ws + WS_Q), (const bf16_t*)(ws + WS_Z),
                                           (const bf16_t*)(ws + WS_WPOOL), (const bf16_t*)(ws + WS_WATT), (const bf16_t*)(ws + WS_WSSD), S, (bf16_t*)(ws + WS_MERGED), (const float*)(ws + WS_SSQH));
    }
    SEAM(B + 6);
    if (PH_ON(7) && PH_IN(B + 7)) REPS(7) {
        const int ZZ = opq0(); unsigned char* ws = P.ws + ZZ; float* outp = P.out + ZZ;
        const float* MOD = (const float*)(ws + WS_MOD) + (size_t)L * 9 * 6144;
        pg8::Gemm g{(const bf16_t*)(ws + WS_MERGED), (const bf16_t*)(ws + WS_WOUT), MTOK, 1024, 1024};
        pg8::StaticOrder S; S.init(MTOK, 1024, gridDim.x, blockIdx.x, 64 * MT_RESID);
        pg8::EpiResid<MT_RESID, L != 0, true> E{L == 0 ? (const void*)P.in[ZZ + I_XP] : (const void*)(ws + WS_X), L == 0 ? (const void*)P.in[ZZ + I_XS] : nullptr, ws + WS_X, MOD + 2048, DRY(7) ? 0.f : 1.f};
        pg8::gemm_phase<pg8::EpiResid<MT_RESID, L != 0, true>, pg8::StaticOrder, true, true>(lds, g, S, E);
    }
    SEAM(B + 7);
    if (PH_ON(8) && PH_IN(B + 8)) REPS(8) phase_h2(P, L);
    SEAM(B + 8);
    if (PH_ON(9) && PH_IN(B + 9)) REPS(9) {
        const int ZZ = opq0(); unsigned char* ws = P.ws + ZZ;
        pg8::Gemm g{(const bf16_t*)(P.out + ZZ), (const bf16_t*)(ws + WS_WM1), MTOK, 4096, 1024};
        pg8::StaticOrder S; S.init(MTOK, 4096, gridDim.x, blockIdx.x);
        pg8::EpiAct<2, 4> E{(bf16_t*)(ws + WS_HID), 4096};
        pg8::gemm_phase<pg8::EpiAct<2, 4>, pg8::StaticOrder, true, true>(lds, g, S, E);
    }
    SEAM(B + 9);
    if (PH_ON(10) && PH_IN(B + 10)) REPS(10) {
        const int ZZ = opq0(); unsigned char* ws = P.ws + ZZ; float* outp = P.out + ZZ;
        const float* MOD = (const float*)(ws + WS_MOD) + (size_t)L * 9 * 6144;
        pg8::Gemm g{(const bf16_t*)(ws + WS_HID), (const bf16_t*)(ws + WS_WM2), MTOK, 1024, 4096};
        pg8::StaticOrder S; S.init(MTOK, 1024, gridDim.x, blockIdx.x, 64 * MT_RESID);
        pg8::EpiResid<MT_RESID, true, L == 0> E{ws + WS_X, nullptr, L == 0 ? (void*)(ws + WS_X) : (void*)outp, MOD + 5120, DRY(10) ? 0.f : 1.f};
        pg8::gemm_phase<pg8::EpiResid<MT_RESID, true, L == 0>, pg8::StaticOrder, true, true>(lds, g, S, E);
    }
    SEAM(B + 10);
}
__global__ void __launch_bounds__(512, 2) fwd_megakernel(Params P) {
    extern __shared__ __attribute__((aligned(16))) unsigned char lds_raw[];
    LAS unsigned char* lds = (LAS unsigned char*)lds_raw;
    cg::grid_group grid = cg::this_grid();
    const int lo = P.ph_lo, hi = P.ph_hi;
    if (hi < 0) grid.sync();
    if (threadIdx.x < 16) ((LAS unsigned*)(lds + LDS_MISC))[threadIdx.x] = 0u;
    __syncthreads();
    const XcdBarrier xbar = xcd_barrier_post((unsigned*)(P.ws + WS_BAR), (volatile LAS unsigned*)(lds + LDS_MISC));
#ifdef PROBE_TS
    if (blockIdx.x == 0 && threadIdx.x == 0) ((unsigned long long*)(P.ws + WS_TS))[0] = __builtin_amdgcn_s_memrealtime();
#endif
    if (PH_ON(20) && PH_IN(0)) phase_mod(P, lds);
#ifdef FILL_SCRATCH
    { u32x4 z; z.x = z.y = z.z = z.w = 0x3f803f80u;
      for (size_t i = (size_t)blockIdx.x * 512 + threadIdx.x; i < (48 * MiB) / 16; i += (size_t)gridDim.x * 512) ((u32x4*)(P.ws + WS_X))[i] = z;
      for (size_t i = (size_t)blockIdx.x * 512 + threadIdx.x; i < (96 * MiB) / 16; i += (size_t)gridDim.x * 512) ((u32x4*)P.out)[i] = z; }
#endif
    SEAM(0);
    layer_program<0>(P, lds, xbar, lo, hi);
    layer_program<1>(P, lds, xbar, lo, hi);
#ifdef EXTRA_SYNCS
    for (int i_ = 0; i_ < EXTRA_SYNCS; ++i_) grid.sync();
#endif
#ifdef DETPROBE_OFF
    grid.sync();
    { const unsigned* src = (const unsigned*)(P.ws + (size_t)(DETPROBE_OFF));
      for (size_t i = (size_t)blockIdx.x * 512 + threadIdx.x; i < OUT_TOTAL; i += (size_t)gridDim.x * 512) { float v = 0.f;
          for (size_t j = i; j < (size_t)(DETPROBE_WORDS); j += OUT_TOTAL) { const unsigned w = src[j]; v += (float)((w ^ (w >> 16)) & 0xffffu); }
          P.out[i] = v; } }
#endif
#ifdef BITPROBE
    grid.sync();
    for (size_t i = (size_t)blockIdx.x * 512 + threadIdx.x; i < OUT_TOTAL; i += (size_t)gridDim.x * 512) P.out[i] = (float)(__float_as_uint(P.out[i]) & 0xfffu);
#endif
#ifdef PROBE_TS
    if (blockIdx.x == 0 && threadIdx.x == 0) ((unsigned long long*)(P.ws + WS_TS))[NPHASES] = __builtin_amdgcn_s_memrealtime();
#endif
}

#ifdef PROBE_TS
__global__ void probe_tail(float* out, const unsigned long long* ts) {
#ifdef SSD_TS_A
    const unsigned long long* sec = ts + 128;
    float ta = (float)sec[SSD_TS_A], tb = (float)sec[SSD_TS_B], tota = 0.f, totb = 0.f;
    for (int k = 0; k < 5; ++k) { tota += (float)sec[(SSD_TS_A & 8) + k]; totb += (float)sec[(SSD_TS_B & 8) + k]; }
    const float fa = ta / tota, fb = tb / totb;
#else
    float ta = (float)(ts[PROBE_A_HI] - ts[PROBE_A_LO]), tb = (float)(ts[PROBE_B_HI] - ts[PROBE_B_LO]);
#ifdef PROBE_BOTH
    ta += (float)(ts[PROBE_A_HI + NPH_LAYER] - ts[PROBE_A_LO + NPH_LAYER]); tb += (float)(ts[PROBE_B_HI + NPH_LAYER] - ts[PROBE_B_LO + NPH_LAYER]);
#endif
    const float tot = (float)(ts[NPHASES] - ts[0]);
    const float fa = ta / tot, fb = tb / tot;
#endif
    const float e = sqrtf(0.0025f * fb);
    for (size_t i = (size_t)blockIdx.x * blockDim.x + threadIdx.x; i < OUT_TOTAL; i += (size_t)gridDim.x * blockDim.x) { float v = out[i] * (1.0f + e); if (i == 0) v += 1.0f + 8.9f * fa; out[i] = v; }
}
#endif
#if DEBUG_STAGE
__global__ void debug_mask(float* out, int mode, float scale) {
    size_t i = (size_t)blockIdx.x * blockDim.x + threadIdx.x; const size_t stride = (size_t)gridDim.x * blockDim.x;
    for (; i < OUT_TOTAL; i += stride) {
        bool keep = false;
        if (mode == 1) keep = i >= OUT_CV && i < OUT_ST && (((i - OUT_CV) >> 15) & 1) == 0;
        if (mode == 2) keep = i >= OUT_CK && i < OUT_CV && (((i - OUT_CK) >> 15) & 1) == 0;
        if (mode == 3) keep = i >= OUT_ST && (((i - OUT_ST) >> 18) & 1) == 0;
        if (mode == 4) keep = i >= OUT_CK && i < OUT_CV;
        if (mode == 5) keep = i >= OUT_CV && i < OUT_ST;
        if (mode == 6) keep = i >= OUT_ST;
        if (mode == 7) keep = i < (size_t)MCTX * 1024;
        if (mode == 8) keep = i >= (size_t)MCTX * 1024 && i < OUT_CK;
        out[i] = keep ? out[i] * scale : 0.f;
    }
}
#endif

extern "C" void kernel_launch(void* const* d_in, const int* in_sizes, int n_in, void* d_out, int out_size, void* d_ws, size_t ws_size, hipStream_t stream) {
    static int grid = 0;
    if (grid == 0) {
        if (n_in != 29 || out_size != (int)OUT_TOTAL || ws_size < WS_END) { fprintf(stderr, "kernel_launch: unexpected shapes (n_in %d, out %d, ws %zu < %zu); nothing launched\n", n_in, out_size, ws_size, (size_t)WS_END); grid = -1; return; }
        int dev = 0, cus = 0, per_cu = 0;
        hipGetDevice(&dev);
        hipDeviceGetAttribute(&cus, hipDeviceAttributeMultiprocessorCount, dev);
        if (hipFuncSetAttribute((const void*)fwd_megakernel, hipFuncAttributeMaxDynamicSharedMemorySize, LDS_BYTES) != hipSuccess) { fprintf(stderr, "kernel_launch: hipFuncSetAttribute failed\n"); grid = -1; return; }
        if (hipOccupancyMaxActiveBlocksPerMultiprocessor(&per_cu, (const void*)fwd_megakernel, 512, LDS_BYTES) != hipSuccess || per_cu < 1) { fprintf(stderr, "kernel_launch: occupancy query says %d blocks per CU\n", per_cu); grid = -1; return; }
        grid = cus;
    }
    if (grid < 0) return;
    if (hipMemsetAsync((char*)d_ws + WS_BAR, 0, XCD_BAR_WORDS * 4, stream) != hipSuccess) { fprintf(stderr, "kernel_launch: memset of the barrier words failed\n"); return; }
    Params p{};
    for (int i = 0; i < 29; ++i) p.in[i] = (const float*)d_in[i];
    p.out = (float*)d_out; p.ws = (unsigned char*)d_ws;
#if DEBUG_STAGE
    const int last_phase = DEBUG_LAST_PHASE;
#elif defined(DETPROBE_LAST)
    const int last_phase = DETPROBE_LAST;
#else
    const int last_phase = NPHASES;
#endif
#if N_LAUNCHES == 1
    p.ph_lo = 0; p.ph_hi = last_phase;
    { void* args[] = {&p}; hipError_t e = hipLaunchCooperativeKernel((const void*)fwd_megakernel, dim3(grid), dim3(512), args, LDS_BYTES, stream);
      if (e != hipSuccess) fprintf(stderr, "cooperative launch failed: %s (grid %d)\n", hipGetErrorString(e), grid); }
#ifdef PROBE_TS
    probe_tail<<<2048, 256, 0, stream>>>((float*)d_out, (const unsigned long long*)((unsigned char*)d_ws + WS_TS));
#endif
#else
    for (int ph = 0; ph < last_phase; ++ph) {
        p.ph_lo = ph; p.ph_hi = ph + 1;
        void* args[] = {&p}; hipError_t e = hipLaunchCooperativeKernel((const void*)fwd_megakernel, dim3(grid), dim3(512), args, LDS_BYTES, stream);
        if (e != hipSuccess) { fprintf(stderr, "cooperative launch failed: %s (grid %d)\n", hipGetErrorString(e), grid); break; }
    }
#endif
#if DEBUG_STAGE
    debug_mask<<<1024, 256, 0, stream>>>((float*)d_out, DEBUG_STAGE, 4.0f);
#endif
}
```
